# Optimizing an MI355X kernel written in HIP

```python
import math
import jax, jax.numpy as jnp
from jax import lax
import numpy as np

D_MODEL = 1024
BATCH = 4
SEQ = 8192
DEPTH = 2

EPS = 1e-6
N_BRANCHES = 3

POOL_WINDOWS = (2, 4, 8, 16)
POOL_GROUP = 128
POOL_WIDTH = POOL_GROUP * len(POOL_WINDOWS)

SSM_GROUP = 16
SSM_GROUPS = 32
SSM_WIDTH = SSM_GROUP * SSM_GROUPS
SSM_STATE = 64

HEAD_DIM = 64
HEADS_PER_GROUP = 4
ATTN_PATTERNS = ((128, 1), (512, 4), (2048, 16))
ATTN_HEADS = HEADS_PER_GROUP * len(ATTN_PATTERNS)
ATTN_WIDTH = ATTN_HEADS * HEAD_DIM
ATTN_OUT = HEADS_PER_GROUP * HEAD_DIM
ATTN_BLOCK = 128
ROPE_THETA = 10000.0

IN_SPLITS = (POOL_WIDTH, SSM_WIDTH, ATTN_WIDTH, ATTN_WIDTH, ATTN_WIDTH, N_BRANCHES * D_MODEL)
IN_COLS = sum(IN_SPLITS)

PEER_HEADS = 8
PEER_NKEYS = 128
PEER_EXPERTS = PEER_NKEYS * PEER_NKEYS
PEER_QDIM = 256
PEER_TOPK = 16
PEER_CHUNK = 128

kernel_name = "hybrid_pool_s5_dilated_attn_peer"

F32 = jnp.float32


def rmsnorm(x, g):
    xf = x.astype(F32)
    y = xf * lax.rsqrt(jnp.mean(xf * xf, axis=-1, keepdims=True) + EPS)
    return (y * g.astype(F32)).astype(x.dtype)


def pool_branch(u, w, scale):
    B, L, _ = u.shape
    uf = u.astype(F32)
    cs = jnp.concatenate([jnp.zeros((B, 1, POOL_WIDTH), F32), jnp.cumsum(uf, axis=1)], axis=1)
    t = jnp.arange(L)
    outs = []
    for gi, win in enumerate(POOL_WINDOWS):
        sl = slice(gi * POOL_GROUP, (gi + 1) * POOL_GROUP)
        start = jnp.maximum(t + 1 - win, 0)
        count = (t + 1 - start).astype(F32)[None, :, None]
        outs.append((cs[:, 1:, sl] - cs[:, start, sl]) / count - uf[:, :, sl])
    pooled = jnp.stack(outs, axis=2)
    mixed = jnp.einsum('blgc,gcd->blgd', pooled, w.astype(F32)).reshape(B, L, POOL_WIDTH)
    return (mixed * scale.astype(F32)).astype(u.dtype)


def diag_linear_scan(a_re, a_im, b_re, b_im):
    def combine(left, right):
        lar, lai, lbr, lbi = left
        rar, rai, rbr, rbi = right
        return (lar * rar - lai * rai,
                lar * rai + lai * rar,
                rar * lbr - rai * lbi + rbr,
                rar * lbi + rai * lbr + rbi)
    _, _, s_re, s_im = lax.associative_scan(combine, (a_re, a_im, b_re, b_im), axis=0)
    return s_re, s_im


def ssm_branch(u, a_re, a_im, log_dt, b_re, b_im, c_re, c_im, d_skip, w_glu):
    B, L, _ = u.shape
    uf = u.astype(F32).reshape(B, L, SSM_GROUPS, SSM_GROUP)
    dt = jnp.exp(log_dt.astype(F32))[:, None]
    ar, ai = a_re.astype(F32), a_im.astype(F32)
    decay = jnp.exp(ar * dt)
    abar_re = decay * jnp.cos(ai * dt)
    abar_im = decay * jnp.sin(ai * dt)
    den = ar * ar + ai * ai
    nr = abar_re - 1.0
    k_re = (nr * ar + abar_im * ai) / den
    k_im = (abar_im * ar - nr * ai) / den
    br, bi = b_re.astype(F32), b_im.astype(F32)
    bbar_re = k_re[:, :, None] * br - k_im[:, :, None] * bi
    bbar_im = k_re[:, :, None] * bi + k_im[:, :, None] * br
    x_re = jnp.einsum('blgp,gnp->blgn', uf, bbar_re)
    x_im = jnp.einsum('blgp,gnp->blgn', uf, bbar_im)
    a_seq_re = jnp.broadcast_to(abar_re, (L,) + abar_re.shape)
    a_seq_im = jnp.broadcast_to(abar_im, (L,) + abar_im.shape)
    s_re, s_im = jax.vmap(diag_linear_scan, in_axes=(None, None, 0, 0))(a_seq_re, a_seq_im, x_re, x_im)
    y = (jnp.einsum('blgn,gpn->blgp', s_re, c_re.astype(F32))
         - jnp.einsum('blgn,gpn->blgp', s_im, c_im.astype(F32))
         + d_skip.astype(F32).reshape(SSM_GROUPS, SSM_GROUP) * uf)
    y = jax.nn.gelu(y.reshape(B, L, SSM_WIDTH))
    val, gate = jnp.split(y @ w_glu.astype(F32), 2, axis=-1)
    return (val * jax.nn.sigmoid(gate)).astype(u.dtype)


def rope(x, positions):
    half = HEAD_DIM // 2
    inv_freq = ROPE_THETA ** (-jnp.arange(half, dtype=F32) / half)
    ang = positions.astype(F32)[..., None] * inv_freq
    cos = jnp.cos(ang)[:, :, None, :]
    sin = jnp.sin(ang)[:, :, None, :]
    x1, x2 = x[..., :half], x[..., half:]
    return jnp.concatenate([x1 * cos - x2 * sin, x2 * cos + x1 * sin], axis=-1)


def dilated_window_attention(q, k, v, dilation, n_back):
    B, L, H, Dh = q.shape
    span = dilation * ATTN_BLOCK
    Lp = -(-L // span) * span
    pad = Lp - L
    M = Lp // dilation
    nb = M // ATTN_BLOCK

    def to_blocks(a):
        a = jnp.pad(a, ((0, 0), (0, pad), (0, 0), (0, 0)))
        a = a.reshape(B, M, dilation, H, Dh).transpose(0, 2, 3, 1, 4)
        return a.reshape(B, dilation, H, nb, ATTN_BLOCK, Dh)

    def with_prev(a):
        prev = jnp.pad(a, ((0, 0), (0, 0), (0, 0), (1, 0), (0, 0), (0, 0)))[:, :, :, :-1]
        return jnp.concatenate([prev, a], axis=4)

    qb = to_blocks(q)
    kc = with_prev(to_blocks(k))
    vc = with_prev(to_blocks(v))
    s = jnp.einsum('brhnqd,brhnkd->brhnqk', qb, kc) * (Dh ** -0.5)
    qi = jnp.arange(ATTN_BLOCK)[:, None] + ATTN_BLOCK
    ki = jnp.arange(2 * ATTN_BLOCK)[None, :]
    dist = qi - ki
    band = (dist >= 0) & (dist <= n_back)
    has_prev = (jnp.arange(nb)[:, None, None] > 0) | (ki[None] >= ATTN_BLOCK)
    mask = band[None] & has_prev
    s = jnp.where(mask, s, -jnp.inf)
    m = jnp.max(s, axis=-1, keepdims=True)
    p = jnp.exp(s - m)
    den = jnp.sum(p, axis=-1, keepdims=True)
    o = jnp.einsum('brhnqk,brhnkd->brhnqd', p, vc) / den
    lse = (m + jnp.log(den))[..., 0]
    o = o.reshape(B, dilation, H, M, Dh).transpose(0, 3, 1, 2, 4).reshape(B, Lp, H, Dh)[:, :L]
    lse = lse.reshape(B, dilation, H, M).transpose(0, 3, 1, 2).reshape(B, Lp, H)[:, :L]
    return o, lse


def attention_branch(q, k, v, positions):
    B, L, _ = q.shape
    q = rope(q.astype(F32).reshape(B, L, ATTN_HEADS, HEAD_DIM), positions)
    k = rope(k.astype(F32).reshape(B, L, ATTN_HEADS, HEAD_DIM), positions)
    v = v.astype(F32).reshape(B, L, ATTN_HEADS, HEAD_DIM)
    outs, lses = [], []
    for gi, (window, dil) in enumerate(ATTN_PATTERNS):
        hs = slice(gi * HEADS_PER_GROUP, (gi + 1) * HEADS_PER_GROUP)
        o, lse = dilated_window_attention(q[:, :, hs], k[:, :, hs], v[:, :, hs], dil, window // dil)
        outs.append(o)
        lses.append(lse)
    w = jax.nn.softmax(jnp.stack(lses), axis=0)
    out = jnp.einsum('gblh,gblhd->blhd', w, jnp.stack(outs))
    return out.reshape(B, L, ATTN_OUT)


def peer_ffn(h, wq, k1, k2, u_tab, v_tab):
    B, L, D = h.shape
    q = (h @ wq).astype(F32).reshape(B, L, PEER_HEADS, 2, PEER_QDIM // 2)
    s1 = jnp.einsum('blhc,kc->blhk', q[..., 0, :], k1.astype(F32))
    s2 = jnp.einsum('blhc,kc->blhk', q[..., 1, :], k2.astype(F32))
    v1, i1 = lax.top_k(s1, PEER_TOPK)
    v2, i2 = lax.top_k(s2, PEER_TOPK)
    cand_s = (v1[..., :, None] + v2[..., None, :]).reshape(B, L, PEER_HEADS, PEER_TOPK * PEER_TOPK)
    cand_i = (i1[..., :, None] * PEER_NKEYS + i2[..., None, :]).reshape(B, L, PEER_HEADS, PEER_TOPK * PEER_TOPK)
    top_s, pos = lax.top_k(cand_s, PEER_TOPK)
    expert = jnp.take_along_axis(cand_i, pos, axis=-1)
    gate = jax.nn.softmax(top_s, axis=-1)
    n_chunks = (B * L) // PEER_CHUNK
    hc = h.reshape(n_chunks, PEER_CHUNK, D)
    ec = expert.reshape(n_chunks, PEER_CHUNK, PEER_HEADS * PEER_TOPK)
    gc = gate.reshape(n_chunks, PEER_CHUNK, PEER_HEADS * PEER_TOPK).astype(h.dtype)

    def eval_chunk(args):
        hx, e, g = args
        a = jnp.einsum('cd,ckd->ck', hx, u_tab[e])
        return jnp.einsum('ck,ckd->cd', g * jax.nn.gelu(a), v_tab[e])

    out = lax.map(eval_chunk, (hc, ec, gc))
    return out.reshape(B, L, D)


def setup_inputs(seed: int = 0) -> dict:
    key = jax.random.key(seed)
    ks = list(jax.random.split(key, 32))

    def nrm(i, shape, scale):
        return jax.random.normal(ks[i], shape, F32) * scale

    n_idx = jnp.arange(SSM_STATE, dtype=F32)
    x = nrm(0, (BATCH, SEQ, D_MODEL), 1.0)
    positions = (jnp.arange(SEQ, dtype=jnp.int32)[None, :]
                 + jax.random.randint(ks[1], (BATCH, 1), 0, 1024, dtype=jnp.int32))
    norm1_g = 1.0 + nrm(2, (DEPTH, D_MODEL), 0.02)
    w_in = nrm(3, (DEPTH, D_MODEL, IN_COLS), D_MODEL ** -0.5)
    pool_w = nrm(4, (DEPTH, len(POOL_WINDOWS), POOL_GROUP, POOL_GROUP), POOL_GROUP ** -0.5)
    pool_scale = 1.0 + nrm(5, (DEPTH, POOL_WIDTH), 0.02)
    pool_proj = nrm(6, (DEPTH, POOL_WIDTH, D_MODEL), POOL_WIDTH ** -0.5)
    ssm_a_re = -0.5 + nrm(7, (DEPTH, SSM_GROUPS, SSM_STATE), 0.01)
    ssm_a_im = math.pi * n_idx + nrm(8, (DEPTH, SSM_GROUPS, SSM_STATE), 0.01)
    ssm_log_dt = jax.random.uniform(ks[9], (DEPTH, SSM_GROUPS), F32, math.log(1e-3), math.log(1e-1))
    b_scale = (2.0 * SSM_GROUP) ** -0.5
    ssm_b_re = nrm(10, (DEPTH, SSM_GROUPS, SSM_STATE, SSM_GROUP), b_scale)
    ssm_b_im = nrm(11, (DEPTH, SSM_GROUPS, SSM_STATE, SSM_GROUP), b_scale)
    c_scale = (2.0 * SSM_STATE) ** -0.5 * 4.0
    ssm_c_re = nrm(12, (DEPTH, SSM_GROUPS, SSM_GROUP, SSM_STATE), c_scale)
    ssm_c_im = nrm(13, (DEPTH, SSM_GROUPS, SSM_GROUP, SSM_STATE), c_scale)
    ssm_d = nrm(14, (DEPTH, SSM_WIDTH), 1.0)
    ssm_glu = nrm(15, (DEPTH, SSM_WIDTH, 2 * SSM_WIDTH), SSM_WIDTH ** -0.5)
    ssm_proj = nrm(16, (DEPTH, SSM_WIDTH, D_MODEL), SSM_WIDTH ** -0.5)
    attn_proj = nrm(17, (DEPTH, ATTN_OUT, D_MODEL), ATTN_OUT ** -0.5)
    w_out = nrm(18, (DEPTH, D_MODEL, D_MODEL), D_MODEL ** -0.5)
    norm2_g = 1.0 + nrm(19, (DEPTH, D_MODEL), 0.02)
    peer_wq = nrm(20, (DEPTH, D_MODEL, PEER_HEADS * PEER_QDIM), D_MODEL ** -0.5)
    peer_k1 = nrm(21, (DEPTH, PEER_NKEYS, PEER_QDIM // 2), (PEER_QDIM // 2) ** -0.5)
    peer_k2 = nrm(22, (DEPTH, PEER_NKEYS, PEER_QDIM // 2), (PEER_QDIM // 2) ** -0.5)
    peer_u = nrm(23, (DEPTH, PEER_EXPERTS, D_MODEL), D_MODEL ** -0.5)
    peer_v = nrm(24, (DEPTH, PEER_EXPERTS, D_MODEL), PEER_HEADS ** -0.5)
    final_g = 1.0 + nrm(25, (D_MODEL,), 0.02)
    return {"x": x, "positions": positions, "norm1_g": norm1_g, "w_in": w_in,
            "pool_w": pool_w, "pool_scale": pool_scale, "pool_proj": pool_proj,
            "ssm_a_re": ssm_a_re, "ssm_a_im": ssm_a_im, "ssm_log_dt": ssm_log_dt,
            "ssm_b_re": ssm_b_re, "ssm_b_im": ssm_b_im, "ssm_c_re": ssm_c_re, "ssm_c_im": ssm_c_im,
            "ssm_d": ssm_d, "ssm_glu": ssm_glu, "ssm_proj": ssm_proj, "attn_proj": attn_proj,
            "w_out": w_out, "norm2_g": norm2_g, "peer_wq": peer_wq, "peer_k1": peer_k1,
            "peer_k2": peer_k2, "peer_u": peer_u, "peer_v": peer_v, "final_g": final_g}


def reference(x, positions, norm1_g, w_in, pool_w, pool_scale, pool_proj,
              ssm_a_re, ssm_a_im, ssm_log_dt, ssm_b_re, ssm_b_im, ssm_c_re, ssm_c_im,
              ssm_d, ssm_glu, ssm_proj, attn_proj, w_out, norm2_g, peer_wq, peer_k1,
              peer_k2, peer_u, peer_v, final_g):
    B, L, D = x.shape
    offsets = [int(o) for o in np.cumsum(IN_SPLITS)[:-1]]
    for l in range(DEPTH):
        h = rmsnorm(x, norm1_g[l])
        z = h @ w_in[l]
        u_pool, u_ssm, q, k, v, gate_logits = jnp.split(z, offsets, axis=-1)
        y_pool = pool_branch(u_pool, pool_w[l], pool_scale[l]) @ pool_proj[l]
        y_ssm = ssm_branch(u_ssm, ssm_a_re[l], ssm_a_im[l], ssm_log_dt[l], ssm_b_re[l], ssm_b_im[l],
                           ssm_c_re[l], ssm_c_im[l], ssm_d[l], ssm_glu[l]) @ ssm_proj[l]
        y_attn = attention_branch(q, k, v, positions).astype(x.dtype) @ attn_proj[l]
        g = jax.nn.sigmoid(gate_logits).reshape(B, L, N_BRANCHES, D)
        merged = g[:, :, 0] * y_pool + g[:, :, 1] * y_ssm + g[:, :, 2] * y_attn
        x = x + merged @ w_out[l]
        h2 = rmsnorm(x, norm2_g[l])
        x = x + peer_ffn(h2, peer_wq[l], peer_k1[l], peer_k2[l], peer_u[l], peer_v[l])
    return rmsnorm(x, final_g)
```

```cpp
#include <hip/hip_runtime.h>
#include <hip/hip_cooperative_groups.h>
#include <cstdio>
#include <cstdint>
namespace cg = cooperative_groups;

#ifndef TAB_BITS
#define TAB_BITS 4
#endif
#ifndef PEER_DRAIN
#define PEER_DRAIN 0
#endif
#ifndef PEER_MFMA
#define PEER_MFMA 0
#endif
#ifndef EPI_NT
#define EPI_NT 0
#endif
#ifndef PEER_SLICED
#define PEER_SLICED 0
#endif
#ifndef XB_SAFE
#define XB_SAFE 5
#endif
#ifndef PEER_RING
#define PEER_RING 2
#endif
#ifndef PEER_XTOK
#define PEER_XTOK 1
#endif
#ifndef ABL_POOL
#define ABL_POOL 0
#endif
#ifndef ABL_SSM
#define ABL_SSM 0
#endif
#ifndef ABL_ATTN
#define ABL_ATTN 0
#endif
#ifndef ABL_PEER
#define ABL_PEER 0
#endif
constexpr int D = 1024, BATCH = 4, SEQ = 8192, M = BATCH * SEQ, DEPTH = 2;
constexpr int IN_COLS = 6400, NZ = 3328;
constexpr int POOLW = 512, SSMW = 512, AW = 768, AOUT = 256, QKVW = 2304;
constexpr int SSM_G = 32, SSM_P = 16, SSM_N = 64;
constexpr int CH = 256, NCH = SEQ / CH;
constexpr int PH = 8, NKEYS = 128, TOPK = 16, NEXP = 16384, PQ = 2048;
constexpr float EPS = 1e-6f;
constexpr int NWAVES = 8, NTHREADS = 512;

constexpr size_t MiB = 1u << 20;
constexpr size_t WS_CTL = 0;
constexpr size_t WS_W = 1 * MiB, W_LAYER = 23 * MiB;
constexpr size_t WO_WIN = 0, WO_POOL = 13107200, WO_PPROJ = WO_POOL + 524288, WO_GLU = WO_PPROJ + 1048576, WO_SPROJ = WO_GLU + 1048576,
                 WO_APROJ = WO_SPROJ + 1048576, WO_WOUT = WO_APROJ + 524288, WO_WQ = WO_WOUT + 2097152, WO_K1 = WO_WQ + 4194304, WO_K2 = WO_K1 + 32768, WO_END = WO_K2 + 32768;
static_assert(WO_END <= W_LAYER, "weights");
constexpr size_t WS_SSMC = 47 * MiB, SSMC_LAYER = 512 * 1024;
constexpr size_t WS_ROPE = 48 * MiB;
constexpr size_t WS_RSTD1 = 56 * MiB, WS_SS2 = WS_RSTD1 + 131072, WS_LSE = WS_SS2 + 131072  , WS_SEND = WS_LSE + 3 * (size_t)M * 16  ;
constexpr size_t WS_TAB = 60 * MiB, TAB_LAYER = 32 * MiB;
constexpr size_t WS_TSC = 59 * MiB + 768 * 1024;
constexpr size_t WS_C = 124 * MiB;
constexpr size_t WS_D = 188 * MiB;
constexpr size_t WS_E = 332 * MiB;
constexpr size_t WS_F = 396 * MiB;
constexpr size_t WS_SSP = 460 * MiB;
constexpr size_t WS_L1 = 462 * MiB, L1_SIZE = 8 * MiB;
constexpr size_t WS_HQ = 470 * MiB;
constexpr size_t WS_END = 502 * MiB;
constexpr size_t CTL_BYTES = 1 * MiB;
static_assert(WS_SEND + (size_t)BATCH * NCH * 32 * 64 * 8 <= WS_TSC && WS_TSC + 2 * 131072 <= 60 * MiB && WS_TAB + 2 * TAB_LAYER <= WS_C, "small");

#define LAS __attribute__((address_space(3)))
typedef unsigned short bf16_t;
typedef short bf16x8 __attribute__((ext_vector_type(8)));
typedef float f32x4 __attribute__((ext_vector_type(4)));
typedef float f32x2 __attribute__((ext_vector_type(2)));
typedef unsigned u32x4 __attribute__((ext_vector_type(4)));
typedef unsigned u32x2 __attribute__((ext_vector_type(2)));
typedef _Float16 h2_t __attribute__((ext_vector_type(2)));
typedef __bf16 b2_t __attribute__((ext_vector_type(2)));
typedef short v4i16_t __attribute__((ext_vector_type(4)));

__device__ __forceinline__ unsigned f2bf(float f) { unsigned u = __builtin_bit_cast(unsigned, f); return (u + 0x7fffu + ((u >> 16) & 1u)) >> 16; }
__device__ __forceinline__ unsigned pk2(float lo, float hi) { f32x2 v = {lo, hi}; b2_t b = __builtin_convertvector(v, b2_t); return __builtin_bit_cast(unsigned, b); }
__device__ __forceinline__ float bflo(unsigned w) { return __builtin_bit_cast(float, w << 16); }
__device__ __forceinline__ float bfhi(unsigned w) { return __builtin_bit_cast(float, w & 0xffff0000u); }
__device__ __forceinline__ unsigned pkh2(float lo, float hi) { h2_t h = {(_Float16)lo, (_Float16)hi}; return __builtin_bit_cast(unsigned, h); }
__device__ __forceinline__ float fast_exp2(float x) { return __builtin_amdgcn_exp2f(x); }
__device__ __forceinline__ float fast_rcp(float x) { return __builtin_amdgcn_rcpf(x); }
__device__ __forceinline__ float sigmoidf_(float x) { return fast_rcp(1.0f + fast_exp2(-1.4426950408889634f * x)); }
__device__ __forceinline__ float gelu_tanh(float x) { const float u = 1.5957691216057308f * (x + 0.044715f * x * x * x); return x * sigmoidf_(u); }
__device__ __forceinline__ float wave_sum(float v) {
#pragma unroll
    for (int o = 1; o < 64; o <<= 1) v += __shfl_xor(v, o);
    return v;
}
__device__ __forceinline__ unsigned fbits(float f) { return __builtin_bit_cast(unsigned, f); }
__device__ __forceinline__ float bitsf(unsigned u) { return __builtin_bit_cast(float, u); }
__device__ __forceinline__ h2_t as_h2(unsigned w) { return __builtin_bit_cast(h2_t, w); }
__device__ __forceinline__ void st_wt(float* p, float v) { __hip_atomic_store(p, v, __ATOMIC_RELAXED, __HIP_MEMORY_SCOPE_AGENT); }
#define LDS_WAIT() asm volatile("s_waitcnt lgkmcnt(0)" ::: "memory")
#define VM_WAIT() asm volatile("s_waitcnt vmcnt(0)" ::: "memory")
namespace pg8 {
#define PG8_LAS __attribute__((address_space(3)))
constexpr int BM = 256, BK = 64, HALF = 128, HTB = HALF * BK * 2  , STAGE_BYTES = 8 * HTB, NXCD = 8, WGM = 8;
__host__ __device__ __forceinline__ int lds_byte(int r, int c) { const int st = (r >> 4) * 2 + (c >> 5), rr = r & 15, cc = c & 31, ob = rr * 64 + cc * 2; return st * 1024 + (ob ^ (((ob >> 9) & 1) << 5)); }
__host__ __device__ __forceinline__ void stage_rc(int b, int& R, int& C) { const int st = b / 1024, sb = b % 1024, swz = sb ^ (((sb >> 9) & 1) << 5); R = (st >> 1) * 16 + swz / 64; C = (st & 1) * 32 + (swz % 64) / 2; }
__host__ __device__ __forceinline__ int perm32(int rho) { const int n = rho >> 4, i = rho & 15; return 8 * (i >> 2) + 4 * n + (i & 3); }

struct Unit { int pm, pn; };
struct Gemm { const bf16_t* A; const bf16_t* Bt; int M, N, K, lda, ldb; };

struct StaticOrder {
    int nM, nN, nwg, G, c;
    __host__ __device__ void init(int M_, int N_, int G_, int c_) { nM = M_ / BM; nN = N_ / BM; nwg = nM * nN; G = G_; c = c_; }
    __host__ __device__ bool next(int i, Unit& u) const {
        const long L = (long)i * G + c; if (L >= nwg) return false;
        int wgid = (int)L; { const int q = nwg / NXCD, r = nwg % NXCD, xcd = wgid % NXCD, off = wgid / NXCD; wgid = (xcd < r ? xcd * (q + 1) : r * (q + 1) + (xcd - r) * q) + off; }
        const int nig = WGM * nN, gid = wgid / nig, fm = gid * WGM, gsz = (nM - fm) < WGM ? (nM - fm) : WGM;
        u.pm = fm + ((wgid % nig) % gsz); u.pn = (wgid % nig) / gsz; return true;
    }
    __device__ __forceinline__ void a_ready(const Unit&) const {}
    __device__ __forceinline__ void done(const Unit&) const {}
};

typedef f32x4 acc_t[2][2][4][2];

__device__ __forceinline__ u32x4 pack8(const f32x4& a, const f32x4& b) { u32x4 w; w.x = pk2(a[0], a[1]); w.y = pk2(a[2], a[3]); w.z = pk2(b[0], b[1]); w.w = pk2(b[2], b[3]); return w; }
__device__ __forceinline__ void unpack8(const u32x4& w, f32x4& a, f32x4& b) { a = (f32x4){bflo(w.x), bfhi(w.x), bflo(w.y), bfhi(w.y)}; b = (f32x4){bflo(w.z), bfhi(w.z), bflo(w.w), bfhi(w.w)}; }

__device__ __forceinline__ float row_rs(const float* ssp, int row) {
    const f32x4* p = (const f32x4*)(ssp + (size_t)row * 16); const f32x4 a = p[0], b = p[1], c = p[2], d = p[3];
    const float s = ((a[0] + a[1]) + (a[2] + a[3])) + ((b[0] + b[1]) + (b[2] + b[3])) + ((c[0] + c[1]) + (c[2] + c[3])) + ((d[0] + d[1]) + (d[2] + d[3]));
    return __builtin_amdgcn_rsqf(s * (1.0f / D) + EPS);
}
struct EpiZ {
    static constexpr bool PERM = true, AFTER_DRAIN = false;
    bf16_t* zps; bf16_t* zqkv; const float* rstd;
    __device__ __forceinline__ void operator()(const acc_t& acc, const Unit& u, int wr, int wc, int fr, int fq) const {
        const int row0 = u.pm * BM + wr * 64 + fr;
        bf16_t* base; int ldc, colt;
        if (u.pn < 4) { base = zps; ldc = 1024; colt = u.pn * BM; } else { base = zqkv; ldc = QKVW; colt = (u.pn - 4) * BM; }
        const int col0 = colt + wc * 32 + 8 * fq;
        float rsv[2][4];
#pragma unroll
        for (int ai = 0; ai < 2; ++ai)
#pragma unroll
            for (int m = 0; m < 4; ++m) rsv[ai][m] = rstd[row0 + ai * HALF + m * 16];
#pragma unroll
        for (int ai = 0; ai < 2; ++ai)
#pragma unroll
            for (int m = 0; m < 4; ++m) { const int row = row0 + ai * HALF + m * 16; const float rs = rsv[ai][m]; bf16_t* rowp = base + (size_t)row * ldc + col0;
#pragma unroll
                for (int bj = 0; bj < 2; ++bj) *(u32x4*)(rowp + bj * HALF) = pack8(acc[ai][bj][m][0] * rs, acc[ai][bj][m][1] * rs); }
    }
};
struct EpiPlain {
    static constexpr bool PERM = true, AFTER_DRAIN = false;
    bf16_t* O; int ldc; const float* ss;
    __device__ __forceinline__ void operator()(const acc_t& acc, const Unit& u, int wr, int wc, int fr, int fq) const {
        const int row0 = u.pm * BM + wr * 64 + fr, col0 = u.pn * BM + wc * 32 + 8 * fq;
        float rsv[2][4];
#pragma unroll
        for (int ai = 0; ai < 2; ++ai)
#pragma unroll
            for (int m = 0; m < 4; ++m) rsv[ai][m] = ss ? row_rs(ss, row0 + ai * HALF + m * 16) : 1.0f;
#pragma unroll
        for (int ai = 0; ai < 2; ++ai)
#pragma unroll
            for (int m = 0; m < 4; ++m) { const int row = row0 + ai * HALF + m * 16; const float rs = rsv[ai][m]; bf16_t* rowp = O + (size_t)row * ldc + col0;
#pragma unroll
                for (int bj = 0; bj < 2; ++bj) *(u32x4*)(rowp + bj * HALF) = pack8(acc[ai][bj][m][0] * rs, acc[ai][bj][m][1] * rs); }
    }
};
struct EpiGlu {
    static constexpr bool PERM = true, AFTER_DRAIN = false;
    bf16_t* O;
    __device__ __forceinline__ void operator()(const acc_t& acc, const Unit& u, int wr, int wc, int fr, int fq) const {
        const int row0 = u.pm * BM + wr * 64 + fr, col0 = u.pn * HALF + wc * 32 + 8 * fq;
#pragma unroll
        for (int ai = 0; ai < 2; ++ai)
#pragma unroll
            for (int m = 0; m < 4; ++m) { const int row = row0 + ai * HALF + m * 16; f32x4 o[2];
#pragma unroll
                for (int n = 0; n < 2; ++n)
#pragma unroll
                    for (int j = 0; j < 4; ++j) o[n][j] = acc[ai][0][m][n][j] * sigmoidf_(acc[ai][1][m][n][j]);
                *(u32x4*)(O + (size_t)row * SSMW + col0) = pack8(o[0], o[1]); }
    }
};
struct EpiGate {
    static constexpr bool PERM = true, AFTER_DRAIN = false;
    bf16_t* S; const float* rstd;
    __device__ __forceinline__ void operator()(const acc_t& acc, const Unit& u, int wr, int wc, int fr, int fq) const {
        const int row0 = u.pm * BM + wr * 64 + fr, col0 = u.pn * BM + wc * 32 + 8 * fq;
        float rsv[2][4];
#pragma unroll
        for (int ai = 0; ai < 2; ++ai)
#pragma unroll
            for (int m = 0; m < 4; ++m) rsv[ai][m] = rstd[row0 + ai * HALF + m * 16];
#pragma unroll
        for (int ai = 0; ai < 2; ++ai)
#pragma unroll
            for (int m = 0; m < 4; ++m) { const int row = row0 + ai * HALF + m * 16; const float rs = rsv[ai][m]; bf16_t* rowp = S + (size_t)row * D + col0;
#pragma unroll
                for (int bj = 0; bj < 2; ++bj) { f32x4 o[2];
#pragma unroll
                    for (int n = 0; n < 2; ++n)
#pragma unroll
                        for (int j = 0; j < 4; ++j) o[n][j] = sigmoidf_(acc[ai][bj][m][n][j] * rs);
                    *(u32x4*)(rowp + bj * HALF) = pack8(o[0], o[1]); } }
    }
};
#if EPI_NT
#define EPI_LD16(p) __builtin_nontemporal_load((const u32x4*)(p))
#else
#define EPI_LD16(p) (*(const u32x4*)(p))
#endif
template <bool FIRST> struct EpiMerge {
    static constexpr bool PERM = true, AFTER_DRAIN = false;
    const bf16_t* S; bf16_t* Mg; float sc;
    __device__ __forceinline__ void operator()(const acc_t& acc, const Unit& u, int wr, int wc, int fr, int fq) const {
        const int row0 = u.pm * BM + wr * 64 + fr, col0 = u.pn * BM + wc * 32 + 8 * fq;
#pragma unroll
        for (int ai = 0; ai < 2; ++ai) {
            u32x4 sv[4][2], gv[4][2];
#pragma unroll
            for (int m = 0; m < 4; ++m) { const size_t off = (size_t)(row0 + ai * HALF + m * 16) * D + col0;
#pragma unroll
                for (int bj = 0; bj < 2; ++bj) { sv[m][bj] = EPI_LD16(S + off + bj * HALF); if (!FIRST) gv[m][bj] = EPI_LD16(Mg + off + bj * HALF); } }
            asm volatile("" ::: "memory");
#pragma unroll
            for (int m = 0; m < 4; ++m) { const size_t off = (size_t)(row0 + ai * HALF + m * 16) * D + col0;
#pragma unroll
                for (int bj = 0; bj < 2; ++bj) { f32x4 s0, s1, g0, g1; unpack8(sv[m][bj], s0, s1);
                    if (FIRST) { g0 = (f32x4){0.f, 0.f, 0.f, 0.f}; g1 = g0; } else unpack8(gv[m][bj], g0, g1);
                    g0 += s0 * acc[ai][bj][m][0] * sc; g1 += s1 * acc[ai][bj][m][1] * sc;
                    *(u32x4*)(Mg + off + bj * HALF) = pack8(g0, g1); } }
            asm volatile("" ::: "memory");
        }
    }
};
struct EpiOut {
    static constexpr bool PERM = false, AFTER_DRAIN = false;
    const float* xin; float* xout; bf16_t* xg; const float* g; float* ss;
    __device__ __forceinline__ void operator()(const acc_t& acc, const Unit& u, int wr, int wc, int fr, int fq) const {
        const int row0 = u.pm * BM + wr * 64 + fr, col0 = u.pn * BM + wc * 32 + 4 * fq;
        f32x4 gv[2][2];
#pragma unroll
        for (int bj = 0; bj < 2; ++bj)
#pragma unroll
            for (int n = 0; n < 2; ++n) gv[bj][n] = *(const f32x4*)(g + col0 + bj * HALF + n * 16);
#pragma unroll
        for (int ai = 0; ai < 2; ++ai)
#pragma unroll
            for (int mh = 0; mh < 2; ++mh) {
                f32x4 xr[2][2][2];
#pragma unroll
                for (int mm = 0; mm < 2; ++mm) { const size_t off = (size_t)(row0 + ai * HALF + (2 * mh + mm) * 16) * D + col0;
#pragma unroll
                    for (int bj = 0; bj < 2; ++bj)
#pragma unroll
                        for (int n = 0; n < 2; ++n) xr[mm][bj][n] = *(const f32x4*)(xin + off + bj * HALF + n * 16); }
                asm volatile("" ::: "memory");
#pragma unroll
                for (int mm = 0; mm < 2; ++mm) { const int m = 2 * mh + mm; const int row = row0 + ai * HALF + m * 16; const size_t off = (size_t)row * D + col0; float sq = 0.f;
#pragma unroll
                    for (int bj = 0; bj < 2; ++bj)
#pragma unroll
                        for (int n = 0; n < 2; ++n) { const f32x4 x1 = xr[mm][bj][n] + acc[ai][bj][m][n];
                            *(f32x4*)(xout + off + bj * HALF + n * 16) = x1; sq += (x1[0] * x1[0] + x1[1] * x1[1]) + (x1[2] * x1[2] + x1[3] * x1[3]);
                            const f32x4 xs = x1 * gv[bj][n]; u32x2 w; w.x = pk2(xs[0], xs[1]); w.y = pk2(xs[2], xs[3]); *(u32x2*)(xg + off + bj * HALF + n * 16) = w; }
                    sq += __shfl_xor(sq, 16); sq += __shfl_xor(sq, 32);
                    if (fq == 0) st_wt(ss + (size_t)row * 16 + u.pn * 4 + wc, sq); }
                asm volatile("" ::: "memory");
            }
    }
};
template <class Epi, class Sched, bool ALIGN_EPI = false, bool SP2 = false>
__device__ __forceinline__ void gemm_phase(PG8_LAS unsigned char* lds, const Gemm g, const Sched& S, const Epi& E) {
    int tid_ = threadIdx.x; asm volatile("" : "+v"(tid_));
    const int tid = tid_, wid = __builtin_amdgcn_readfirstlane(tid >> 6), lane = tid & 63, wr = wid >> 2, wc = wid & 3, fr = lane & 15, fq = lane >> 4;
    const int K = g.K, nt = K / BK, lda = g.lda, ldb = g.ldb;
    unsigned voffA[2], voffB[2];
#pragma unroll
    for (int i = 0; i < 2; ++i) { int R, C; stage_rc(tid * 16 + i * 8192, R, C); const int Rb = Epi::PERM ? ((R & ~31) + perm32(R & 31)) : R;
        voffA[i] = (unsigned)(R * lda + C) * 2u; voffB[i] = (unsigned)(Rb * ldb + C) * 2u; }
    const size_t kstep = (size_t)(BK * 2);
    const size_t hstepA = (size_t)HALF * lda * 2, hstepB = (size_t)HALF * ldb * 2;
    const size_t tstepA = 2 * hstepA, tstepB = 2 * hstepB;
    const unsigned ldsw = (unsigned)wid * 1024u;
    const int aoff = lds_byte(wr * 64 + fr, fq * 8), boff = lds_byte(wc * 32 + fr, fq * 8);
#define PG8_SA(b, h) (((b) * 2 + (h)) * HTB)
#define PG8_SB(b, h) ((4 + (b) * 2 + (h)) * HTB)
#define PG8_STAGE(bufoff, gbase, voff) do { _Pragma("unroll") for (int _i = 0; _i < 2; ++_i) \
        __builtin_amdgcn_global_load_lds((const unsigned*)((const char*)(gbase) + (voff)[_i]), (PG8_LAS unsigned*)(lds + (bufoff) + ldsw + _i * 8192), 16, 0, 0); } while (0)
#define PG8_LDA(dst, b, h) do { _Pragma("unroll") for (int m = 0; m < 4; ++m) _Pragma("unroll") for (int k = 0; k < 2; ++k) dst[m][k] = *(const PG8_LAS bf16x8*)(lds + PG8_SA(b, h) + aoff + m * 2048 + k * 1024); } while (0)
#define PG8_LDB(dst, b, h) do { _Pragma("unroll") for (int n = 0; n < 2; ++n) _Pragma("unroll") for (int k = 0; k < 2; ++k) dst[n][k] = *(const PG8_LAS bf16x8*)(lds + PG8_SB(b, h) + boff + n * 2048 + k * 1024); } while (0)
#define PG8_MMA(ai, bj, At, Bt) do { __builtin_amdgcn_s_setprio(1); _Pragma("unroll") for (int m = 0; m < 4; ++m) _Pragma("unroll") for (int n = 0; n < 2; ++n) _Pragma("unroll") for (int k = 0; k < 2; ++k) \
        acc[ai][bj][m][n] = __builtin_amdgcn_mfma_f32_16x16x32_bf16(Bt[n][k], At[m][k], acc[ai][bj][m][n], 0, 0, 0); __builtin_amdgcn_s_setprio(0); } while (0)
#define PG8_WAIT_V(n) asm volatile("s_waitcnt vmcnt(" #n ")" ::: "memory")
#define PG8_WAIT_L(n) asm volatile("s_waitcnt lgkmcnt(" #n ")" ::: "memory")
#define PG8_BAR __builtin_amdgcn_s_barrier()
#define PG8_SCHED __builtin_amdgcn_sched_barrier(0)
    Unit cur, nxt; int ui = 0;
    if (!S.next(0, cur)) return;
    f32x4 acc[2][2][4][2];
#pragma unroll
    for (int a = 0; a < 2; ++a)
#pragma unroll
        for (int b = 0; b < 2; ++b)
#pragma unroll
            for (int m = 0; m < 4; ++m)
#pragma unroll
                for (int n = 0; n < 2; ++n) acc[a][b][m][n] = (f32x4){0.f, 0.f, 0.f, 0.f};
    bf16x8 At[4][2], B0[2][2], B1[2][2];
    const char* cA = (const char*)g.A + (size_t)cur.pm * tstepA; const char* cB = (const char*)g.Bt + (size_t)cur.pn * tstepB;
    S.a_ready(cur);
    if constexpr (SP2) {
        PG8_STAGE(PG8_SB(0, 0), cB, voffB); PG8_STAGE(PG8_SB(0, 1), cB + hstepB, voffB); PG8_STAGE(PG8_SA(0, 0), cA, voffA); PG8_STAGE(PG8_SA(0, 1), cA + hstepA, voffA);
        if (wr == 1) PG8_BAR;
        PG8_WAIT_V(2); PG8_BAR;
        PG8_STAGE(PG8_SB(1, 0), cB + kstep, voffB); PG8_STAGE(PG8_SA(1, 0), cA + kstep, voffA); PG8_STAGE(PG8_SB(1, 1), cB + hstepB + kstep, voffB);
        PG8_WAIT_V(6); PG8_BAR;
    } else {
        PG8_STAGE(PG8_SB(0, 0), cB, voffB); PG8_STAGE(PG8_SA(0, 0), cA, voffA); PG8_STAGE(PG8_SB(0, 1), cB + hstepB, voffB); PG8_STAGE(PG8_SA(0, 1), cA + hstepA, voffA);
        if (wr == 1) PG8_BAR;
        PG8_WAIT_V(4); PG8_BAR;
        PG8_STAGE(PG8_SB(1, 0), cB + kstep, voffB); PG8_STAGE(PG8_SA(1, 0), cA + kstep, voffA); PG8_STAGE(PG8_SB(1, 1), cB + hstepB + kstep, voffB);
        PG8_WAIT_V(6); PG8_BAR;
    }
    for (;;) {
        const bool has_next = S.next(ui + 1, nxt);
        const char* nA = has_next ? (const char*)g.A + (size_t)nxt.pm * tstepA : cA; const char* nB = has_next ? (const char*)g.Bt + (size_t)nxt.pn * tstepB : cB;
        for (int t = 0; t < nt; t += 2) {
            const bool last = (t == nt - 2);
            const char* a1 = cA + (size_t)(t + 1) * kstep;
            const char* a2 = last ? nA : cA + (size_t)(t + 2) * kstep; const char* b2 = last ? nB : cB + (size_t)(t + 2) * kstep;
            const char* a3 = a2 + kstep; const char* b3 = b2 + kstep;
            if (last && has_next) S.a_ready(nxt);
            if constexpr (SP2) {
            PG8_LDB(B0, 0, 0); PG8_LDB(B1, 0, 1); PG8_SCHED; PG8_LDA(At, 0, 0); PG8_STAGE(PG8_SA(1, 1), a1 + hstepA, voffA);
            PG8_WAIT_V(8); PG8_WAIT_L(0); PG8_BAR; PG8_MMA(0, 0, At, B0); PG8_MMA(0, 1, At, B1); PG8_BAR; PG8_SCHED;
            PG8_LDA(At, 0, 1); PG8_STAGE(PG8_SB(0, 0), b2, voffB); PG8_STAGE(PG8_SB(0, 1), b2 + hstepB, voffB); PG8_STAGE(PG8_SA(0, 0), a2, voffA);
            PG8_WAIT_V(8); PG8_WAIT_L(0); PG8_BAR; PG8_MMA(1, 0, At, B0); PG8_MMA(1, 1, At, B1); PG8_BAR; PG8_SCHED;
            PG8_LDB(B0, 1, 0); PG8_LDB(B1, 1, 1); PG8_SCHED; PG8_LDA(At, 1, 0); PG8_STAGE(PG8_SA(0, 1), a2 + hstepA, voffA);
            PG8_WAIT_V(8); PG8_WAIT_L(0); PG8_BAR; PG8_MMA(0, 0, At, B0); PG8_MMA(0, 1, At, B1); PG8_BAR; PG8_SCHED;
            PG8_LDA(At, 1, 1); PG8_STAGE(PG8_SB(1, 0), b3, voffB); PG8_STAGE(PG8_SB(1, 1), b3 + hstepB, voffB); PG8_STAGE(PG8_SA(1, 0), a3, voffA);
            PG8_WAIT_V(8); PG8_WAIT_L(0); PG8_BAR; PG8_MMA(1, 0, At, B0); PG8_MMA(1, 1, At, B1); PG8_BAR; PG8_SCHED;
            } else {
            PG8_LDB(B0, 0, 0); PG8_SCHED; PG8_LDA(At, 0, 0); PG8_STAGE(PG8_SA(1, 1), a1 + hstepA, voffA);
            PG8_WAIT_L(8); PG8_BAR; PG8_WAIT_L(0); PG8_MMA(0, 0, At, B0); PG8_BAR; PG8_SCHED;
            PG8_LDB(B1, 0, 1); PG8_STAGE(PG8_SB(0, 0), b2, voffB);
            PG8_BAR; PG8_WAIT_L(0); PG8_MMA(0, 1, At, B1); PG8_BAR;
            PG8_LDA(At, 0, 1); PG8_STAGE(PG8_SA(0, 0), a2, voffA);
            PG8_BAR; PG8_WAIT_L(0); PG8_MMA(1, 0, At, B0); PG8_BAR; PG8_SCHED;
            PG8_STAGE(PG8_SB(0, 1), b2 + hstepB, voffB);
            PG8_WAIT_V(6); PG8_BAR; PG8_MMA(1, 1, At, B1); PG8_BAR;
            PG8_LDB(B0, 1, 0); PG8_SCHED; PG8_LDA(At, 1, 0); PG8_STAGE(PG8_SA(0, 1), a2 + hstepA, voffA);
            PG8_WAIT_L(8); PG8_BAR; PG8_WAIT_L(0); PG8_MMA(0, 0, At, B0); PG8_BAR; PG8_SCHED;
            PG8_LDB(B1, 1, 1); PG8_STAGE(PG8_SB(1, 0), b3, voffB);
            PG8_BAR; PG8_WAIT_L(0); PG8_MMA(0, 1, At, B1); PG8_BAR;
            PG8_LDA(At, 1, 1); PG8_STAGE(PG8_SA(1, 0), a3, voffA);
            PG8_BAR; PG8_WAIT_L(0); PG8_MMA(1, 0, At, B0); PG8_BAR; PG8_SCHED;
            PG8_STAGE(PG8_SB(1, 1), b3 + hstepB, voffB);
            PG8_WAIT_V(6); PG8_BAR; PG8_MMA(1, 1, At, B1); PG8_BAR;
            }
        }
        if constexpr (ALIGN_EPI) { if (wr == 0) PG8_BAR; }
        if constexpr (!Epi::AFTER_DRAIN) { E(acc, cur, wr, wc, fr, fq); S.done(cur); }
        if (!has_next) break;
#pragma unroll
        for (int a = 0; a < 2; ++a)
#pragma unroll
            for (int b = 0; b < 2; ++b)
#pragma unroll
                for (int m = 0; m < 4; ++m)
#pragma unroll
                    for (int n = 0; n < 2; ++n) acc[a][b][m][n] = (f32x4){0.f, 0.f, 0.f, 0.f};
        cur = nxt; cA = nA; cB = nB; ++ui;
        if constexpr (ALIGN_EPI) { if (wr == 1) PG8_BAR; }
    }
    PG8_WAIT_V(0);
    if constexpr (!ALIGN_EPI) { if (wr == 0) PG8_BAR; }
    PG8_BAR;
    if constexpr (Epi::AFTER_DRAIN) { E.fused(acc, cur, wr, wc, fr, fq, lds, wid, lane); S.done(cur); }
#undef PG8_SA
#undef PG8_SB
#undef PG8_STAGE
#undef PG8_LDA
#undef PG8_LDB
#undef PG8_MMA
#undef PG8_WAIT_V
#undef PG8_WAIT_L
#undef PG8_BAR
#undef PG8_SCHED
}
}
struct Args { const void* in[26]; float* out; unsigned char* ws; };
enum { I_X = 0, I_POS, I_N1G, I_WIN, I_POOLW, I_POOLS, I_PPROJ, I_ARE, I_AIM, I_LDT, I_BRE, I_BIM, I_CRE, I_CIM, I_SD, I_GLU, I_SPROJ, I_APROJ, I_WOUT, I_N2G, I_WQ, I_K1, I_K2, I_PU, I_PV, I_FG };

struct Ctx {
    int tid, lane, wave, G, bid;
    int gw, ngw;
    int gt, ngt;
    LAS unsigned char* lds;
};

__device__ __forceinline__ void cis_f(float ang, float& c, float& s) {
    const double r = (double)ang * 0.15915494309189535;
    const double fr = r - __builtin_rint(r);
    const float f = (float)fr;
    c = __builtin_amdgcn_cosf(f); s = __builtin_amdgcn_sinf(f);
}

template <class RowMap>
__device__ __forceinline__ void p0_transpose_item(const float* W, int K, int N, bf16_t* WT, RowMap rm, LAS float* scr, int item, int lane) {
    const int nblk = N / 32, kb = item / nblk, nb = item % nblk, k0 = 64 * kb, n0 = 32 * nb;
#pragma unroll 8
    for (int i = 0; i < 32; ++i) { const int kk = 2 * i + (lane >> 5); scr[kk * 33 + (lane & 31)] = W[(size_t)(k0 + kk) * N + n0 + (lane & 31)]; }
    LDS_WAIT(); asm volatile("" ::: "memory");
    const int c = lane & 7;
#pragma unroll
    for (int j = 0; j < 4; ++j) { const int n = (lane >> 3) + 8 * j; const LAS float* s = scr + (8 * c) * 33 + n;
        u32x4 o; o.x = pk2(s[0 * 33], s[1 * 33]); o.y = pk2(s[2 * 33], s[3 * 33]); o.z = pk2(s[4 * 33], s[5 * 33]); o.w = pk2(s[6 * 33], s[7 * 33]);
        *(u32x4*)(WT + (size_t)rm(n0 + n) * K + k0 + 8 * c) = o; }
    LDS_WAIT(); asm volatile("" ::: "memory");
}
struct RmId { __device__ __forceinline__ int operator()(int n) const { return n; } };
struct RmGlu { __device__ __forceinline__ int operator()(int n) const { return 256 * ((n & 511) >> 7) + 128 * (n >> 9) + (n & 127); } };

__device__ __forceinline__ void convert_f16(const Ctx& C, const float* src, unsigned short* dst, size_t n8) {
    for (size_t i = C.gt; i < n8; i += C.ngt) { const f32x4 a = *(const f32x4*)(src + i * 8), b = *(const f32x4*)(src + i * 8 + 4);
        u32x4 o; o.x = pkh2(a[0], a[1]); o.y = pkh2(a[2], a[3]); o.z = pkh2(b[0], b[1]); o.w = pkh2(b[2], b[3]); *(u32x4*)(dst + i * 8) = o; }
}
__device__ __forceinline__ void norm_row(const float* xrow, const float* g, bf16_t* orow, float* rstd_out, int lane) {
    f32x4 v[4]; float s = 0.f;
#pragma unroll
    for (int j = 0; j < 4; ++j) { v[j] = *((const f32x4*)xrow + lane + 64 * j); s += (v[j][0] * v[j][0] + v[j][1] * v[j][1]) + (v[j][2] * v[j][2] + v[j][3] * v[j][3]); }
    s = wave_sum(s);
#pragma unroll
    for (int j = 0; j < 4; ++j) { const f32x4 gg = *((const f32x4*)g + lane + 64 * j); const f32x4 o = v[j] * gg; u32x2 w; w.x = pk2(o[0], o[1]); w.y = pk2(o[2], o[3]); *((u32x2*)orow + lane + 64 * j) = w; }
    if (lane == 0) st_wt(rstd_out, __builtin_amdgcn_rsqf(s * (1.0f / D) + EPS));
}

__device__ __forceinline__ void quant_expert(const float* usrc, const float* vsrc, unsigned char* dst, int e, float* su_out, float* sv_out, int lane) {
    f32x4 u[4], v[4]; float mu = 0.f, mv = 0.f;
#pragma unroll
    for (int j = 0; j < 4; ++j) { u[j] = *((const f32x4*)usrc + 4 * lane + j); v[j] = *((const f32x4*)vsrc + 4 * lane + j);
        mu = fmaxf(mu, fmaxf(fmaxf(fabsf(u[j][0]), fabsf(u[j][1])), fmaxf(fabsf(u[j][2]), fabsf(u[j][3])))); mv = fmaxf(mv, fmaxf(fmaxf(fabsf(v[j][0]), fabsf(v[j][1])), fmaxf(fabsf(v[j][2]), fabsf(v[j][3])))); }
#pragma unroll
    for (int o = 1; o < 64; o <<= 1) { mu = fmaxf(mu, __shfl_xor(mu, o)); mv = fmaxf(mv, __shfl_xor(mv, o)); }
    const float su = fmaxf(mu, 1e-30f) * (PEER_MFMA ? (1.0f / 6.0f) : (1.0f / 7.0f)), iu = 1.0f / su, sv = fmaxf(mv, 1e-30f) * (1.0f / 6.0f), iv = 1.0f / sv;
    unsigned w[4];
#if PEER_MFMA
#pragma unroll
    for (int dd = 0; dd < 2; ++dd) { unsigned t = 0u;
#pragma unroll
        for (int j = 0; j < 8; ++j) { const float x = u[2 * dd + (j >> 2)][j & 3] * iu, ax = fabsf(x);
            const unsigned c = (unsigned)(ax > 0.25f) + (unsigned)(ax > 0.75f) + (unsigned)(ax > 1.25f) + (unsigned)(ax > 1.75f) + (unsigned)(ax > 2.5f) + (unsigned)(ax > 3.5f) + (unsigned)(ax > 5.0f);
            t |= (c | (x < 0.f ? 8u : 0u)) << (4 * j); }
        w[dd] = t; }
#else
#pragma unroll
    for (int dd = 0; dd < 2; ++dd) { unsigned t = 0u;
#pragma unroll
        for (int j = 0; j < 8; ++j) { const float x = u[2 * dd + (j >> 2)][j & 3] * iu; int q = (int)rintf(x); q = q > 7 ? 7 : (q < -7 ? -7 : q); t |= ((unsigned)q & 15u) << (4 * j); }
        w[dd] = t; }
#endif
#pragma unroll
    for (int dd = 0; dd < 2; ++dd) { unsigned t = 0u;
        t = __builtin_amdgcn_cvt_scalef32_pk_fp4_f32(t, v[2 * dd][0] * iv, v[2 * dd][1] * iv, 1.0f, 0); t = __builtin_amdgcn_cvt_scalef32_pk_fp4_f32(t, v[2 * dd][2] * iv, v[2 * dd][3] * iv, 1.0f, 1);
        t = __builtin_amdgcn_cvt_scalef32_pk_fp4_f32(t, v[2 * dd + 1][0] * iv, v[2 * dd + 1][1] * iv, 1.0f, 2); t = __builtin_amdgcn_cvt_scalef32_pk_fp4_f32(t, v[2 * dd + 1][2] * iv, v[2 * dd + 1][3] * iv, 1.0f, 3); w[2 + dd] = t; }
#if PEER_SLICED
    *(u32x2*)(dst + (size_t)(lane >> 3) * MiB + (size_t)e * 64 + (lane & 7) * 8) = (u32x2){w[0], w[1]};
    *((u32x2*)(dst + 16 * MiB + (size_t)e * 512) + lane) = (u32x2){w[2], w[3]};
#elif PEER_MFMA
    *((u32x2*)(dst + (size_t)e * 1024) + lane) = (u32x2){w[0], w[1]};
    *((u32x2*)(dst + (size_t)e * 1024 + 512) + lane) = (u32x2){w[2], w[3]};
#else
    *((u32x4*)(dst + (size_t)e * 1024) + lane) = (u32x4){w[0], w[1], w[2], w[3]};
#endif
    if (lane == 0) { st_wt(su_out, su); st_wt(sv_out, sv); }
}

__device__ __forceinline__ void phase_prologue(const Ctx& C, const Args& a) {
    unsigned char* ws = a.ws;
    LAS float* scr = (LAS float*)(C.lds) + C.wave * (64 * 33);
    constexpr int I_WINI = 16 * 200, I_PP = 8 * 32, I_GL = 8 * 32, I_SP = 8 * 32, I_AP = 4 * 32, I_WO = 16 * 32, I_WQI = 16 * 64, I_LAYER = I_WINI + I_PP + I_GL + I_SP + I_AP + I_WO + I_WQI;
    for (int it = C.gw; it < DEPTH * I_LAYER; it += C.ngw) {
        const int l = it / I_LAYER; int r = it % I_LAYER; unsigned char* wl = ws + WS_W + (size_t)l * W_LAYER;
        if (r < I_WINI) { p0_transpose_item((const float*)a.in[I_WIN] + (size_t)l * D * IN_COLS, D, IN_COLS, (bf16_t*)(wl + WO_WIN), RmId(), scr, r, C.lane); continue; } r -= I_WINI;
        if (r < I_PP) { p0_transpose_item((const float*)a.in[I_PPROJ] + (size_t)l * POOLW * D, POOLW, D, (bf16_t*)(wl + WO_PPROJ), RmId(), scr, r, C.lane); continue; } r -= I_PP;
        if (r < I_GL) { p0_transpose_item((const float*)a.in[I_GLU] + (size_t)l * SSMW * 2 * SSMW, SSMW, 2 * SSMW, (bf16_t*)(wl + WO_GLU), RmGlu(), scr, r, C.lane); continue; } r -= I_GL;
        if (r < I_SP) { p0_transpose_item((const float*)a.in[I_SPROJ] + (size_t)l * SSMW * D, SSMW, D, (bf16_t*)(wl + WO_SPROJ), RmId(), scr, r, C.lane); continue; } r -= I_SP;
        if (r < I_AP) { p0_transpose_item((const float*)a.in[I_APROJ] + (size_t)l * AOUT * D, AOUT, D, (bf16_t*)(wl + WO_APROJ), RmId(), scr, r, C.lane); continue; } r -= I_AP;
        if (r < I_WO) { p0_transpose_item((const float*)a.in[I_WOUT] + (size_t)l * D * D, D, D, (bf16_t*)(wl + WO_WOUT), RmId(), scr, r, C.lane); continue; } r -= I_WO;
        p0_transpose_item((const float*)a.in[I_WQ] + (size_t)l * D * PQ, D, PQ, (bf16_t*)(wl + WO_WQ), RmId(), scr, r, C.lane);
    }
    for (int i = C.gt; i < DEPTH * 512 * 512; i += C.ngt) {
        const int l = i / (512 * 512), r = i % (512 * 512), n = r / 512, k = r % 512, gn = n >> 7, gk = k >> 7;
        float v = 0.f;
        if (gn == gk) v = ((const float*)a.in[I_POOLW])[((size_t)(l * 4 + gn) * 128 + (k & 127)) * 128 + (n & 127)] * ((const float*)a.in[I_POOLS])[l * POOLW + n];
        ((bf16_t*)(ws + WS_W + (size_t)l * W_LAYER + WO_POOL))[r] = (bf16_t)f2bf(v);
    }
    for (int i = C.gt; i < DEPTH * 2 * 128 * 128; i += C.ngt) {
        const int l = i / (2 * 16384), r = i % (2 * 16384), t = r / 16384, e = r % 16384;
        const float v = ((const float*)a.in[t ? I_K2 : I_K1])[(size_t)l * 16384 + e];
        ((bf16_t*)(ws + WS_W + (size_t)l * W_LAYER + (t ? WO_K2 : WO_K1)))[e] = (bf16_t)f2bf(v);
    }
    for (int r = C.gw; r < DEPTH * NEXP; r += C.ngw) { const int l = r / NEXP, e = r % NEXP;
        quant_expert((const float*)a.in[I_PU] + ((size_t)l * NEXP + e) * D, (const float*)a.in[I_PV] + ((size_t)l * NEXP + e) * D, ws + WS_TAB + (size_t)l * TAB_LAYER, e,
                     (float*)(ws + WS_TSC + (size_t)l * 131072) + e, (float*)(ws + WS_TSC + (size_t)l * 131072 + 65536) + e, C.lane); }
    for (int i = C.gt; i < M * 32; i += C.ngt) {
        const int m = i >> 5, f = i & 31;
        const float invf = exp2f(-(float)f * (13.287712379549449f / 32.0f));
        const float ang = (float)((const int*)a.in[I_POS])[m] * invf;
        float c, s; cis_f(ang, c, s);
        ((f32x2*)(ws + WS_ROPE))[i] = (f32x2){c, s};
    }
    for (int i = C.gt; i < DEPTH * SSM_G * SSM_N; i += C.ngt) {
        const int l = i / (SSM_G * SSM_N), gn = i % (SSM_G * SSM_N), g = gn / SSM_N;
        unsigned char* sc = ws + WS_SSMC + (size_t)l * SSMC_LAYER;
        const float dt = expf(((const float*)a.in[I_LDT])[l * SSM_G + g]);
        const float ar = ((const float*)a.in[I_ARE])[i], ai = ((const float*)a.in[I_AIM])[i];
        const float decay = expf(ar * dt); float cc, ss; cis_f(ai * dt, cc, ss);
        const float abr = decay * cc, abi = decay * ss;
        const float den = ar * ar + ai * ai, nr = abr - 1.0f;
        const float kr = (nr * ar + abi * ai) / den, ki = (abi * ar - nr * ai) / den;
        ((f32x2*)sc)[gn] = (f32x2){abr, abi};
        double pr = (double)abr, pi = (double)abi;
#pragma unroll
        for (int q = 0; q < 8; ++q) { const double nr2 = pr * pr - pi * pi, ni2 = 2.0 * pr * pi; pr = nr2; pi = ni2; }
        ((f32x2*)(sc + 16384))[gn] = (f32x2){(float)pr, (float)pi};
        const float* br = (const float*)a.in[I_BRE] + (size_t)i * SSM_P; const float* bi = (const float*)a.in[I_BIM] + (size_t)i * SSM_P;
        f32x2* bb = (f32x2*)(sc + 32768) + (size_t)gn * SSM_P;
#pragma unroll
        for (int q = 0; q < SSM_P; ++q) bb[q] = (f32x2){kr * br[q] - ki * bi[q], kr * bi[q] + ki * br[q]};
    }
    for (int m = C.gw; m < M; m += C.ngw) norm_row((const float*)a.in[I_X] + (size_t)m * D, (const float*)a.in[I_N1G], (bf16_t*)(ws + WS_E) + (size_t)m * D, (float*)(ws + WS_RSTD1) + m, C.lane);
}
constexpr int AT_K_OFF = 0, AT_V_OFF = 32768, AT_VROW = 160, AT_LDS = AT_V_OFF + 256 * AT_VROW;
constexpr float AT_QSCALE = 0.125f * 1.4426950408889634f;

__device__ __forceinline__ void attn_item(const Ctx& C, int it, const bf16_t* zqkv, const f32x2* rope, bf16_t* og, float* lse_out) {
    const int b = it / 768, rem = it % 768, head = rem >> 6, blk = rem & 63;
    const int grp = head >> 2, hs = head & 3, dsh = 2 * grp, dil = 1 << dsh, nbpc = 64 >> dsh, cls = blk / nbpc, nb = blk % nbpc;
    const size_t rowb = (size_t)b * SEQ;
    const int slot0 = 128 * (nb - 1);
    LAS unsigned char* Ks = C.lds + AT_K_OFF; LAS unsigned char* Vs = C.lds + AT_V_OFF;
#pragma unroll
    for (int p = 0; p < 2; ++p) {
        const int e = C.tid + p * NTHREADS, j = e >> 2, c = e & 3, slot = slot0 + j;
        u32x4 o1 = {0u, 0u, 0u, 0u}, o2 = o1;
        if (slot >= 0) {
            const size_t m = rowb + (size_t)slot * dil + cls;
            const bf16_t* kp = zqkv + m * QKVW + AW + head * 64 + 8 * c;
            const u32x4 x1 = *(const u32x4*)kp, x2 = *(const u32x4*)(kp + 32);
            const f32x2* rp = rope + m * 32 + 8 * c;
            unsigned w1[4] = {x1.x, x1.y, x1.z, x1.w}, w2[4] = {x2.x, x2.y, x2.z, x2.w}, r1[4], r2[4];
#pragma unroll
            for (int q = 0; q < 4; ++q) {
                const f32x2 cs0 = rp[2 * q], cs1 = rp[2 * q + 1];
                const float a0 = bflo(w1[q]), a1 = bfhi(w1[q]), b0 = bflo(w2[q]), b1 = bfhi(w2[q]);
                r1[q] = pk2(a0 * cs0[0] - b0 * cs0[1], a1 * cs1[0] - b1 * cs1[1]);
                r2[q] = pk2(b0 * cs0[0] + a0 * cs0[1], b1 * cs1[0] + a1 * cs1[1]);
            }
            o1 = (u32x4){r1[0], r1[1], r1[2], r1[3]}; o2 = (u32x4){r2[0], r2[1], r2[2], r2[3]};
        }
        *(LAS u32x4*)(Ks + j * 128 + ((c ^ (j & 7)) << 4)) = o1;
        *(LAS u32x4*)(Ks + j * 128 + (((c + 4) ^ (j & 7)) << 4)) = o2;
    }
#pragma unroll
    for (int p = 0; p < 4; ++p) {
        const int e = C.tid + p * NTHREADS, j = e >> 3, c = e & 7, slot = slot0 + j;
        u32x4 v = {0u, 0u, 0u, 0u};
        if (slot >= 0) v = *(const u32x4*)(zqkv + (rowb + (size_t)slot * dil + cls) * QKVW + 2 * AW + head * 64 + 8 * c);
        *(LAS u32x4*)(Vs + j * AT_VROW + c * 16) = v;
    }
    const int w = C.wave, ql = C.lane & 15, quad = C.lane >> 4;
    const size_t mq = rowb + (size_t)(128 * nb + 16 * w + ql) * dil + cls;
    bf16x8 qf[2];
    {
        const bf16_t* qp = zqkv + mq * QKVW + head * 64 + 8 * quad;
        const u32x4 x1 = *(const u32x4*)qp, x2 = *(const u32x4*)(qp + 32);
        const f32x2* rp = rope + mq * 32 + 8 * quad;
        unsigned w1[4] = {x1.x, x1.y, x1.z, x1.w}, w2[4] = {x2.x, x2.y, x2.z, x2.w}, r1[4], r2[4];
#pragma unroll
        for (int q = 0; q < 4; ++q) {
            const f32x2 cs0 = rp[2 * q] * AT_QSCALE, cs1 = rp[2 * q + 1] * AT_QSCALE;
            const float a0 = bflo(w1[q]), a1 = bfhi(w1[q]), b0 = bflo(w2[q]), b1 = bfhi(w2[q]);
            r1[q] = pk2(a0 * cs0[0] - b0 * cs0[1], a1 * cs1[0] - b1 * cs1[1]);
            r2[q] = pk2(b0 * cs0[0] + a0 * cs0[1], b1 * cs1[0] + a1 * cs1[1]);
        }
        qf[0] = __builtin_bit_cast(bf16x8, (u32x4){r1[0], r1[1], r1[2], r1[3]}); qf[1] = __builtin_bit_cast(bf16x8, (u32x4){r2[0], r2[1], r2[2], r2[3]});
    }
    __syncthreads();
    f32x4 st[9];
#pragma unroll
    for (int r = 0; r < 9; ++r) {
        const int row = 16 * (w + r) + ql;
        f32x4 acc = {0.f, 0.f, 0.f, 0.f};
#pragma unroll
        for (int kk = 0; kk < 2; ++kk) {
            const bf16x8 kf = *(const LAS bf16x8*)(Ks + row * 128 + (((4 * kk + quad) ^ (row & 7)) << 4));
            acc = __builtin_amdgcn_mfma_f32_16x16x32_bf16(kf, qf[kk], acc, 0, 0, 0);
        }
        st[r] = acc;
    }
    const float NEG = -INFINITY;
    float mx = NEG;
#pragma unroll
    for (int r = 0; r < 9; ++r)
#pragma unroll
        for (int i = 0; i < 4; ++i) {
            bool ok = true;
            if (r == 0) ok = (4 * quad + i >= ql);
            if (r == 8) ok = (4 * quad + i <= ql);
            if (nb == 0 && (w + r) < 8) ok = false;
            st[r][i] = ok ? st[r][i] : NEG;
            mx = fmaxf(mx, st[r][i]);
        }
    mx = fmaxf(mx, __shfl_xor(mx, 16)); mx = fmaxf(mx, __shfl_xor(mx, 32));
    float den = 0.f;
#pragma unroll
    for (int r = 0; r < 9; ++r)
#pragma unroll
        for (int i = 0; i < 4; ++i) { const float p = fast_exp2(st[r][i] - mx); st[r][i] = p; den += p; }
    den += __shfl_xor(den, 16); den += __shfl_xor(den, 32);
    f32x4 o[4];
#pragma unroll
    for (int mb = 0; mb < 4; ++mb) o[mb] = (f32x4){0.f, 0.f, 0.f, 0.f};
    const int li = C.lane & 15, trr = li >> 2, trc = li & 3;
#pragma unroll
    for (int jj = 0; jj < 5; ++jj) {
        u32x4 pw; pw.x = pk2(st[2 * jj][0], st[2 * jj][1]); pw.y = pk2(st[2 * jj][2], st[2 * jj][3]);
        if (jj < 4) { pw.z = pk2(st[2 * jj + 1][0], st[2 * jj + 1][1]); pw.w = pk2(st[2 * jj + 1][2], st[2 * jj + 1][3]); } else { pw.z = 0u; pw.w = 0u; }
        const bf16x8 pf = __builtin_bit_cast(bf16x8, pw);
        const int jb1 = w + 2 * jj; int jb2 = jb1 + 1; jb2 = jb2 > 15 ? 15 : jb2;
        const int row1 = 16 * jb1 + 4 * quad + trr, row2 = 16 * jb2 + 4 * quad + trr;
#pragma unroll
        for (int mb = 0; mb < 4; ++mb) {
            const v4i16_t lo = __builtin_amdgcn_ds_read_tr16_b64_v4i16((LAS v4i16_t*)(Vs + row1 * AT_VROW + (16 * mb + 4 * trc) * 2));
            const v4i16_t hi = __builtin_amdgcn_ds_read_tr16_b64_v4i16((LAS v4i16_t*)(Vs + row2 * AT_VROW + (16 * mb + 4 * trc) * 2));
            const bf16x8 vf = {lo[0], lo[1], lo[2], lo[3], hi[0], hi[1], hi[2], hi[3]};
            o[mb] = __builtin_amdgcn_mfma_f32_16x16x32_bf16(vf, pf, o[mb], 0, 0, 0);
        }
    }
    const float rden = 1.0f / den;
    bf16_t* op = og + ((size_t)grp * M + mq) * AOUT + hs * 64 + 4 * quad;
#pragma unroll
    for (int mb = 0; mb < 4; ++mb) { u32x2 wv; wv.x = pk2(o[mb][0] * rden, o[mb][1] * rden); wv.y = pk2(o[mb][2] * rden, o[mb][3] * rden); *(u32x2*)(op + 16 * mb) = wv; }
    if (quad == 0) st_wt(lse_out + ((size_t)grp * M + mq) * 4 + hs, (mx + __builtin_amdgcn_logf(den)) * 0.6931471805599453f);
    __syncthreads();
}
typedef float f32x16 __attribute__((ext_vector_type(16)));
constexpr int SS_TILE = 32 * 256;
__device__ __forceinline__ void cstep(float& sr, float& si, float ar, float ai, float xr, float xi) { const float nr = fmaf(ar, sr, fmaf(-ai, si, xr)), ni = fmaf(ar, si, fmaf(ai, sr, xi)); sr = nr; si = ni; }
template <bool OUT>
__device__ __forceinline__ void ssm_item(const Ctx& C, int it, const bf16_t* zps, const unsigned char* sc, f32x2* send, const float* cre, const float* cim, const float* dsk, bf16_t* ssmy) {
    const int b = it / (NCH * SSM_G), rem = it % (NCH * SSM_G), c = rem / SSM_G, g = rem % SSM_G;
    const int lane = C.lane, n = lane & 31, hi = lane >> 5, tl = lane & 15, quad = lane >> 4;
    const f32x2 ab0 = ((const f32x2*)sc)[g * SSM_N + n], ab1 = ((const f32x2*)sc)[g * SSM_N + 32 + n];
    bf16x8 bfr[4];
    { const f32x4* p0 = (const f32x4*)(sc + 32768) + (size_t)(g * SSM_N + n) * 8 + 4 * hi; const f32x4* p1 = (const f32x4*)(sc + 32768) + (size_t)(g * SSM_N + 32 + n) * 8 + 4 * hi;
      const f32x4 a0 = p0[0], a1 = p0[1], a2 = p0[2], a3 = p0[3], c0 = p1[0], c1 = p1[1], c2 = p1[2], c3 = p1[3];
      bfr[0] = __builtin_bit_cast(bf16x8, (u32x4){pk2(a0[0], a0[2]), pk2(a1[0], a1[2]), pk2(a2[0], a2[2]), pk2(a3[0], a3[2])});
      bfr[2] = __builtin_bit_cast(bf16x8, (u32x4){pk2(a0[1], a0[3]), pk2(a1[1], a1[3]), pk2(a2[1], a2[3]), pk2(a3[1], a3[3])});
      bfr[1] = __builtin_bit_cast(bf16x8, (u32x4){pk2(c0[0], c0[2]), pk2(c1[0], c1[2]), pk2(c2[0], c2[2]), pk2(c3[0], c3[2])});
      bfr[3] = __builtin_bit_cast(bf16x8, (u32x4){pk2(c0[1], c0[3]), pk2(c1[1], c1[3]), pk2(c2[1], c2[3]), pk2(c3[1], c3[3])}); }
    float s0r = 0.f, s0i = 0.f, s1r = 0.f, s1i = 0.f;
    float p0r = ab0[0], p0i = ab0[1], p1r = ab1[0], p1i = ab1[1];
    if (!OUT) {
#pragma unroll
        for (int q = 0; q < 4; ++q) { const float t0 = p0r * p0r - p0i * p0i, t1 = 2.f * p0r * p0i, t2 = p1r * p1r - p1i * p1i, t3 = 2.f * p1r * p1i; p0r = t0; p0i = t1; p1r = t2; p1i = t3; }
    }
    bf16x8 cf[4]; float dq[4];
    LAS unsigned char* tile = C.lds + C.wave * SS_TILE;
    if (OUT) {
        const f32x2 aC0 = ((const f32x2*)(sc + 16384))[g * SSM_N + n], aC1 = ((const f32x2*)(sc + 16384))[g * SSM_N + 32 + n];
        const f32x2* sp = send + ((size_t)(b * NCH) * SSM_G + g) * SSM_N + n;
        f32x2 sv0[NCH], sv1[NCH];
#pragma unroll
        for (int k = 0; k < NCH; ++k) { const int kc = k < c ? k : 0; sv0[k] = sp[(size_t)kc * SSM_G * SSM_N]; sv1[k] = sp[(size_t)kc * SSM_G * SSM_N + 32]; }
#pragma unroll
        for (int k = 0; k < NCH; ++k) if (k < c) { cstep(s0r, s0i, aC0[0], aC0[1], sv0[k][0], sv0[k][1]); cstep(s1r, s1i, aC1[0], aC1[1], sv1[k][0], sv1[k][1]); }
        const float* crp = cre + ((size_t)g * SSM_P + tl) * SSM_N; const float* cip = cim + ((size_t)g * SSM_P + tl) * SSM_N;
#pragma unroll
        for (int kk = 0; kk < 4; ++kk) { const float* src = (kk < 2 ? crp : cip) + (kk & 1) * 32 + 8 * quad; const float sg = kk < 2 ? 1.f : -1.f;
            const f32x4 a = *(const f32x4*)src * sg, bq = *(const f32x4*)(src + 4) * sg;
            cf[kk] = __builtin_bit_cast(bf16x8, (u32x4){pk2(a[0], a[1]), pk2(a[2], a[3]), pk2(bq[0], bq[1]), pk2(bq[2], bq[3])}); }
#pragma unroll
        for (int i = 0; i < 4; ++i) dq[i] = dsk[g * SSM_P + 4 * quad + i];
    }
    const size_t m0 = (size_t)b * SEQ + (size_t)c * CH;
    const int tau = 16 * ((n >> 2) & 1) + (n & 3) + 4 * (n >> 3);
    const bf16_t* up = zps + (m0 + tau) * 1024 + POOLW + g * SSM_P + 8 * hi;
    const bf16_t* ue = zps + (m0 + tl) * 1024 + POOLW + g * SSM_P + 4 * quad;
    bf16x8 ua = *(const bf16x8*)up;
    u32x2 ue0 = {0u, 0u}, ue1 = {0u, 0u};
    if (OUT) { ue0 = *(const u32x2*)ue; ue1 = *(const u32x2*)(ue + 16 * 1024); }
    for (int blk = 0; blk < CH / 32; ++blk) {
        const bf16x8 ucur = ua; const u32x2 uc0 = ue0, uc1 = ue1;
        if (blk + 1 < CH / 32) { ua = *(const bf16x8*)(up + (size_t)(blk + 1) * 32 * 1024); if (OUT) { ue0 = *(const u32x2*)(ue + (size_t)(blk + 1) * 32 * 1024); ue1 = *(const u32x2*)(ue + (size_t)((blk + 1) * 32 + 16) * 1024); } }
        f32x16 xr0 = {}, xr1 = {}, xi0 = {}, xi1 = {};
        xr0 = __builtin_amdgcn_mfma_f32_32x32x16_bf16(ucur, bfr[0], xr0, 0, 0, 0);
        xr1 = __builtin_amdgcn_mfma_f32_32x32x16_bf16(ucur, bfr[1], xr1, 0, 0, 0);
        xi0 = __builtin_amdgcn_mfma_f32_32x32x16_bf16(ucur, bfr[2], xi0, 0, 0, 0);
        xi1 = __builtin_amdgcn_mfma_f32_32x32x16_bf16(ucur, bfr[3], xi1, 0, 0, 0);
        float e0r = hi ? 0.f : s0r, e0i = hi ? 0.f : s0i, e1r = hi ? 0.f : s1r, e1i = hi ? 0.f : s1i;
#pragma unroll
        for (int r = 0; r < 16; ++r) { cstep(e0r, e0i, ab0[0], ab0[1], xr0[r], xi0[r]); cstep(e1r, e1i, ab1[0], ab1[1], xr1[r], xi1[r]); }
        const float q0r = __shfl_xor(e0r, 32), q0i = __shfl_xor(e0i, 32), q1r = __shfl_xor(e1r, 32), q1i = __shfl_xor(e1i, 32);
        if (!OUT) {
            float f0r = e0r, f0i = e0i, f1r = e1r, f1i = e1i;
            { const float nr = fmaf(p0r, q0r, fmaf(-p0i, q0i, f0r)), ni = fmaf(p0r, q0i, fmaf(p0i, q0r, f0i)); f0r = nr; f0i = ni; }
            { const float nr = fmaf(p1r, q1r, fmaf(-p1i, q1i, f1r)), ni = fmaf(p1r, q1i, fmaf(p1i, q1r, f1i)); f1r = nr; f1i = ni; }
            const float g0r = __shfl_xor(f0r, 32), g0i = __shfl_xor(f0i, 32), g1r = __shfl_xor(f1r, 32), g1i = __shfl_xor(f1i, 32);
            s0r = hi ? f0r : g0r; s0i = hi ? f0i : g0i; s1r = hi ? f1r : g1r; s1i = hi ? f1i : g1i;
        } else {
            float t0r = hi ? q0r : s0r, t0i = hi ? q0i : s0i, t1r = hi ? q1r : s1r, t1i = hi ? q1i : s1i;
#pragma unroll
            for (int r = 0; r < 16; ++r) { cstep(t0r, t0i, ab0[0], ab0[1], xr0[r], xi0[r]); xr0[r] = t0r; xi0[r] = t0i; cstep(t1r, t1i, ab1[0], ab1[1], xr1[r], xi1[r]); xr1[r] = t1r; xi1[r] = t1i; }
            const float g0r = __shfl_xor(t0r, 32), g0i = __shfl_xor(t0i, 32), g1r = __shfl_xor(t1r, 32), g1i = __shfl_xor(t1i, 32);
            s0r = hi ? t0r : g0r; s0i = hi ? t0i : g0i; s1r = hi ? t1r : g1r; s1i = hi ? t1i : g1i;
#pragma unroll
            for (int r = 0; r < 16; ++r) { LAS unsigned char* rowp = tile + (16 * hi + r) * 256 + (n & 7) * 2; const int cb = n >> 3;
                const unsigned wre = pk2(xr0[r], xr1[r]), wim = pk2(xi0[r], xi1[r]);
                *(LAS bf16_t*)(rowp + (((cb) ^ r) << 4)) = (bf16_t)(wre & 0xffffu); *(LAS bf16_t*)(rowp + (((cb + 4) ^ r) << 4)) = (bf16_t)(wre >> 16);
                *(LAS bf16_t*)(rowp + (((cb + 8) ^ r) << 4)) = (bf16_t)(wim & 0xffffu); *(LAS bf16_t*)(rowp + (((cb + 12) ^ r) << 4)) = (bf16_t)(wim >> 16); }
            LDS_WAIT(); asm volatile("" ::: "memory");
#pragma unroll
            for (int h2 = 0; h2 < 2; ++h2) {
                f32x4 y = {0.f, 0.f, 0.f, 0.f};
#pragma unroll
                for (int kk = 0; kk < 4; ++kk) { const bf16x8 sf = *(const LAS bf16x8*)(tile + (16 * h2 + tl) * 256 + (((4 * kk + quad) ^ tl) << 4)); y = __builtin_amdgcn_mfma_f32_16x16x32_bf16(cf[kk], sf, y, 0, 0, 0); }
                const size_t m = m0 + 32 * blk + 16 * h2 + tl;
                const u32x2 uu = h2 ? uc1 : uc0;
                const float uf[4] = {bflo(uu.x), bfhi(uu.x), bflo(uu.y), bfhi(uu.y)};
                float o[4];
#pragma unroll
                for (int i = 0; i < 4; ++i) o[i] = gelu_tanh(y[i] + dq[i] * uf[i]);
                u32x2 wv; wv.x = pk2(o[0], o[1]); wv.y = pk2(o[2], o[3]);
                *(u32x2*)(ssmy + m * SSMW + g * SSM_P + 4 * quad) = wv;
            }
            LDS_WAIT(); asm volatile("" ::: "memory");
        }
    }
    if (!OUT && hi == 0) { f32x2* dst = send + (((size_t)b * NCH + c) * SSM_G + g) * SSM_N + n; dst[0] = (f32x2){s0r, s0i}; dst[32] = (f32x2){s1r, s1i}; }
}

__device__ __forceinline__ void pool_items(const Ctx& C, const bf16_t* zps, bf16_t* pooled) {
    for (int i = C.gt; i < M * 64; i += C.ngt) {
        const int m = i >> 6, c = i & 63, gi = c >> 4, win = 2 << gi, t = m & (SEQ - 1), cnt = (t + 1) < win ? (t + 1) : win;
        u32x4 v[16];
#pragma unroll
        for (int k = 0; k < 16; ++k) { v[k] = (u32x4){0u, 0u, 0u, 0u}; if (k < cnt) v[k] = *(const u32x4*)(zps + (size_t)(m - k) * 1024 + 8 * c); }
        float acc[8];
#pragma unroll
        for (int e = 0; e < 8; ++e) acc[e] = 0.f;
#pragma unroll
        for (int k = 0; k < 16; ++k) { acc[0] += bflo(v[k].x); acc[1] += bfhi(v[k].x); acc[2] += bflo(v[k].y); acc[3] += bfhi(v[k].y); acc[4] += bflo(v[k].z); acc[5] += bfhi(v[k].z); acc[6] += bflo(v[k].w); acc[7] += bfhi(v[k].w); }
        const float inv = 1.0f / (float)cnt; const u32x4 cur = v[0];
        u32x4 o; o.x = pk2(acc[0] * inv - bflo(cur.x), acc[1] * inv - bfhi(cur.x)); o.y = pk2(acc[2] * inv - bflo(cur.y), acc[3] * inv - bfhi(cur.y));
        o.z = pk2(acc[4] * inv - bflo(cur.z), acc[5] * inv - bfhi(cur.z)); o.w = pk2(acc[6] * inv - bflo(cur.w), acc[7] * inv - bfhi(cur.w));
        *(u32x4*)(pooled + (size_t)m * POOLW + 8 * c) = o;
    }
}
__device__ __forceinline__ void attn_merge_items(const Ctx& C, const bf16_t* og, const float* lse, bf16_t* attn) {
    for (int i = C.gt; i < M * 32; i += C.ngt) {
        const int m = i >> 5, c = i & 31, hs = c >> 3;
        const float l0 = lse[((size_t)0 * M + m) * 4 + hs], l1 = lse[((size_t)1 * M + m) * 4 + hs], l2 = lse[((size_t)2 * M + m) * 4 + hs];
        const float mx = fmaxf(l0, fmaxf(l1, l2));
        float w0 = __expf(l0 - mx), w1 = __expf(l1 - mx), w2 = __expf(l2 - mx); const float inv = 1.0f / (w0 + w1 + w2); w0 *= inv; w1 *= inv; w2 *= inv;
        const u32x4 a = *(const u32x4*)(og + ((size_t)0 * M + m) * AOUT + 8 * c), bq = *(const u32x4*)(og + ((size_t)1 * M + m) * AOUT + 8 * c), cq = *(const u32x4*)(og + ((size_t)2 * M + m) * AOUT + 8 * c);
        u32x4 o;
        o.x = pk2(w0 * bflo(a.x) + w1 * bflo(bq.x) + w2 * bflo(cq.x), w0 * bfhi(a.x) + w1 * bfhi(bq.x) + w2 * bfhi(cq.x));
        o.y = pk2(w0 * bflo(a.y) + w1 * bflo(bq.y) + w2 * bflo(cq.y), w0 * bfhi(a.y) + w1 * bfhi(bq.y) + w2 * bfhi(cq.y));
        o.z = pk2(w0 * bflo(a.z) + w1 * bflo(bq.z) + w2 * bflo(cq.z), w0 * bfhi(a.z) + w1 * bfhi(bq.z) + w2 * bfhi(cq.z));
        o.w = pk2(w0 * bflo(a.w) + w1 * bflo(bq.w) + w2 * bflo(cq.w), w0 * bfhi(a.w) + w1 * bfhi(bq.w) + w2 * bfhi(cq.w));
        *(u32x4*)(attn + (size_t)m * AOUT + 8 * c) = o;
    }
}
constexpr int TK_KEYS = 65536, TK_CIJ = TK_KEYS, TK_WSCR = TK_KEYS + 256, TK_LDS = TK_WSCR + 8 * 1024;
__device__ __forceinline__ void topk_stage_keys(const Ctx& C, const bf16_t* k1, const bf16_t* k2) {
#pragma unroll
    for (int p = 0; p < 8; ++p) { const int e = C.tid + p * NTHREADS, tab = e >> 11, row = (e >> 4) & 127, ch = e & 15;
        const u32x4 v = *(const u32x4*)((tab ? k2 : k1) + row * 128 + ch * 8);
        *(LAS u32x4*)(C.lds + tab * 32768 + row * 256 + ((ch ^ (row & 15)) << 4)) = v; }
    if (C.tid < 64) { int c = C.tid, i = 0, j = 0, found = 0, cnt = 0;
        for (int ii = 0; ii < 16; ++ii) for (int jj = 0; jj < 16; ++jj) if ((ii + 1) * (jj + 1) <= 16) { if (cnt == c) { i = ii; j = jj; found = 1; } ++cnt; }
        *(LAS unsigned char*)(C.lds + TK_CIJ + c) = (unsigned char)(found ? ((i << 4) | j) : 0); }
}
template <int N> __device__ __forceinline__ void bitonic_sort_desc(float (&a)[N]) {
#pragma unroll
    for (int k = 2; k <= N; k <<= 1)
#pragma unroll
        for (int j = k >> 1; j > 0; j >>= 1)
#pragma unroll
            for (int i = 0; i < N; ++i) { const int l = i ^ j; if (l > i) { const bool desc = (i & k) == 0; const float hi = fmaxf(a[i], a[l]), lo = fminf(a[i], a[l]); a[i] = desc ? hi : lo; a[l] = desc ? lo : hi; } }
}
template <int N> __device__ __forceinline__ void bitonic_merge_desc(float (&a)[N]) {
#pragma unroll
    for (int j = N >> 1; j > 0; j >>= 1)
#pragma unroll
        for (int i = 0; i < N; ++i) { const int l = i ^ j; if (l > i) { const float hi = fmaxf(a[i], a[l]), lo = fminf(a[i], a[l]); a[i] = hi; a[l] = lo; } }
}
__device__ __forceinline__ void merge_lanes16(float (&top)[16], int mask) {
    float c[16];
#pragma unroll
    for (int i = 0; i < 16; ++i) c[i] = fmaxf(top[i], __shfl_xor(top[15 - i], mask));
    bitonic_merge_desc<16>(c);
#pragma unroll
    for (int i = 0; i < 16; ++i) top[i] = c[i];
}
__device__ __forceinline__ void topk_table(const Ctx& C, int tab, const bf16_t* qrow  , float (&top)[16]) {
    const int tl = C.lane & 15, quad = C.lane >> 4;
    bf16x8 qf[4];
#pragma unroll
    for (int kk = 0; kk < 4; ++kk) qf[kk] = *(const bf16x8*)(qrow + 32 * kk + 8 * quad);
    float v[32];
#pragma unroll
    for (int mb = 0; mb < 8; ++mb) {
        f32x4 acc = {0.f, 0.f, 0.f, 0.f}; const int row = 16 * mb + tl;
#pragma unroll
        for (int kk = 0; kk < 4; ++kk) { const bf16x8 kf = *(const LAS bf16x8*)(C.lds + tab * 32768 + row * 256 + (((4 * kk + quad) ^ (row & 15)) << 4));
            acc = __builtin_amdgcn_mfma_f32_16x16x32_bf16(kf, qf[kk], acc, 0, 0, 0); }
#pragma unroll
        for (int i = 0; i < 4; ++i) { const float sc_ = acc[i]; v[4 * mb + i] = bitsf((fbits(sc_) & ~127u) | (unsigned)(16 * mb + 4 * quad + i)); }
    }
    bitonic_sort_desc<32>(v);
#pragma unroll
    for (int i = 0; i < 16; ++i) top[i] = v[i];
    merge_lanes16(top, 16); merge_lanes16(top, 32);
}

__device__ __forceinline__ void topk_item(const Ctx& C, int it, const bf16_t* qbuf, int* idx, float* gate) {
    const int tg = it >> 3, h = it & 7, tl = C.lane & 15, quad = C.lane >> 4;
    const size_t m = (size_t)16 * tg + tl;
    float t1[16], t2[16];
    topk_table(C, 0, qbuf + m * PQ + h * 256, t1);
    __builtin_amdgcn_sched_barrier(0);
    topk_table(C, 1, qbuf + m * PQ + h * 256 + 128, t2);
    __builtin_amdgcn_sched_barrier(0);
    constexpr int CI[50] = {0,0,0,0,0,0,0,0,0,0,0,0,0,0,0,0,1,1,1,1,1,1,1,1,2,2,2,2,2,3,3,3,3,4,4,4,5,5,6,6,7,7,8,9,10,11,12,13,14,15};
    constexpr int CJ[50] = {0,1,2,3,4,5,6,7,8,9,10,11,12,13,14,15,0,1,2,3,4,5,6,7,0,1,2,3,4,0,1,2,3,0,1,2,0,1,0,1,0,1,0,0,0,0,0,0,0,0};
    float c1[16], c2[16];
#pragma unroll
    for (int i = 0; i < 16; ++i) { c1[i] = bitsf(fbits(t1[i]) & ~127u); c2[i] = bitsf(fbits(t2[i]) & ~127u); }
    LAS unsigned char* wscr = C.lds + TK_WSCR + C.wave * 1024 + tl * 32;
    {
        unsigned p1 = 0u, p2 = 0u;
#pragma unroll
        for (int i = 0; i < 4; ++i) { const unsigned a = quad == 0 ? fbits(t1[i]) : quad == 1 ? fbits(t1[4 + i]) : quad == 2 ? fbits(t1[8 + i]) : fbits(t1[12 + i]);
            const unsigned b = quad == 0 ? fbits(t2[i]) : quad == 1 ? fbits(t2[4 + i]) : quad == 2 ? fbits(t2[8 + i]) : fbits(t2[12 + i]);
            p1 |= (a & 127u) << (8 * i); p2 |= (b & 127u) << (8 * i); }
        *(LAS unsigned*)(wscr + 4 * quad) = p1; *(LAS unsigned*)(wscr + 16 + 4 * quad) = p2;
    }
    float cv[16];
#pragma unroll
    for (int s = 0; s < 16; ++s) {
        float vv = -INFINITY;
        if (s < 13) {
#pragma unroll
            for (int qd = 0; qd < 4; ++qd) { const int c = 4 * s + qd;
                if (c < 50) { const float sum = c1[CI[c < 50 ? c : 0]] + c2[CJ[c < 50 ? c : 0]];
                    const float pv = bitsf((fbits(sum) & ~63u) | (unsigned)c);
                    if (quad == qd) vv = pv; } } }
        cv[s] = vv;
    }
    bitonic_sort_desc<16>(cv);
    merge_lanes16(cv, 16); merge_lanes16(cv, 32);
    float ex[16], sum = 0.f;
#pragma unroll
    for (int r = 0; r < 16; ++r) { ex[r] = __expf(cv[r] - cv[0]); sum += ex[r]; }
    const float inv = 1.0f / sum;
    int oe[4]; float og_[4];
#pragma unroll
    for (int i = 0; i < 4; ++i) {
        const float rvv = quad == 0 ? cv[i] : quad == 1 ? cv[4 + i] : quad == 2 ? cv[8 + i] : cv[12 + i];
        og_[i] = (quad == 0 ? ex[i] : quad == 1 ? ex[4 + i] : quad == 2 ? ex[8 + i] : ex[12 + i]) * inv;
        const unsigned c = fbits(rvv) & 63u;
        const unsigned ij = *(const LAS unsigned char*)(C.lds + TK_CIJ + c);
        const unsigned e1 = *(const LAS unsigned char*)(wscr + (ij >> 4)), e2 = *(const LAS unsigned char*)(wscr + 16 + (ij & 15u));
        oe[i] = (int)((e1 * NKEYS + e2) & (NEXP - 1));
    }
    *(int4*)(idx + m * 128 + h * 16 + 4 * quad) = make_int4(oe[0], oe[1], oe[2], oe[3]);
    *(f32x4*)(gate + m * 128 + h * 16 + 4 * quad) = (f32x4){og_[0], og_[1], og_[2], og_[3]};
}
#if TAB_BITS == 8
typedef u32x4 tabv_t;
#else
typedef u32x2 tabv_t;
#endif
constexpr int TABROW = D * TAB_BITS / 8;
__device__ __forceinline__ void peer_load8(const unsigned char* tab, int e0, int e1, int kbase, int lane, tabv_t (&buf)[8]) {
#pragma unroll
    for (int e = 0; e < 8; ++e) { const int k = kbase + e; const int ex = __builtin_amdgcn_readlane(k < 64 ? e0 : e1, k & 63);
        buf[e] = *((const tabv_t*)(tab + (size_t)ex * TABROW) + lane); }
}
__device__ __forceinline__ float dot16(const tabv_t& a, const unsigned (&hh)[8]) {
    float d = 0.f;
#if TAB_BITS == 8
    const unsigned w[4] = {a.x, a.y, a.z, a.w};
#pragma unroll
    for (int q = 0; q < 4; ++q) {
        d = __builtin_amdgcn_fdot2(__builtin_amdgcn_cvt_scalef32_pk_f16_fp8(w[q], 1.0f, false), as_h2(hh[2 * q]), d, false);
        d = __builtin_amdgcn_fdot2(__builtin_amdgcn_cvt_scalef32_pk_f16_fp8(w[q], 1.0f, true), as_h2(hh[2 * q + 1]), d, false);
    }
#else
    const unsigned w[2] = {a.x, a.y};
#pragma unroll
    for (int dd = 0; dd < 2; ++dd) {
        d = __builtin_amdgcn_fdot2(__builtin_amdgcn_cvt_scalef32_pk_f16_fp4(w[dd], 1.0f, 0), as_h2(hh[4 * dd + 0]), d, false);
        d = __builtin_amdgcn_fdot2(__builtin_amdgcn_cvt_scalef32_pk_f16_fp4(w[dd], 1.0f, 1), as_h2(hh[4 * dd + 1]), d, false);
        d = __builtin_amdgcn_fdot2(__builtin_amdgcn_cvt_scalef32_pk_f16_fp4(w[dd], 1.0f, 2), as_h2(hh[4 * dd + 2]), d, false);
        d = __builtin_amdgcn_fdot2(__builtin_amdgcn_cvt_scalef32_pk_f16_fp4(w[dd], 1.0f, 3), as_h2(hh[4 * dd + 3]), d, false);
    }
#endif
    return d;
}
__device__ __forceinline__ float reduce8(const float (&d)[8], int lane) {
    const bool b5 = lane & 32, b4 = lane & 16, b3 = lane & 8;
    float r4[4];
#pragma unroll
    for (int i = 0; i < 4; ++i) { const float keep = b5 ? d[4 + i] : d[i], send = b5 ? d[i] : d[4 + i]; r4[i] = keep + __shfl_xor(send, 32); }
    float r2[2];
#pragma unroll
    for (int i = 0; i < 2; ++i) { const float keep = b4 ? r4[2 + i] : r4[i], send = b4 ? r4[i] : r4[2 + i]; r2[i] = keep + __shfl_xor(send, 16); }
    float r1; { const float keep = b3 ? r2[1] : r2[0], send = b3 ? r2[0] : r2[1]; r1 = keep + __shfl_xor(send, 8); }
    r1 += __shfl_xor(r1, 4); r1 += __shfl_xor(r1, 2); r1 += __shfl_xor(r1, 1);
    return r1;
}
#if TAB_BITS == 4
__device__ __forceinline__ int idot16(const tabv_t& a, const unsigned (&hq)[4]) {
    const int s_hi = __builtin_amdgcn_sdot8((int)a.y, (int)hq[1], __builtin_amdgcn_sdot8((int)a.x, (int)hq[0], 0, false), false);
    const int s_lo = __builtin_amdgcn_sdot8((int)a.y, (int)hq[3], __builtin_amdgcn_sdot8((int)a.x, (int)hq[2], 0, false), false);
    return 16 * s_hi + s_lo;
}
__device__ __forceinline__ int reduce8i(const int (&d)[8], int lane) {
    const bool b5 = lane & 32, b4 = lane & 16, b3 = lane & 8;
    int r4[4];
#pragma unroll
    for (int i = 0; i < 4; ++i) { const int keep = b5 ? d[4 + i] : d[i], send = b5 ? d[i] : d[4 + i]; r4[i] = keep + __shfl_xor(send, 32); }
    int r2[2];
#pragma unroll
    for (int i = 0; i < 2; ++i) { const int keep = b4 ? r4[2 + i] : r4[i], send = b4 ? r4[i] : r4[2 + i]; r2[i] = keep + __shfl_xor(send, 16); }
    int r1; { const int keep = b3 ? r2[1] : r2[0], send = b3 ? r2[0] : r2[1]; r1 = keep + __shfl_xor(send, 8); }
    r1 += __shfl_xor(r1, 4); r1 += __shfl_xor(r1, 2); r1 += __shfl_xor(r1, 1);
    return r1;
}
__device__ __forceinline__ void peer_dots(const tabv_t (&buf)[8], const unsigned (&hq)[4], int grp, int lane, float& a0, float& a1) {
    int d[8];
#pragma unroll
    for (int e = 0; e < 8; ++e) d[e] = idot16(buf[e], hq);
    const int r1 = reduce8i(d, lane);
    const int e = lane & 7, src = ((e >> 2) & 1) * 32 + ((e >> 1) & 1) * 16 + (e & 1) * 8;
    const float val = (float)__shfl(r1, src);
    if ((lane >> 3) == (grp & 7)) { if (grp < 8) a0 = val; else a1 = val; }
}
#else
__device__ __forceinline__ void peer_dots(const tabv_t (&buf)[8], const unsigned (&hh)[8], int grp, int lane, float& a0, float& a1) {
    float d[8];
#pragma unroll
    for (int e = 0; e < 8; ++e) d[e] = dot16(buf[e], hh);
    const float r1 = reduce8(d, lane);
    const int e = lane & 7, src = ((e >> 2) & 1) * 32 + ((e >> 1) & 1) * 16 + (e & 1) * 8;
    const float val = __shfl(r1, src);
    if ((lane >> 3) == (grp & 7)) { if (grp < 8) a0 = val; else a1 = val; }
}
#endif
__device__ __forceinline__ void peer_fma8(const tabv_t (&buf)[8], float c0, float c1, int kbase, float (&acc)[16]) {
#pragma unroll
    for (int e = 0; e < 8; ++e) { const int k = kbase + e; const float ck = bitsf((unsigned)__builtin_amdgcn_readlane((int)fbits(k < 64 ? c0 : c1), k & 63));
#if TAB_BITS == 4
        const unsigned w4[2] = {buf[e].x, buf[e].y};
#pragma unroll
        for (int dd = 0; dd < 2; ++dd) {
            const h2_t p0 = __builtin_amdgcn_cvt_scalef32_pk_f16_fp4(w4[dd], 1.0f, 0), p1 = __builtin_amdgcn_cvt_scalef32_pk_f16_fp4(w4[dd], 1.0f, 1),
                       p2 = __builtin_amdgcn_cvt_scalef32_pk_f16_fp4(w4[dd], 1.0f, 2), p3 = __builtin_amdgcn_cvt_scalef32_pk_f16_fp4(w4[dd], 1.0f, 3);
            acc[8 * dd + 0] = fmaf((float)p0[0], ck, acc[8 * dd + 0]); acc[8 * dd + 1] = fmaf((float)p0[1], ck, acc[8 * dd + 1]);
            acc[8 * dd + 2] = fmaf((float)p1[0], ck, acc[8 * dd + 2]); acc[8 * dd + 3] = fmaf((float)p1[1], ck, acc[8 * dd + 3]);
            acc[8 * dd + 4] = fmaf((float)p2[0], ck, acc[8 * dd + 4]); acc[8 * dd + 5] = fmaf((float)p2[1], ck, acc[8 * dd + 5]);
            acc[8 * dd + 6] = fmaf((float)p3[0], ck, acc[8 * dd + 6]); acc[8 * dd + 7] = fmaf((float)p3[1], ck, acc[8 * dd + 7]); }
#else
        const unsigned w[4] = {buf[e].x, buf[e].y, buf[e].z, buf[e].w};
#pragma unroll
        for (int q = 0; q < 4; ++q) { const h2_t lo = __builtin_amdgcn_cvt_scalef32_pk_f16_fp8(w[q], 1.0f, false), hi = __builtin_amdgcn_cvt_scalef32_pk_f16_fp8(w[q], 1.0f, true);
            acc[4 * q] = fmaf((float)lo[0], ck, acc[4 * q]); acc[4 * q + 1] = fmaf((float)lo[1], ck, acc[4 * q + 1]);
            acc[4 * q + 2] = fmaf((float)hi[0], ck, acc[4 * q + 2]); acc[4 * q + 3] = fmaf((float)hi[1], ck, acc[4 * q + 3]); }
#endif
    }
}
struct PeerTok { int e0, e1; float g0, g1, su0, su1, sv0, sv1; };
__device__ __forceinline__ void peer_tok_idx(PeerTok& T, int m, const int* idx, const float* gate, int lane) {
    T.e0 = idx[(size_t)m * 128 + lane]; T.e1 = idx[(size_t)m * 128 + 64 + lane]; T.g0 = gate[(size_t)m * 128 + lane]; T.g1 = gate[(size_t)m * 128 + 64 + lane];
}
__device__ __forceinline__ void peer_tok_scales(PeerTok& T, const float* scU, const float* scV) { T.su0 = scU[T.e0]; T.su1 = scU[T.e1]; T.sv0 = scV[T.e0]; T.sv1 = scV[T.e1]; }
__device__ __forceinline__ void peer_issue_f(int grp, const unsigned char* tab, const PeerTok& T, int lane, u32x4 (&buf)[8]) {
#pragma unroll
    for (int e = 0; e < 8; ++e) { const int k = 8 * grp + e; const int ex = __builtin_amdgcn_readlane(k < 64 ? T.e0 : T.e1, k & 63);
        buf[e] = *((const u32x4*)(tab + (size_t)ex * 1024) + lane); }
}
__device__ __forceinline__ void peer_group(const u32x4 (&buf)[8], const unsigned (&hq)[4], int grp, int lane, const PeerTok& T, float sh, h2_t (&acc)[8]) {
    int d[8];
#pragma unroll
    for (int e = 0; e < 8; ++e) { const u32x2 up = {buf[e].x, buf[e].y}; d[e] = idot16(up, hq); }
    const int r1 = reduce8i(d, lane);
    const int el = lane & 7, src = ((el >> 2) & 1) * 32 + ((el >> 1) & 1) * 16 + (el & 1) * 8;
    const float a = (float)__shfl(r1, src);
    const bool lo = grp < 8;
    const float c = ABL_PEER ? 0.f : (lo ? T.g0 : T.g1) * gelu_tanh(a * ((lo ? T.su0 : T.su1) * sh)) * (lo ? T.sv0 : T.sv1);
    const unsigned cpk = pkh2(c, c);
#pragma unroll
    for (int e = 0; e < 8; ++e) { const h2_t ck = as_h2((unsigned)__builtin_amdgcn_readlane((int)cpk, 8 * (grp & 7) + e));
        const unsigned w4[2] = {buf[e].z, buf[e].w};
#pragma unroll
        for (int dd = 0; dd < 2; ++dd) {
#pragma unroll
            for (int sl = 0; sl < 4; ++sl) { h2_t pv;
                if (sl == 0) pv = __builtin_amdgcn_cvt_scalef32_pk_f16_fp4(w4[dd], 1.0f, 0); else if (sl == 1) pv = __builtin_amdgcn_cvt_scalef32_pk_f16_fp4(w4[dd], 1.0f, 1);
                else if (sl == 2) pv = __builtin_amdgcn_cvt_scalef32_pk_f16_fp4(w4[dd], 1.0f, 2); else pv = __builtin_amdgcn_cvt_scalef32_pk_f16_fp4(w4[dd], 1.0f, 3);
                acc[4 * dd + sl] = __builtin_elementwise_fma(pv, ck, acc[4 * dd + sl]); } } }
}
template <bool LAST, bool DRY = false>
__device__ __forceinline__ void peer_tokens(const Ctx& C, int m0, int step, const unsigned char* tab, const float* scU, const float* scV, const int* idx, const float* gate, const float* ss2,
                                            float* xs, bf16_t* xg, const float* gnext, float* rstd1) {
    const int lane = C.lane;
    if (m0 >= M) return;
    PeerTok T, Tn;
    peer_tok_idx(T, m0, idx, gate, lane); peer_tok_scales(T, scU, scV);
#if PEER_RING == 3
    u32x4 bA[8], bB[8], bC[8];
#else
    u32x4 bA[8], bB[8];
#endif
    for (int m = m0; m < M; m += step) {
        const int mn = m + step; const bool has_next = mn < M;
        peer_issue_f(0, tab, T, lane, bA);
#if PEER_RING == 3
        peer_issue_f(1, tab, T, lane, bB);
#endif
        if (has_next) peer_tok_idx(Tn, mn, idx, gate, lane);
        const float rs = pg8::row_rs(ss2, m);
        unsigned hh[4]; float sh;
        { const u32x4 x0 = *((const u32x4*)(xg + (size_t)m * D) + 2 * lane), x1 = *((const u32x4*)(xg + (size_t)m * D) + 2 * lane + 1);
          const unsigned w[8] = {x0.x, x0.y, x0.z, x0.w, x1.x, x1.y, x1.z, x1.w};
          float hv[16]; float mxh = 0.f;
#pragma unroll
          for (int q = 0; q < 8; ++q) { hv[2 * q] = bflo(w[q]) * rs; hv[2 * q + 1] = bfhi(w[q]) * rs; mxh = fmaxf(mxh, fmaxf(fabsf(hv[2 * q]), fabsf(hv[2 * q + 1]))); }
#pragma unroll
          for (int o = 1; o < 64; o <<= 1) mxh = fmaxf(mxh, __shfl_xor(mxh, o));
          sh = fmaxf(mxh, 1e-30f) * (1.0f / 119.0f); const float inv = 1.0f / sh;
#pragma unroll
          for (int dd = 0; dd < 2; ++dd) { unsigned th = 0u, tl = 0u;
#pragma unroll
              for (int j = 0; j < 8; ++j) { const int q8 = (int)rintf(hv[8 * dd + j] * inv), hi = (q8 + 8) >> 4, lo = q8 - (hi << 4); th |= ((unsigned)hi & 15u) << (4 * j); tl |= ((unsigned)lo & 15u) << (4 * j); }
              hh[dd] = th; hh[2 + dd] = tl; } }
        h2_t acc[8];
#pragma unroll
        for (int i = 0; i < 8; ++i) acc[i] = (h2_t){(_Float16)0.f, (_Float16)0.f};
#if PEER_RING == 3
#pragma unroll 1
        for (int j = 0; j < 15; j += 3) {
            peer_issue_f(j + 2, tab, T, lane, bC); peer_group(bA, hh, j, lane, T, sh, acc);
            peer_issue_f(j + 3, tab, T, lane, bA); peer_group(bB, hh, j + 1, lane, T, sh, acc);
            if (j + 4 < 16) peer_issue_f(j + 4, tab, T, lane, bB);
            peer_group(bC, hh, j + 2, lane, T, sh, acc);
        }
        peer_group(bA, hh, 15, lane, T, sh, acc);
#else
#pragma unroll 1
        for (int j = 0; j < 16; j += 2) {
            peer_issue_f(j + 1, tab, T, lane, bB); peer_group(bA, hh, j, lane, T, sh, acc);
            if (j + 2 < 16) peer_issue_f(j + 2, tab, T, lane, bA);
            peer_group(bB, hh, j + 1, lane, T, sh, acc);
        }
#endif
        if (has_next) peer_tok_scales(Tn, scU, scV);
        float* xr = xs + (size_t)m * D;
        f32x4 x[4];
#pragma unroll
        for (int j = 0; j < 4; ++j) x[j] = *((const f32x4*)xr + 4 * lane + j);
        float sq = 0.f;
#pragma unroll
        for (int j = 0; j < 4; ++j)
#pragma unroll
            for (int i = 0; i < 4; ++i) { x[j][i] += (float)acc[2 * j + (i >> 1)][i & 1]; sq += x[j][i] * x[j][i]; }
        sq = wave_sum(sq);
        const float rn = __builtin_amdgcn_rsqf(sq * (1.0f / D) + EPS);
        if (!(DRY && rn != 12345.678f)) {
        f32x4 gg[4];
#pragma unroll
        for (int j = 0; j < 4; ++j) gg[j] = *((const f32x4*)gnext + 4 * lane + j);
        if (LAST) {
#pragma unroll
            for (int j = 0; j < 4; ++j) *((f32x4*)xr + 4 * lane + j) = x[j] * gg[j] * rn;
        } else {
#pragma unroll
            for (int j = 0; j < 4; ++j) *((f32x4*)xr + 4 * lane + j) = x[j];
            u32x4 o0, o1; const f32x4 y0 = x[0] * gg[0], y1 = x[1] * gg[1], y2 = x[2] * gg[2], y3 = x[3] * gg[3];
            o0.x = pk2(y0[0], y0[1]); o0.y = pk2(y0[2], y0[3]); o0.z = pk2(y1[0], y1[1]); o0.w = pk2(y1[2], y1[3]);
            o1.x = pk2(y2[0], y2[1]); o1.y = pk2(y2[2], y2[3]); o1.z = pk2(y3[0], y3[1]); o1.w = pk2(y3[2], y3[3]);
            *((u32x4*)(xg + (size_t)m * D) + 2 * lane) = o0; *((u32x4*)(xg + (size_t)m * D) + 2 * lane + 1) = o1;
            if (lane == 0) st_wt(rstd1 + m, rn);
        }
        }
        T = Tn;
    }
}

constexpr int PS_WAVE = 12800, PS_AC = 0, PS_EID = 8192, PS_SH = 12288;
__device__ __forceinline__ void peer_fma8_v(const u32x2 (&buf)[8], float c0, float c1, int kbase, float (&acc)[16]) {
#pragma unroll
    for (int e = 0; e < 8; ++e) { const int k = kbase + e; const float ck = bitsf((unsigned)__builtin_amdgcn_readlane((int)fbits(k < 64 ? c0 : c1), k & 63));
        const unsigned w4[2] = {buf[e].x, buf[e].y};
#pragma unroll
        for (int dd = 0; dd < 2; ++dd) {
            const h2_t p0 = __builtin_amdgcn_cvt_scalef32_pk_f16_fp4(w4[dd], 1.0f, 0), p1 = __builtin_amdgcn_cvt_scalef32_pk_f16_fp4(w4[dd], 1.0f, 1),
                       p2 = __builtin_amdgcn_cvt_scalef32_pk_f16_fp4(w4[dd], 1.0f, 2), p3 = __builtin_amdgcn_cvt_scalef32_pk_f16_fp4(w4[dd], 1.0f, 3);
            acc[8 * dd + 0] = fmaf((float)p0[0], ck, acc[8 * dd + 0]); acc[8 * dd + 1] = fmaf((float)p0[1], ck, acc[8 * dd + 1]);
            acc[8 * dd + 2] = fmaf((float)p1[0], ck, acc[8 * dd + 2]); acc[8 * dd + 3] = fmaf((float)p1[1], ck, acc[8 * dd + 3]);
            acc[8 * dd + 4] = fmaf((float)p2[0], ck, acc[8 * dd + 4]); acc[8 * dd + 5] = fmaf((float)p2[1], ck, acc[8 * dd + 5]);
            acc[8 * dd + 6] = fmaf((float)p3[0], ck, acc[8 * dd + 6]); acc[8 * dd + 7] = fmaf((float)p3[1], ck, acc[8 * dd + 7]); } }
}
__device__ __forceinline__ void peer_load8_v(const unsigned char* tabV, int e0, int e1, int kbase, int lane, u32x2 (&buf)[8]) {
#pragma unroll
    for (int e = 0; e < 8; ++e) { const int k = kbase + e; const int ex = __builtin_amdgcn_readlane(k < 64 ? e0 : e1, k & 63);
        buf[e] = *((const u32x2*)(tabV + (size_t)ex * 512) + lane); }
}
__device__ __forceinline__ void ps_issue(LAS unsigned char* wl, int i, const unsigned char* uslice, int r, int p, u32x2 (&rows)[16]) {
    const u32x4 w0 = *(const LAS u32x4*)(wl + PS_EID + i * 256 + r * 32), w1 = *(const LAS u32x4*)(wl + PS_EID + i * 256 + r * 32 + 16);
    const unsigned w[8] = {w0.x, w0.y, w0.z, w0.w, w1.x, w1.y, w1.z, w1.w};
#pragma unroll
    for (int j = 0; j < 16; ++j) { const unsigned e = (j & 1) ? (w[j >> 1] >> 16) : (w[j >> 1] & 0xffffu); rows[j] = *(const u32x2*)(uslice + (size_t)e * 64 + p * 8); }
}
__device__ __forceinline__ void ps_consume(LAS unsigned char* wl, int i, const u32x2 (&rows)[16], const u32x4& hq4, int lane) {
    const unsigned hq[4] = {hq4.x, hq4.y, hq4.z, hq4.w};
    int d[16];
#pragma unroll
    for (int j = 0; j < 16; ++j) d[j] = idot16(rows[j], hq);
    const bool b2 = lane & 4, b1 = lane & 2, b0 = lane & 1;
    int r8[8], r4[4], r2[2];
#pragma unroll
    for (int k = 0; k < 8; ++k) { const int keep = b2 ? d[8 + k] : d[k], send = b2 ? d[k] : d[8 + k]; r8[k] = keep + __shfl_xor(send, 4); }
#pragma unroll
    for (int k = 0; k < 4; ++k) { const int keep = b1 ? r8[4 + k] : r8[k], send = b1 ? r8[k] : r8[4 + k]; r4[k] = keep + __shfl_xor(send, 2); }
#pragma unroll
    for (int k = 0; k < 2; ++k) { const int keep = b0 ? r4[2 + k] : r4[k], send = b0 ? r4[k] : r4[2 + k]; r2[k] = keep + __shfl_xor(send, 1); }
    LAS int* ap = (LAS int*)(wl + PS_AC + i * 512) + (lane >> 3) * 16 + 2 * (lane & 7);
    const int o0 = ap[0], o1 = ap[1]; ap[0] = o0 + r2[0]; ap[1] = o1 + r2[1];
}
template <bool LAST, bool DRY = false>
__device__ __forceinline__ void peer_sweep(const Ctx& C, const unsigned char* tabUs, const unsigned char* tabV, const float* scU, const float* scV, const int* idx, const float* gate, const float* ss2,
                                           float* xs, bf16_t* xg, const float* gnext, float* rstd1, unsigned char* hqbuf) {
    const int lane = C.lane, r = lane >> 3, p = lane & 7;
    LAS unsigned char* wl = C.lds + C.wave * PS_WAVE;
#pragma unroll 1
    for (int i = 0; i < 16; ++i) {
        const int m = C.gw + i * C.ngw;
        const int e0 = idx[(size_t)m * 128 + lane], e1 = idx[(size_t)m * 128 + 64 + lane];
        const int p0 = (lane & 7) * 16 + (lane >> 3), p1 = p0 + 8;
        *(LAS unsigned short*)(wl + PS_EID + i * 256 + p0 * 2) = (unsigned short)e0; *(LAS unsigned short*)(wl + PS_EID + i * 256 + p1 * 2) = (unsigned short)e1;
        ((LAS int*)(wl + PS_AC + i * 512))[lane] = 0; ((LAS int*)(wl + PS_AC + i * 512))[64 + lane] = 0;
        const float rs = pg8::row_rs(ss2, m);
        const u32x4 x0 = *((const u32x4*)(xg + (size_t)m * D) + 2 * lane), x1 = *((const u32x4*)(xg + (size_t)m * D) + 2 * lane + 1);
        const unsigned w[8] = {x0.x, x0.y, x0.z, x0.w, x1.x, x1.y, x1.z, x1.w};
        float hv[16]; float mxh = 0.f;
#pragma unroll
        for (int q = 0; q < 8; ++q) { hv[2 * q] = bflo(w[q]) * rs; hv[2 * q + 1] = bfhi(w[q]) * rs; mxh = fmaxf(mxh, fmaxf(fabsf(hv[2 * q]), fabsf(hv[2 * q + 1]))); }
#pragma unroll
        for (int o = 1; o < 64; o <<= 1) mxh = fmaxf(mxh, __shfl_xor(mxh, o));
        const float sh = fmaxf(mxh, 1e-30f) * (1.0f / 119.0f), inv = 1.0f / sh;
        unsigned hh[4];
#pragma unroll
        for (int dd = 0; dd < 2; ++dd) { unsigned th = 0u, tl = 0u;
#pragma unroll
            for (int j = 0; j < 8; ++j) { const int q8 = (int)rintf(hv[8 * dd + j] * inv), hi = (q8 + 8) >> 4, lo = q8 - (hi << 4); th |= ((unsigned)hi & 15u) << (4 * j); tl |= ((unsigned)lo & 15u) << (4 * j); }
            hh[dd] = th; hh[2 + dd] = tl; }
        *((u32x4*)(hqbuf + (size_t)m * 1024) + lane) = (u32x4){hh[0], hh[1], hh[2], hh[3]};
        if (lane == 0) ((LAS float*)(wl + PS_SH))[i] = sh;
    }
    asm volatile("s_waitcnt vmcnt(0) lgkmcnt(0)" ::: "memory");
#pragma unroll 1
    for (int s = 0; s < 8; ++s) {
        const unsigned char* uslice = tabUs + (size_t)s * MiB;
        u32x2 rA[16], rB[16]; u32x4 hA, hB;
        ps_issue(wl, 0, uslice, r, p, rA); hA = *((const u32x4*)(hqbuf + (size_t)C.gw * 1024) + s * 8 + p);
#pragma unroll 1
        for (int i = 0; i < 16; i += 2) {
            ps_issue(wl, i + 1, uslice, r, p, rB); hB = *((const u32x4*)(hqbuf + (size_t)(C.gw + (i + 1) * C.ngw) * 1024) + s * 8 + p);
            ps_consume(wl, i, rA, hA, lane);
            if (i + 2 < 16) { ps_issue(wl, i + 2, uslice, r, p, rA); hA = *((const u32x4*)(hqbuf + (size_t)(C.gw + (i + 2) * C.ngw) * 1024) + s * 8 + p); }
            ps_consume(wl, i + 1, rB, hB, lane);
        }
    }
#pragma unroll 1
    for (int i = 0; i < 16; ++i) {
        const int m = C.gw + i * C.ngw; const float sh = ((LAS float*)(wl + PS_SH))[i];
#pragma unroll
        for (int hf = 0; hf < 2; ++hf) { const int pos = lane + 64 * hf, k = (pos & 15) * 8 + (pos >> 4);
            const int e = *(LAS unsigned short*)(wl + PS_EID + i * 256 + pos * 2); const int a = ((LAS int*)(wl + PS_AC + i * 512))[pos];
            const float g = gate[(size_t)m * 128 + k], su = scU[e], sv = scV[e];
            const float c = ABL_PEER ? 0.f : g * gelu_tanh((float)a * (su * sh)) * sv;
            ((LAS float*)(wl + PS_AC + i * 512))[pos] = c; }
    }
#pragma unroll 1
    for (int i = 0; i < 16; ++i) {
        const int m = C.gw + i * C.ngw;
        const int e0 = idx[(size_t)m * 128 + lane], e1 = idx[(size_t)m * 128 + 64 + lane];
        const int p0 = (lane & 7) * 16 + (lane >> 3);
        const float c0 = ((LAS float*)(wl + PS_AC + i * 512))[p0], c1 = ((LAS float*)(wl + PS_AC + i * 512))[p0 + 8];
        float acc[16];
#pragma unroll
        for (int q = 0; q < 16; ++q) acc[q] = 0.f;
        u32x2 bA[8], bB[8];
        peer_load8_v(tabV, e0, e1, 0, lane, bA);
#pragma unroll 1
        for (int j = 0; j < 16; j += 2) {
            peer_load8_v(tabV, e0, e1, 8 * (j + 1), lane, bB); peer_fma8_v(bA, c0, c1, 8 * j, acc);
            if (j + 2 < 16) peer_load8_v(tabV, e0, e1, 8 * (j + 2), lane, bA);
            peer_fma8_v(bB, c0, c1, 8 * (j + 1), acc);
        }
        float* xr = xs + (size_t)m * D;
        f32x4 x[4];
#pragma unroll
        for (int j = 0; j < 4; ++j) x[j] = *((const f32x4*)xr + 4 * lane + j);
        float sq = 0.f;
#pragma unroll
        for (int j = 0; j < 4; ++j)
#pragma unroll
            for (int q = 0; q < 4; ++q) { x[j][q] += acc[4 * j + q]; sq += x[j][q] * x[j][q]; }
        sq = wave_sum(sq);
        const float rn = __builtin_amdgcn_rsqf(sq * (1.0f / D) + EPS);
        if (!(DRY && rn != 12345.678f)) {
        f32x4 gg[4];
#pragma unroll
        for (int j = 0; j < 4; ++j) gg[j] = *((const f32x4*)gnext + 4 * lane + j);
        if (LAST) {
#pragma unroll
            for (int j = 0; j < 4; ++j) *((f32x4*)xr + 4 * lane + j) = x[j] * gg[j] * rn;
        } else {
#pragma unroll
            for (int j = 0; j < 4; ++j) *((f32x4*)xr + 4 * lane + j) = x[j];
            u32x4 o0, o1; const f32x4 y0 = x[0] * gg[0], y1 = x[1] * gg[1], y2 = x[2] * gg[2], y3 = x[3] * gg[3];
            o0.x = pk2(y0[0], y0[1]); o0.y = pk2(y0[2], y0[3]); o0.z = pk2(y1[0], y1[1]); o0.w = pk2(y1[2], y1[3]);
            o1.x = pk2(y2[0], y2[1]); o1.y = pk2(y2[2], y2[3]); o1.z = pk2(y3[0], y3[1]); o1.w = pk2(y3[2], y3[3]);
            *((u32x4*)(xg + (size_t)m * D) + 2 * lane) = o0; *((u32x4*)(xg + (size_t)m * D) + 2 * lane + 1) = o1;
            if (lane == 0) st_wt(rstd1 + m, rn);
        }
        }
    }
}

typedef int v8i_t __attribute__((ext_vector_type(8)));
constexpr int PM_WAVE = 2048, PM_H = 0, PM_A = 1024;
#define PM_MFMA8(ACC, UA, BF, SC) asm volatile("s_nop 4\n\t" \
    "v_mfma_scale_f32_16x16x128_f8f6f4 %0, %1, %9, %0, %17, %17 op_sel_hi:[0,0,0] cbsz:4\n\t" \
    "v_mfma_scale_f32_16x16x128_f8f6f4 %0, %2, %10, %0, %17, %17 op_sel_hi:[0,0,0] cbsz:4\n\t" \
    "v_mfma_scale_f32_16x16x128_f8f6f4 %0, %3, %11, %0, %17, %17 op_sel_hi:[0,0,0] cbsz:4\n\t" \
    "v_mfma_scale_f32_16x16x128_f8f6f4 %0, %4, %12, %0, %17, %17 op_sel_hi:[0,0,0] cbsz:4\n\t" \
    "v_mfma_scale_f32_16x16x128_f8f6f4 %0, %5, %13, %0, %17, %17 op_sel_hi:[0,0,0] cbsz:4\n\t" \
    "v_mfma_scale_f32_16x16x128_f8f6f4 %0, %6, %14, %0, %17, %17 op_sel_hi:[0,0,0] cbsz:4\n\t" \
    "v_mfma_scale_f32_16x16x128_f8f6f4 %0, %7, %15, %0, %17, %17 op_sel_hi:[0,0,0] cbsz:4\n\t" \
    "v_mfma_scale_f32_16x16x128_f8f6f4 %0, %8, %16, %0, %17, %17 op_sel_hi:[0,0,0] cbsz:4\n\t" \
    "s_nop 15\n\ts_nop 7" \
    : "+v"(ACC) : "v"(UA[0]), "v"(UA[1]), "v"(UA[2]), "v"(UA[3]), "v"(UA[4]), "v"(UA[5]), "v"(UA[6]), "v"(UA[7]), \
      "v"(BF[0]), "v"(BF[1]), "v"(BF[2]), "v"(BF[3]), "v"(BF[4]), "v"(BF[5]), "v"(BF[6]), "v"(BF[7]), "v"(SC))
struct TokM { int e0, e1; float g0, g1, su0, su1, sv0, sv1; int er[8]; };
__device__ __forceinline__ void tokm_idx(TokM& T, int m, const int* idx, const float* gate, int lane) {
    T.e0 = idx[(size_t)m * 128 + lane]; T.e1 = idx[(size_t)m * 128 + 64 + lane]; T.g0 = gate[(size_t)m * 128 + lane]; T.g1 = gate[(size_t)m * 128 + 64 + lane];
#pragma unroll
    for (int mb = 0; mb < 8; ++mb) T.er[mb] = idx[(size_t)m * 128 + 16 * mb + (lane & 15)];
}
__device__ __forceinline__ void tokm_scales(TokM& T, const float* scU, const float* scV) { T.su0 = scU[T.e0]; T.su1 = scU[T.e1]; T.sv0 = scV[T.e0]; T.sv1 = scV[T.e1]; }
__device__ __forceinline__ void pm_issue_u(const unsigned char* tab, int er, int quad, u32x4 (&ua)[8]) {
    const u32x4* bp = (const u32x4*)(tab + (size_t)er * 1024 + 16 * quad);
#pragma unroll
    for (int kb = 0; kb < 8; ++kb) ua[kb] = bp[4 * kb];
}
__device__ __forceinline__ void pm_issue_v(int grp, const unsigned char* tab, const TokM& T, int lane, u32x2 (&buf)[8]) {
#pragma unroll
    for (int e = 0; e < 8; ++e) { const int k = 8 * grp + e; const int ex = __builtin_amdgcn_readlane(k < 64 ? T.e0 : T.e1, k & 63);
        buf[e] = *((const u32x2*)(tab + (size_t)ex * 1024 + 512) + lane); }
}
__device__ __forceinline__ void pm_fma_v(const u32x2 (&buf)[8], unsigned cp0, unsigned cp1, int grp, h2_t (&acc)[8]) {
#pragma unroll
    for (int e = 0; e < 8; ++e) { const int k = 8 * grp + e; const h2_t ck = as_h2((unsigned)__builtin_amdgcn_readlane((int)(k < 64 ? cp0 : cp1), k & 63));
        const unsigned w4[2] = {buf[e].x, buf[e].y};
#pragma unroll
        for (int dd = 0; dd < 2; ++dd) {
#pragma unroll
            for (int sl = 0; sl < 4; ++sl) { h2_t pv;
                if (sl == 0) pv = __builtin_amdgcn_cvt_scalef32_pk_f16_fp4(w4[dd], 1.0f, 0); else if (sl == 1) pv = __builtin_amdgcn_cvt_scalef32_pk_f16_fp4(w4[dd], 1.0f, 1);
                else if (sl == 2) pv = __builtin_amdgcn_cvt_scalef32_pk_f16_fp4(w4[dd], 1.0f, 2); else pv = __builtin_amdgcn_cvt_scalef32_pk_f16_fp4(w4[dd], 1.0f, 3);
                acc[4 * dd + sl] = __builtin_elementwise_fma(pv, ck, acc[4 * dd + sl]); } } }
}
template <bool LAST, bool DRY = false>
__device__ __forceinline__ void peer_tokens_mf(const Ctx& C, int m0, int step, const unsigned char* tab, const float* scU, const float* scV, const int* idx, const float* gate, const float* ss2,
                                               float* xs, bf16_t* xg, const float* gnext, float* rstd1) {
    const int lane = C.lane, n16 = lane & 15, quad = lane >> 4;
    if (m0 >= M) return;
    LAS unsigned char* wl = C.lds + C.wave * PM_WAVE;
    TokM T, Tn;
    tokm_idx(T, m0, idx, gate, lane); tokm_scales(T, scU, scV);
    unsigned e8m0_one = 0x7F7F7F7Fu; asm volatile("" : "+v"(e8m0_one));
    for (int m = m0; m < M; m += step) {
        const int mn = m + step; const bool has_next = mn < M;
        u32x4 uA[8], uB[8];
        pm_issue_u(tab, T.er[0], quad, uA);
        if (has_next) tokm_idx(Tn, mn, idx, gate, lane);
        const float rs = pg8::row_rs(ss2, m);
        float sh;
        { const u32x4 x0 = *((const u32x4*)(xg + (size_t)m * D) + 2 * lane), x1 = *((const u32x4*)(xg + (size_t)m * D) + 2 * lane + 1);
          const unsigned w[8] = {x0.x, x0.y, x0.z, x0.w, x1.x, x1.y, x1.z, x1.w};
          float hv[16]; float mxh = 0.f;
#pragma unroll
          for (int q = 0; q < 8; ++q) { hv[2 * q] = bflo(w[q]) * rs; hv[2 * q + 1] = bfhi(w[q]) * rs; mxh = fmaxf(mxh, fmaxf(fabsf(hv[2 * q]), fabsf(hv[2 * q + 1]))); }
#pragma unroll
          for (int o = 1; o < 64; o <<= 1) mxh = fmaxf(mxh, __shfl_xor(mxh, o));
          sh = fmaxf(mxh, 1e-30f) * (1.0f / 240.0f); const float inv = 1.0f / sh;
          unsigned hb[4];
#pragma unroll
          for (int q = 0; q < 4; ++q) { unsigned t = __builtin_amdgcn_cvt_pk_fp8_f32(hv[4 * q] * inv, hv[4 * q + 1] * inv, 0u, false); hb[q] = __builtin_amdgcn_cvt_pk_fp8_f32(hv[4 * q + 2] * inv, hv[4 * q + 3] * inv, t, true); }
          *(LAS u32x4*)(wl + PM_H + 16 * lane) = (u32x4){hb[0], hb[1], hb[2], hb[3]}; }
        v8i_t bfr[8];
#pragma unroll
        for (int kb = 0; kb < 8; ++kb) { const u32x4 b0 = *(const LAS u32x4*)(wl + PM_H + 128 * kb + 16 * quad), b1 = *(const LAS u32x4*)(wl + PM_H + 128 * kb + 64 + 16 * quad);
            bfr[kb] = (v8i_t){(int)b0.x, (int)b0.y, (int)b0.z, (int)b0.w, (int)b1.x, (int)b1.y, (int)b1.z, (int)b1.w}; }
#pragma unroll
        for (int mb = 0; mb < 8; ++mb) {
            if (mb + 1 < 8) { if (mb & 1) pm_issue_u(tab, T.er[mb + 1], quad, uA); else pm_issue_u(tab, T.er[mb + 1], quad, uB); }
            f32x4 acc = {0.f, 0.f, 0.f, 0.f};
            if (mb & 1) PM_MFMA8(acc, uB, bfr, e8m0_one); else PM_MFMA8(acc, uA, bfr, e8m0_one);
            *(LAS f32x4*)(wl + PM_A + (16 * mb + 4 * quad) * 4) = acc;
        }
        const float a0 = ((const LAS float*)(wl + PM_A))[lane], a1 = ((const LAS float*)(wl + PM_A))[64 + lane];
        const float c0 = ABL_PEER ? 0.f : T.g0 * gelu_tanh(a0 * (T.su0 * sh)) * T.sv0, c1 = ABL_PEER ? 0.f : T.g1 * gelu_tanh(a1 * (T.su1 * sh)) * T.sv1;
        const unsigned cp0 = pkh2(c0, c0), cp1 = pkh2(c1, c1);
        if (has_next) tokm_scales(Tn, scU, scV);
        h2_t acc[8];
#pragma unroll
        for (int i = 0; i < 8; ++i) acc[i] = (h2_t){(_Float16)0.f, (_Float16)0.f};
        u32x2 vA[8], vB[8];
        pm_issue_v(0, tab, T, lane, vA);
#pragma unroll 1
        for (int j = 0; j < 16; j += 2) {
            pm_issue_v(j + 1, tab, T, lane, vB); pm_fma_v(vA, cp0, cp1, j, acc);
            if (j + 2 < 16) pm_issue_v(j + 2, tab, T, lane, vA);
            pm_fma_v(vB, cp0, cp1, j + 1, acc);
        }
        float* xr = xs + (size_t)m * D;
        f32x4 x[4];
#pragma unroll
        for (int j = 0; j < 4; ++j) x[j] = *((const f32x4*)xr + 4 * lane + j);
        float sq = 0.f;
#pragma unroll
        for (int j = 0; j < 4; ++j)
#pragma unroll
            for (int i = 0; i < 4; ++i) { x[j][i] += (float)acc[2 * j + (i >> 1)][i & 1]; sq += x[j][i] * x[j][i]; }
        sq = wave_sum(sq);
        const float rn = __builtin_amdgcn_rsqf(sq * (1.0f / D) + EPS);
        if (!(DRY && rn != 12345.678f)) {
        f32x4 gg[4];
#pragma unroll
        for (int j = 0; j < 4; ++j) gg[j] = *((const f32x4*)gnext + 4 * lane + j);
        if (LAST) {
#pragma unroll
            for (int j = 0; j < 4; ++j) *((f32x4*)xr + 4 * lane + j) = x[j] * gg[j] * rn;
        } else {
#pragma unroll
            for (int j = 0; j < 4; ++j) *((f32x4*)xr + 4 * lane + j) = x[j];
            u32x4 o0, o1; const f32x4 y0 = x[0] * gg[0], y1 = x[1] * gg[1], y2 = x[2] * gg[2], y3 = x[3] * gg[3];
            o0.x = pk2(y0[0], y0[1]); o0.y = pk2(y0[2], y0[3]); o0.z = pk2(y1[0], y1[1]); o0.w = pk2(y1[2], y1[3]);
            o1.x = pk2(y2[0], y2[1]); o1.y = pk2(y2[2], y2[3]); o1.z = pk2(y3[0], y3[1]); o1.w = pk2(y3[2], y3[3]);
            *((u32x4*)(xg + (size_t)m * D) + 2 * lane) = o0; *((u32x4*)(xg + (size_t)m * D) + 2 * lane + 1) = o1;
            if (lane == 0) st_wt(rstd1 + m, rn);
        }
        }
        T = Tn;
    }
}
typedef __attribute__((address_space(1))) unsigned gu32;
#define XB_TMO      128
#define XB_XCNT(j)  (256  + 64 * (j))
#define XB_XSUB(j)  (1280 + 64 * (j))
#define XB_XGEN(j)  (2304 + 64 * (j))
#define XB_TOP      3328
#define XB_TOPGEN   3392
#define XCD_BAR_WORDS 3456
#define XB_SPIN_CAP (1u << 18)

__device__ __forceinline__ unsigned xb_ld(unsigned* p)              { return __hip_atomic_load(p, __ATOMIC_RELAXED, __HIP_MEMORY_SCOPE_AGENT); }
__device__ __forceinline__ unsigned xb_add(unsigned* p, unsigned v) { return __hip_atomic_fetch_add(p, v, __ATOMIC_RELAXED, __HIP_MEMORY_SCOPE_AGENT); }
__device__ __forceinline__ unsigned xb_xcc_id() { return (unsigned)__builtin_amdgcn_s_getreg((3 << 11) | 20) & 0xFu; }
#define XB_SPIN(cond, bar) do { unsigned _sp = 0; while (cond) { __builtin_amdgcn_s_sleep(1); \
    if ((++_sp & 255u) == 0u) { if (xb_ld(&(bar)[XB_TMO])) break; if (_sp > XB_SPIN_CAP) { atomicAdd(&(bar)[XB_TMO], 1u); break; } } } } while (0)

struct XcdBarrier {
    unsigned* bar; unsigned x;
    volatile LAS unsigned* st;
};

__device__ __forceinline__ XcdBarrier xcd_barrier_post(unsigned* bar, volatile LAS unsigned* st) {
    XcdBarrier b; b.bar = bar; b.x = xb_xcc_id(); b.st = st;
    if (threadIdx.x == 0) (void)xb_add(&bar[XB_XCNT(b.x)], 1u);
    return b;
}
__device__ __forceinline__ void xcd_barrier_complete(unsigned* bar, unsigned x, unsigned& nloc, unsigned& nx) {
    const unsigned G = gridDim.x * gridDim.y * gridDim.z;
    unsigned sum, cnt, mine, sp = 0u;
    for (;;) {
        sum = 0u; cnt = 0u; mine = 0u;
#pragma unroll
        for (unsigned j = 0; j < 16; ++j) { const unsigned c = xb_ld(&bar[XB_XCNT(j)]); sum += c; cnt += (c > 0u) ? 1u : 0u; mine = (j == x) ? c : mine; }
        if (sum == G) break;
        __builtin_amdgcn_s_sleep(1);
        if ((++sp & 255u) == 0u) { if (xb_ld(&bar[XB_TMO])) break; if (sp > XB_SPIN_CAP) { atomicAdd(&bar[XB_TMO], 1u); break; } }
    }
    nloc = mine > 0u ? mine : 1u; nx = cnt > 0u ? cnt : 1u;
}

__device__ __forceinline__ void xcd_barrier(const XcdBarrier& b) {
    asm volatile("s_waitcnt vmcnt(0)" ::: "memory");
    __syncthreads();
    if (threadIdx.x == 0) {
        unsigned* bar = b.bar;
        __builtin_amdgcn_s_waitcnt(0);
#if XB_SAFE == 4
        __builtin_amdgcn_fence(__ATOMIC_RELEASE, "");
        asm volatile("s_waitcnt vmcnt(0)" ::: "memory");
#endif
#if XB_SAFE == 1 || XB_SAFE == 2 || XB_SAFE == 5
        __builtin_amdgcn_fence(__ATOMIC_RELEASE, "agent");
        asm volatile("s_waitcnt vmcnt(0)" ::: "memory");
#endif
        unsigned nloc = b.st[0], nx = b.st[1];
        if (nloc == 0u) { xcd_barrier_complete(bar, b.x, nloc, nx); b.st[0] = nloc; b.st[1] = nx; }
        const unsigned old = xb_add(&bar[XB_XSUB(b.x)], 1u);
        const unsigned gen = old / nloc;
        if (old + 1u == (gen + 1u) * nloc) {
            __builtin_amdgcn_fence(__ATOMIC_RELEASE, "agent");
            asm volatile("s_waitcnt vmcnt(0)" ::: "memory");
            const unsigned og = xb_add(&bar[XB_TOP], 1u);
            const unsigned tg = og / nx;
            if (og + 1u == (tg + 1u) * nx) xb_add(&bar[XB_TOPGEN], 1u);
            else XB_SPIN(xb_ld(&bar[XB_TOPGEN]) == tg, bar);
#if XB_SAFE == 4 || XB_SAFE == 5
            __builtin_amdgcn_fence(__ATOMIC_ACQUIRE, "");
#endif
            __builtin_amdgcn_fence(__ATOMIC_ACQUIRE, "agent");
            xb_add(&bar[XB_XGEN(b.x)], 1u);
            asm volatile("s_waitcnt vmcnt(0)" ::: "memory");
        } else {
            XB_SPIN(xb_ld(&bar[XB_XGEN(b.x)]) == gen, bar);
#if XB_SAFE == 4
            __builtin_amdgcn_fence(__ATOMIC_ACQUIRE, "");
#endif
            __builtin_amdgcn_fence(__ATOMIC_ACQUIRE, "agent");
            asm volatile("s_waitcnt vmcnt(0)" ::: "memory");
        }
    }
    __syncthreads();
#if XB_SAFE == 1 || XB_SAFE == 3
    __builtin_amdgcn_fence(__ATOMIC_ACQUIRE, "agent");
    asm volatile("s_waitcnt vmcnt(0)" ::: "memory");
    __syncthreads();
#endif
}

constexpr int LDS_BYTES = 147456;
#ifndef MK_SYNC_CG
#define MK_SYNC_CG 1
#endif

__device__ __forceinline__ Ctx make_ctx(LAS unsigned char* lds) {
    Ctx C; int tid = threadIdx.x; asm volatile("" : "+v"(tid));
    C.tid = tid; C.lane = tid & 63; C.wave = __builtin_amdgcn_readfirstlane(tid >> 6); C.G = gridDim.x; C.bid = blockIdx.x;
    C.gw = C.bid * NWAVES + C.wave; C.ngw = C.G * NWAVES; C.gt = C.bid * NTHREADS + tid; C.ngt = C.G * NTHREADS; C.lds = lds;
    return C;
}
template <class Epi>
__device__ __forceinline__ void run_gemm(const Ctx& C, const bf16_t* A, int lda, const bf16_t* Bt, int ldb, int N, int K, const Epi& E) {
    pg8::Gemm g{A, Bt, M, N, K, lda, ldb}; pg8::StaticOrder S; S.init(M, N, C.G, C.bid);
    pg8::gemm_phase<Epi, pg8::StaticOrder, true, true>(C.lds, g, S, E);
}

__device__ __forceinline__ const void* karg(int i) {
    const __attribute__((address_space(4))) unsigned long long* ka = (const __attribute__((address_space(4))) unsigned long long*)__builtin_amdgcn_kernarg_segment_ptr();
    int z = 0; asm volatile("" : "+s"(z));
    return (const void*)(const __attribute__((address_space(1))) void*)ka[i + z];
}
#define KWS() ((unsigned char*)karg(27))
#define KIN(i) ((const float*)karg(i))


#if PEER_SLICED
#define PEER_CALL(LAST_, DRY_) PEER_CALL_S_<LAST_, DRY_>
template <bool LAST, bool DRY>
__device__ __forceinline__ void PEER_CALL_S_(const Ctx& C, unsigned char* ws, const unsigned char* tab, const float* scU, const float* scV, const int* idx, const float* gate, const float* ssp, float* xs, bf16_t* xg, const float* gn, float* rstd1) {
    peer_sweep<LAST, DRY>(C, tab, tab + 16 * MiB, scU, scV, idx, gate, ssp, xs, xg, gn, rstd1, ws + WS_HQ);
}
#else
#define PEER_CALL(LAST_, DRY_) PEER_CALL_T_<LAST_, DRY_>
template <bool LAST, bool DRY>
__device__ __forceinline__ void PEER_CALL_T_(const Ctx& C, unsigned char* ws, const unsigned char* tab, const float* scU, const float* scV, const int* idx, const float* gate, const float* ssp, float* xs, bf16_t* xg, const float* gn, float* rstd1) {
#if PEER_MFMA
    peer_tokens_mf<LAST, DRY>(C, C.gw, C.ngw, tab, scU, scV, idx, gate, ssp, xs, xg, gn, rstd1);
#else
    peer_tokens<LAST, DRY>(C, C.gw, C.ngw, tab, scU, scV, idx, gate, ssp, xs, xg, gn, rstd1);
#endif
}
#endif
#ifndef DBG_STOP
#define DBG_STOP 0
#endif
#ifndef DBG_LAYER
#define DBG_LAYER 1
#endif
#ifndef DUP_PHASE
#define DUP_PHASE 0
#endif
#ifndef DUP_LAYER
#define DUP_LAYER -1
#endif
__global__ void __launch_bounds__(NTHREADS, 2) mk_fwd(Args args) {
    extern __shared__ __attribute__((aligned(16))) unsigned char lds_raw[];
    cg::grid_group grid = cg::this_grid();
#define MKCTX() make_ctx((LAS unsigned char*)lds_raw)
    volatile LAS unsigned* bst = (volatile LAS unsigned*)((LAS unsigned char*)lds_raw + 131072 + 64);
    if (threadIdx.x < 2) bst[threadIdx.x] = 0u;
    __syncthreads();
    const XcdBarrier xbar = xcd_barrier_post((unsigned*)(args.ws + WS_CTL) + 4096, bst);
#define GRID_SYNC() xcd_barrier(xbar)
#define GRID_SYNC_CG() do { asm volatile("s_waitcnt vmcnt(0)" ::: "memory"); grid.sync(); if (threadIdx.x == 0) { __builtin_amdgcn_fence(__ATOMIC_ACQUIRE, ""); asm volatile("s_waitcnt vmcnt(0)" ::: "memory"); } __syncthreads(); } while (0)

    for (int rep_ = 0; rep_ < (DUP_PHASE == 10 ? 2 : 1); ++rep_) { const Ctx C = MKCTX(); phase_prologue(C, args); }
    if (gridDim.y == 0x7fffffffu) GRID_SYNC_CG();
    GRID_SYNC();

    if (DUP_PHASE == 11) { for (int rep_ = 0; rep_ < 10; ++rep_) GRID_SYNC(); }
    for (int l = 0; l < DEPTH; ++l) {
#define WL(ws) ((ws) + WS_W + (size_t)l * W_LAYER)
        const size_t o_rstd = l == 0 ? WS_RSTD1 : WS_L1, o_lse = l == 0 ? WS_LSE : WS_L1 + 1 * MiB, o_send = l == 0 ? WS_SEND : WS_L1 + 3 * MiB, o_ssp = l == 0 ? WS_SSP : WS_L1 + 5 * MiB;
        const size_t o_rstd_next = WS_L1;
        for (int rep_ = 0; rep_ < ((DUP_PHASE == 1 && (DUP_LAYER < 0 || DUP_LAYER == l)) ? 2 : 1); ++rep_) {
        { const Ctx C = MKCTX(); unsigned char* ws = KWS(); pg8::EpiZ E{(bf16_t*)(ws + WS_C), (bf16_t*)(ws + WS_D), (const float*)(ws + o_rstd)};
          run_gemm(C, (const bf16_t*)(ws + WS_E), D, (const bf16_t*)(WL(ws) + WO_WIN), D, NZ, D, E); }
        GRID_SYNC();
        }
#if DBG_STOP >= 11 && DBG_STOP <= 18
        if (DBG_STOP == 10 + 1 && l == DBG_LAYER) return;
#endif
        for (int rep_ = 0; rep_ < ((DUP_PHASE == 2 && (DUP_LAYER < 0 || DUP_LAYER == l)) ? 2 : 1); ++rep_) {
        for (int r2_ = 0; r2_ < (DUP_PHASE == 21 ? 2 : 1); ++r2_)
        { const Ctx C = MKCTX(); unsigned char* ws = KWS();
          for (int it = C.bid; it < BATCH * 768; it += C.G) attn_item(C, it, (const bf16_t*)(ws + WS_D), (const f32x2*)(ws + WS_ROPE), (bf16_t*)(ws + WS_F), (float*)(ws + o_lse)); }
        for (int r2_ = 0; r2_ < (DUP_PHASE == 22 ? 2 : 1); ++r2_)
        { const Ctx C = MKCTX(); unsigned char* ws = KWS();
          for (int it = C.gw; it < BATCH * NCH * SSM_G; it += C.ngw) ssm_item<false>(C, it, (const bf16_t*)(ws + WS_C), ws + WS_SSMC + (size_t)l * SSMC_LAYER, (f32x2*)(ws + o_send), nullptr, nullptr, nullptr, nullptr); }
        GRID_SYNC();
        }
#if DBG_STOP >= 11 && DBG_STOP <= 18
        if (DBG_STOP == 10 + 2 && l == DBG_LAYER) return;
#endif
        for (int rep_ = 0; rep_ < ((DUP_PHASE == 3 && (DUP_LAYER < 0 || DUP_LAYER == l)) ? 2 : 1); ++rep_) {
        for (int r2_ = 0; r2_ < (DUP_PHASE == 31 ? 2 : 1); ++r2_)
        { const Ctx C = MKCTX(); unsigned char* ws = KWS();
          const float* cre = KIN(I_CRE) + (size_t)l * SSM_G * SSM_P * SSM_N; const float* cim = KIN(I_CIM) + (size_t)l * SSM_G * SSM_P * SSM_N; const float* dsk = KIN(I_SD) + (size_t)l * SSMW;
          for (int it = C.gw; it < BATCH * NCH * SSM_G; it += C.ngw)
              ssm_item<true>(C, it, (const bf16_t*)(ws + WS_C), ws + WS_SSMC + (size_t)l * SSMC_LAYER, (f32x2*)(ws + o_send), cre, cim, dsk, (bf16_t*)(ws + WS_D + 32 * MiB)); }
        for (int r2_ = 0; r2_ < (DUP_PHASE == 32 ? 2 : 1); ++r2_)
        { const Ctx C = MKCTX(); unsigned char* ws = KWS();
          pool_items(C, (const bf16_t*)(ws + WS_C), (bf16_t*)(ws + WS_D));
          attn_merge_items(C, (const bf16_t*)(ws + WS_F), (const float*)(ws + o_lse), (bf16_t*)(ws + WS_D + 64 * MiB));
          }
        GRID_SYNC();
        }
#if DBG_STOP >= 11 && DBG_STOP <= 18
        if (DBG_STOP == 10 + 3 && l == DBG_LAYER) return;
#endif
        for (int rep_ = 0; rep_ < ((DUP_PHASE == 4 && (DUP_LAYER < 0 || DUP_LAYER == l)) ? 2 : 1); ++rep_) {
        { const Ctx C = MKCTX(); unsigned char* ws = KWS(); pg8::EpiPlain E{(bf16_t*)(ws + WS_C), POOLW, nullptr};
          run_gemm(C, (const bf16_t*)(ws + WS_D), POOLW, (const bf16_t*)(WL(ws) + WO_POOL), POOLW, POOLW, POOLW, E); }
        { const Ctx C = MKCTX(); unsigned char* ws = KWS(); pg8::EpiGlu E{(bf16_t*)(ws + WS_C + 32 * MiB)};
          run_gemm(C, (const bf16_t*)(ws + WS_D + 32 * MiB), SSMW, (const bf16_t*)(WL(ws) + WO_GLU), SSMW, 2 * SSMW, SSMW, E); }
        GRID_SYNC();
        }
#if DBG_STOP >= 11 && DBG_STOP <= 18
        if (DBG_STOP == 10 + 4 && l == DBG_LAYER) return;
#endif
        for (int rep_ = 0; rep_ < ((DUP_PHASE == 5 && (DUP_LAYER < 0 || DUP_LAYER == l)) ? 2 : 1); ++rep_) {
#define GATE_GEMM(b) { const Ctx C = MKCTX(); unsigned char* ws = KWS(); pg8::EpiGate E{(bf16_t*)(ws + WS_D + 80 * MiB), (const float*)(ws + o_rstd)}; \
          run_gemm(C, (const bf16_t*)(ws + WS_E), D, (const bf16_t*)(WL(ws) + WO_WIN) + (size_t)(NZ + (b) * D) * D, D, D, D, E); }
        GATE_GEMM(0)
        { const Ctx C = MKCTX(); unsigned char* ws = KWS(); pg8::EpiMerge<true> E{(const bf16_t*)(ws + WS_D + 80 * MiB), (bf16_t*)(ws + WS_F), ABL_POOL ? 0.f : 1.f};
          run_gemm(C, (const bf16_t*)(ws + WS_C), POOLW, (const bf16_t*)(WL(ws) + WO_PPROJ), POOLW, D, POOLW, E); }
        GATE_GEMM(1)
        { const Ctx C = MKCTX(); unsigned char* ws = KWS(); pg8::EpiMerge<false> E{(const bf16_t*)(ws + WS_D + 80 * MiB), (bf16_t*)(ws + WS_F), ABL_SSM ? 0.f : 1.f};
          run_gemm(C, (const bf16_t*)(ws + WS_C + 32 * MiB), SSMW, (const bf16_t*)(WL(ws) + WO_SPROJ), SSMW, D, SSMW, E); }
        GATE_GEMM(2)
        { const Ctx C = MKCTX(); unsigned char* ws = KWS(); pg8::EpiMerge<false> E{(const bf16_t*)(ws + WS_D + 80 * MiB), (bf16_t*)(ws + WS_F), ABL_ATTN ? 0.f : 1.f};
          run_gemm(C, (const bf16_t*)(ws + WS_D + 64 * MiB), AOUT, (const bf16_t*)(WL(ws) + WO_APROJ), AOUT, D, AOUT, E); }
        GRID_SYNC();
        }
#if DBG_STOP >= 11 && DBG_STOP <= 18
        if (DBG_STOP == 10 + 5 && l == DBG_LAYER) return;
#endif
        for (int rep_ = 0; rep_ < ((DUP_PHASE == 6 && (DUP_LAYER < 0 || DUP_LAYER == l)) ? 2 : 1); ++rep_) {
        { const Ctx C = MKCTX(); unsigned char* ws = KWS(); float* xs = (float*)karg(26);
          pg8::EpiOut E{l == 0 ? KIN(I_X) : (const float*)xs, xs, (bf16_t*)(ws + WS_E), KIN(I_N2G) + (size_t)l * D, (float*)(ws + o_ssp)};
          run_gemm(C, (const bf16_t*)(ws + WS_F), D, (const bf16_t*)(WL(ws) + WO_WOUT), D, D, D, E); }
        GRID_SYNC();
        }
#if DBG_STOP >= 11 && DBG_STOP <= 18
        if (DBG_STOP == 10 + 6 && l == DBG_LAYER) return;
#endif
        for (int rep_ = 0; rep_ < ((DUP_PHASE == 7 && (DUP_LAYER < 0 || DUP_LAYER == l)) ? 2 : 1); ++rep_) {
        { const Ctx C = MKCTX(); unsigned char* ws = KWS(); pg8::EpiPlain E{(bf16_t*)(ws + WS_D), PQ, (const float*)(ws + o_ssp)};
          run_gemm(C, (const bf16_t*)(ws + WS_E), D, (const bf16_t*)(WL(ws) + WO_WQ), D, PQ, D, E); }
        GRID_SYNC();
        }
#if DBG_STOP >= 11 && DBG_STOP <= 18
        if (DBG_STOP == 10 + 7 && l == DBG_LAYER) return;
#endif
        for (int rep_ = 0; rep_ < ((DUP_PHASE == 8 && (DUP_LAYER < 0 || DUP_LAYER == l)) ? 2 : 1); ++rep_) {
        { const Ctx C = MKCTX(); unsigned char* ws = KWS();
          topk_stage_keys(C, (const bf16_t*)(WL(ws) + WO_K1), (const bf16_t*)(WL(ws) + WO_K2));
          __syncthreads();
          for (int it = C.gw; it < (M / 16) * PH; it += C.ngw) topk_item(C, it, (const bf16_t*)(ws + WS_D), (int*)(ws + WS_C), (float*)(ws + WS_C + 16 * MiB)); }
        GRID_SYNC();
        }
#if DBG_STOP >= 11 && DBG_STOP <= 18
        if (DBG_STOP == 10 + 8 && l == DBG_LAYER) return;
#endif
#if DBG_STOP == 28 || DBG_STOP == 27
        if (l == DBG_LAYER) { const Ctx C = MKCTX(); unsigned char* ws = KWS(); float* o = (float*)karg(26);
          if (DBG_STOP == 28) { const int* pi = (const int*)(ws + WS_C); for (size_t i = C.gt; i < (size_t)M * D; i += C.ngt) { const size_t m = i >> 10; const int c = (int)(i & 1023); o[i] = c < 128 ? (float)pi[m * 128 + c] : 0.f; } }
          else { const bf16_t* q = (const bf16_t*)(ws + WS_D); for (size_t i = C.gt; i < (size_t)M * D; i += C.ngt) { const size_t m = i >> 10; const int c = (int)(i & 1023); o[i] = bflo((unsigned)q[m * PQ + c]) + bflo((unsigned)q[m * PQ + 1024 + c]) * 3.0f; } }
          return; }
#endif
        if (l + 1 < DEPTH) {
            { const Ctx C = MKCTX(); unsigned char* ws = KWS(); float* xs = (float*)karg(26); const float* gn = KIN(I_N1G) + (size_t)(l + 1) * D;
              if (DUP_PHASE == 9) { PEER_CALL(false, true)(C, ws, ws + WS_TAB + (size_t)l * TAB_LAYER, (const float*)(ws + WS_TSC + (size_t)l * 131072), (const float*)(ws + WS_TSC + (size_t)l * 131072 + 65536), (const int*)(ws + WS_C), (const float*)(ws + WS_C + 16 * MiB),
                                                                     (const float*)(ws + o_ssp), xs, (bf16_t*)(ws + WS_E), gn, (float*)(ws + o_rstd_next)); }
              PEER_CALL(false, false)(C, ws, ws + WS_TAB + (size_t)l * TAB_LAYER, (const float*)(ws + WS_TSC + (size_t)l * 131072), (const float*)(ws + WS_TSC + (size_t)l * 131072 + 65536), (const int*)(ws + WS_C), (const float*)(ws + WS_C + 16 * MiB),
                                                                     (const float*)(ws + o_ssp), xs, (bf16_t*)(ws + WS_E), gn, (float*)(ws + o_rstd_next)); }
            GRID_SYNC();
#if DBG_STOP == 6
            return;
#endif
        } else {
            const Ctx C = MKCTX(); unsigned char* ws = KWS(); float* xs = (float*)karg(26); const float* gn = KIN(I_FG);
            PEER_CALL(true, false)(C, ws, ws + WS_TAB + (size_t)l * TAB_LAYER, (const float*)(ws + WS_TSC + (size_t)l * 131072), (const float*)(ws + WS_TSC + (size_t)l * 131072 + 65536), (const int*)(ws + WS_C), (const float*)(ws + WS_C + 16 * MiB),
                                                                  (const float*)(ws + o_ssp), xs, (bf16_t*)(ws + WS_E), gn, (float*)(ws + o_rstd_next));
        }
    }
}

extern "C" void kernel_launch(void* const* d_in, const int* in_sizes, int n_in, void* d_out, int out_size, void* d_ws, size_t ws_size, hipStream_t stream) {
    static int grid = 0;
    if (grid == 0) {
        if (n_in != 26 || in_sizes[0] != M * D || out_size != M * D || ws_size < WS_END) { fprintf(stderr, "kernel_launch: unexpected shapes (n_in %d, in0 %d, out %d, ws %zu); nothing launched\n", n_in, n_in > 0 ? in_sizes[0] : -1, out_size, ws_size); grid = -1; return; }
        int dev = 0, cus = 0, per_cu = 0;
        if (hipGetDevice(&dev) != hipSuccess || hipDeviceGetAttribute(&cus, hipDeviceAttributeMultiprocessorCount, dev) != hipSuccess) { grid = -1; return; }
        if (hipFuncSetAttribute((const void*)mk_fwd, hipFuncAttributeMaxDynamicSharedMemorySize, LDS_BYTES) != hipSuccess) { fprintf(stderr, "kernel_launch: hipFuncSetAttribute failed\n"); grid = -1; return; }
        if (hipOccupancyMaxActiveBlocksPerMultiprocessor(&per_cu, (const void*)mk_fwd, NTHREADS, LDS_BYTES) != hipSuccess || per_cu < 1) { fprintf(stderr, "kernel_launch: occupancy query says %d\n", per_cu); grid = -1; (void)hipGetLastError(); return; }
        grid = cus;
    }
    if (grid < 0) return;
    (void)hipMemsetAsync((char*)d_ws + WS_CTL, 0, CTL_BYTES, stream);
    Args a{};
    for (int i = 0; i < 26; ++i) a.in[i] = d_in[i];
    a.out = (float*)d_out; a.ws = (unsigned char*)d_ws;
    void* kargs[] = {&a};
    const hipError_t e = hipLaunchCooperativeKernel((const void*)mk_fwd, dim3(grid), dim3(NTHREADS), kargs, LDS_BYTES, stream);
    if (e != hipSuccess) fprintf(stderr, "kernel_launch: cooperative launch failed: %s (grid %d)\n", hipGetErrorString(e), grid);
}
```

```cpp
#include <hip/hip_runtime.h>
#include <hip/hip_cooperative_groups.h>
#include <cstdio>
#include <cstdint>
namespace cg = cooperative_groups;

#ifndef TAB_BITS
#define TAB_BITS 4
#endif
#ifndef GATE_F8
#define GATE_F8 1
#endif
#ifndef XB16
#define XB16 0
#endif
#if XB16 && (PEER_SLICED || PEER_MFMA)
#error "XB16 is implemented for the fused token-major PEER path only"
#endif
#ifndef PEER_RESDMA
#define PEER_RESDMA 1
#endif
#ifndef PEER_HDMA
#define PEER_HDMA 0
#endif
#ifndef FUSE78
#define FUSE78 1
#endif
#if FUSE78 && Q_F8
#error "FUSE78 is wired for the bf16 q GEMM call"
#endif
#ifndef TABQ_DEFER
#define TABQ_DEFER 1
#endif
#ifndef ROPE_FLY
#define ROPE_FLY 1
#endif
#ifndef OUT_PREFILL
#define OUT_PREFILL 1
#endif
#ifndef S_U8
#define S_U8 2
#endif
#ifndef Q_F8
#define Q_F8 0
#endif
constexpr float GATE_WSC = 64.0f;
#ifndef PEER_DRAIN
#define PEER_DRAIN 0
#endif
#ifndef PEER_MFMA
#define PEER_MFMA 0
#endif
#ifndef EPI_NT
#define EPI_NT 0
#endif
#ifndef PEER_SLICED
#define PEER_SLICED 0
#endif
#ifndef XB_SAFE
#define XB_SAFE 5
#endif
#ifndef PEER_RING
#define PEER_RING 2
#endif
#ifndef PEER_XTOK
#define PEER_XTOK 1
#endif
#ifndef ABL_POOL
#define ABL_POOL 0
#endif
#ifndef ABL_SSM
#define ABL_SSM 0
#endif
#ifndef ABL_ATTN
#define ABL_ATTN 0
#endif
#ifndef ABL_PEER
#define ABL_PEER 0
#endif
constexpr int D = 1024, BATCH = 4, SEQ = 8192, M = BATCH * SEQ, DEPTH = 2;
constexpr int IN_COLS = 6400, NZ = 3328;
constexpr int POOLW = 512, SSMW = 512, AW = 768, AOUT = 256, QKVW = 2304;
constexpr int SSM_G = 32, SSM_P = 16, SSM_N = 64;
constexpr int CH = 256, NCH = SEQ / CH;
constexpr int PH = 8, NKEYS = 128, TOPK = 16, NEXP = 16384, PQ = 2048;
constexpr float EPS = 1e-6f;
constexpr int NWAVES = 8, NTHREADS = 512;

constexpr size_t MiB = 1u << 20;
constexpr size_t WS_CTL = 0;
constexpr size_t WS_W = 1 * MiB, W_LAYER = 23 * MiB;
constexpr size_t WO_WIN = 0, WO_POOL = 13107200, WO_PPROJ = WO_POOL + 524288, WO_GLU = WO_PPROJ + 1048576, WO_SPROJ = WO_GLU + 1048576,
                 WO_APROJ = WO_SPROJ + 1048576, WO_WOUT = WO_APROJ + 524288, WO_WQ = WO_WOUT + 2097152, WO_K1 = WO_WQ + 4194304, WO_K2 = WO_K1 + 32768, WO_END = WO_K2 + 32768;
static_assert(WO_END <= W_LAYER, "weights");
constexpr size_t WS_SSMC = 47 * MiB, SSMC_LAYER = 512 * 1024;
constexpr size_t WS_ROPE = 48 * MiB;
constexpr size_t WS_RSTD1 = 56 * MiB, WS_SS2 = WS_RSTD1 + 131072, WS_LSE = WS_SS2 + 131072  , WS_SEND = WS_LSE + 3 * (size_t)M * 16  ;
constexpr size_t WS_TAB = 60 * MiB, TAB_LAYER = 32 * MiB;
constexpr size_t WS_TSC = 59 * MiB + 768 * 1024;
constexpr size_t WS_C = 124 * MiB;
constexpr size_t WS_D = 188 * MiB;
constexpr size_t WS_E = 332 * MiB;
constexpr size_t WS_F = 396 * MiB;
constexpr size_t WS_SSP = 460 * MiB;
constexpr size_t WS_L1 = 462 * MiB, L1_SIZE = 8 * MiB;
constexpr size_t WS_HQ = 470 * MiB;
constexpr size_t WS_H8 = WS_HQ;
constexpr size_t WS_END = 502 * MiB;
constexpr size_t CTL_BYTES = 1 * MiB;
static_assert(WS_SEND + (size_t)BATCH * NCH * 32 * 64 * 8 <= WS_TSC && WS_TSC + 2 * 131072 <= 60 * MiB && WS_TAB + 2 * TAB_LAYER <= WS_C, "small");

#define LAS __attribute__((address_space(3)))
typedef unsigned short bf16_t;
typedef short bf16x8 __attribute__((ext_vector_type(8)));
typedef float f32x4 __attribute__((ext_vector_type(4)));
typedef float f32x2 __attribute__((ext_vector_type(2)));
typedef unsigned u32x4 __attribute__((ext_vector_type(4)));
typedef unsigned u32x2 __attribute__((ext_vector_type(2)));
typedef _Float16 h2_t __attribute__((ext_vector_type(2)));
typedef __bf16 b2_t __attribute__((ext_vector_type(2)));
typedef short v4i16_t __attribute__((ext_vector_type(4)));

__device__ __forceinline__ unsigned f2bf(float f) { unsigned u = __builtin_bit_cast(unsigned, f); return (u + 0x7fffu + ((u >> 16) & 1u)) >> 16; }
__device__ __forceinline__ unsigned pk2(float lo, float hi) { f32x2 v = {lo, hi}; b2_t b = __builtin_convertvector(v, b2_t); return __builtin_bit_cast(unsigned, b); }
__device__ __forceinline__ unsigned pk4_fp8(float a, float b, float c, float d) {
    a = __builtin_fminf(__builtin_fmaxf(a, -448.f), 448.f); b = __builtin_fminf(__builtin_fmaxf(b, -448.f), 448.f); c = __builtin_fminf(__builtin_fmaxf(c, -448.f), 448.f); d = __builtin_fminf(__builtin_fmaxf(d, -448.f), 448.f);
    int w = __builtin_amdgcn_cvt_pk_fp8_f32(a, b, 0, false); w = __builtin_amdgcn_cvt_pk_fp8_f32(c, d, w, true); return (unsigned)w;
}
__device__ __forceinline__ float bflo(unsigned w) { return __builtin_bit_cast(float, w << 16); }
__device__ __forceinline__ float bfhi(unsigned w) { return __builtin_bit_cast(float, w & 0xffff0000u); }
__device__ __forceinline__ unsigned pkh2(float lo, float hi) { h2_t h = {(_Float16)lo, (_Float16)hi}; return __builtin_bit_cast(unsigned, h); }
__device__ __forceinline__ float fast_exp2(float x) { return __builtin_amdgcn_exp2f(x); }
__device__ __forceinline__ float fast_rcp(float x) { return __builtin_amdgcn_rcpf(x); }
__device__ __forceinline__ float sigmoidf_(float x) { return fast_rcp(1.0f + fast_exp2(-1.4426950408889634f * x)); }
__device__ __forceinline__ float gelu_tanh(float x) { const float u = 1.5957691216057308f * (x + 0.044715f * x * x * x); return x * sigmoidf_(u); }
__device__ __forceinline__ unsigned fbits(float f) { return __builtin_bit_cast(unsigned, f); }
__device__ __forceinline__ float bitsf(unsigned u) { return __builtin_bit_cast(float, u); }
template <int MASK> __device__ __forceinline__ unsigned shx_u(unsigned v) {
    if constexpr (MASK < 32) return (unsigned)__builtin_amdgcn_ds_swizzle((int)v, 0x1F | (MASK << 10));
    else { const auto r = __builtin_amdgcn_permlane32_swap(v, v, false, false);
           return (unsigned)__builtin_amdgcn_update_dpp((int)r[1], (int)r[0], 0xE4, 0xC, 0xF, false); }
}
template <int MASK> __device__ __forceinline__ float shx(float v) { return bitsf(shx_u<MASK>(fbits(v))); }
template <int MASK> __device__ __forceinline__ int shx(int v) { return (int)shx_u<MASK>((unsigned)v); }
__device__ __forceinline__ float shfl_idx(float v, int src) { return bitsf((unsigned)__builtin_amdgcn_ds_bpermute(src << 2, (int)fbits(v))); }
__device__ __forceinline__ int shfl_idx(int v, int src) { return __builtin_amdgcn_ds_bpermute(src << 2, v); }
__device__ __forceinline__ float wave_sum(float v) { v += shx<1>(v); v += shx<2>(v); v += shx<4>(v); v += shx<8>(v); v += shx<16>(v); v += shx<32>(v); return v; }
__device__ __forceinline__ float wave_max(float v) { v = fmaxf(v, shx<1>(v)); v = fmaxf(v, shx<2>(v)); v = fmaxf(v, shx<4>(v)); v = fmaxf(v, shx<8>(v)); v = fmaxf(v, shx<16>(v)); v = fmaxf(v, shx<32>(v)); return v; }
__device__ __forceinline__ h2_t as_h2(unsigned w) { return __builtin_bit_cast(h2_t, w); }
__device__ __forceinline__ void st_wt(float* p, float v) { __hip_atomic_store(p, v, __ATOMIC_RELAXED, __HIP_MEMORY_SCOPE_AGENT); }
#define LDS_WAIT() asm volatile("s_waitcnt lgkmcnt(0)" ::: "memory")
#define VM_WAIT() asm volatile("s_waitcnt vmcnt(0)" ::: "memory")
namespace pg8 {
#define PG8_LAS __attribute__((address_space(3)))
constexpr int BM = 256, BK = 64, HALF = 128, HTB = HALF * BK * 2  , STAGE_BYTES = 8 * HTB, NXCD = 8, WGM = 8;
__host__ __device__ __forceinline__ int lds_byte(int r, int c) { const int st = (r >> 4) * 2 + (c >> 5), rr = r & 15, cc = c & 31, ob = rr * 64 + cc * 2; return st * 1024 + (ob ^ (((ob >> 9) & 1) << 5)); }
__host__ __device__ __forceinline__ void stage_rc(int b, int& R, int& C) { const int st = b / 1024, sb = b % 1024, swz = sb ^ (((sb >> 9) & 1) << 5); R = (st >> 1) * 16 + swz / 64; C = (st & 1) * 32 + (swz % 64) / 2; }
__host__ __device__ __forceinline__ int perm32(int rho) { const int n = rho >> 4, i = rho & 15; return 8 * (i >> 2) + 4 * n + (i & 3); }

typedef int i32x8_t __attribute__((ext_vector_type(8)));
typedef int i32x4_t __attribute__((ext_vector_type(4)));
__device__ __forceinline__ i32x8_t cat8(const bf16x8 a, const bf16x8 b) { const i32x4_t x = __builtin_bit_cast(i32x4_t, a), y = __builtin_bit_cast(i32x4_t, b); return __builtin_shufflevector(x, y, 0, 1, 2, 3, 4, 5, 6, 7); }
struct Unit { int pm, pn; };
struct Gemm { const bf16_t* A; const bf16_t* Bt; int M, N, K, lda, ldb; };

struct StaticOrder {
    int nM, nN, nwg, G, c;
    __host__ __device__ void init(int M_, int N_, int G_, int c_) { nM = M_ / BM; nN = N_ / BM; nwg = nM * nN; G = G_; c = c_; }
    __host__ __device__ bool next(int i, Unit& u) const {
        const long L = (long)i * G + c; if (L >= nwg) return false;
        int wgid = (int)L; { const int q = nwg / NXCD, r = nwg % NXCD, xcd = wgid % NXCD, off = wgid / NXCD; wgid = (xcd < r ? xcd * (q + 1) : r * (q + 1) + (xcd - r) * q) + off; }
        const int nig = WGM * nN, gid = wgid / nig, fm = gid * WGM, gsz = (nM - fm) < WGM ? (nM - fm) : WGM;
        u.pm = fm + ((wgid % nig) % gsz); u.pn = (wgid % nig) / gsz; return true;
    }
    __device__ __forceinline__ void a_ready(const Unit&) const {}
    __device__ __forceinline__ void done(const Unit&) const {}
};

typedef f32x4 acc_t[2][2][4][2];

__device__ __forceinline__ u32x4 pack8(const f32x4& a, const f32x4& b) { u32x4 w; w.x = pk2(a[0], a[1]); w.y = pk2(a[2], a[3]); w.z = pk2(b[0], b[1]); w.w = pk2(b[2], b[3]); return w; }
__device__ __forceinline__ void unpack8(const u32x4& w, f32x4& a, f32x4& b) { a = (f32x4){bflo(w.x), bfhi(w.x), bflo(w.y), bfhi(w.y)}; b = (f32x4){bflo(w.z), bfhi(w.z), bflo(w.w), bfhi(w.w)}; }

__device__ __forceinline__ float row_rs(const float* ssp, int row) {
    const f32x4* p = (const f32x4*)(ssp + (size_t)row * 16); const f32x4 a = p[0], b = p[1], c = p[2], d = p[3];
    const float s = ((a[0] + a[1]) + (a[2] + a[3])) + ((b[0] + b[1]) + (b[2] + b[3])) + ((c[0] + c[1]) + (c[2] + c[3])) + ((d[0] + d[1]) + (d[2] + d[3]));
    return __builtin_amdgcn_rsqf(s * (1.0f / D) + EPS);
}
struct EpiZ {
    static constexpr bool PERM = true, AFTER_DRAIN = false;
    bf16_t* zps; bf16_t* zqkv; const float* rstd;
    __device__ __forceinline__ void operator()(const acc_t& acc, const Unit& u, int wr, int wc, int fr, int fq) const {
        const int row0 = u.pm * BM + wr * 64 + fr;
        bf16_t* base; int ldc, colt;
        if (u.pn < 4) { base = zps; ldc = 1024; colt = u.pn * BM; } else { base = zqkv; ldc = QKVW; colt = (u.pn - 4) * BM; }
        const int col0 = colt + wc * 32 + 8 * fq;
        float rsv[2][4];
#pragma unroll
        for (int ai = 0; ai < 2; ++ai)
#pragma unroll
            for (int m = 0; m < 4; ++m) rsv[ai][m] = rstd[row0 + ai * HALF + m * 16];
#pragma unroll
        for (int ai = 0; ai < 2; ++ai)
#pragma unroll
            for (int m = 0; m < 4; ++m) { const int row = row0 + ai * HALF + m * 16; const float rs = rsv[ai][m]; bf16_t* rowp = base + (size_t)row * ldc + col0;
#pragma unroll
                for (int bj = 0; bj < 2; ++bj) *(u32x4*)(rowp + bj * HALF) = pack8(acc[ai][bj][m][0] * rs, acc[ai][bj][m][1] * rs); }
    }
};
struct EpiPlain {
    static constexpr bool PERM = true, AFTER_DRAIN = false;
    bf16_t* O; int ldc; const float* ss; float wsc = 1.0f;
    __device__ __forceinline__ void operator()(const acc_t& acc, const Unit& u, int wr, int wc, int fr, int fq) const {
        const int row0 = u.pm * BM + wr * 64 + fr, col0 = u.pn * BM + wc * 32 + 8 * fq;
        float rsv[2][4];
#pragma unroll
        for (int ai = 0; ai < 2; ++ai)
#pragma unroll
            for (int m = 0; m < 4; ++m) rsv[ai][m] = ss ? row_rs(ss, row0 + ai * HALF + m * 16) * wsc : 1.0f;
#pragma unroll
        for (int ai = 0; ai < 2; ++ai)
#pragma unroll
            for (int m = 0; m < 4; ++m) { const int row = row0 + ai * HALF + m * 16; const float rs = rsv[ai][m]; bf16_t* rowp = O + (size_t)row * ldc + col0;
#pragma unroll
                for (int bj = 0; bj < 2; ++bj) *(u32x4*)(rowp + bj * HALF) = pack8(acc[ai][bj][m][0] * rs, acc[ai][bj][m][1] * rs); }
    }
};
struct EpiGlu {
    static constexpr bool PERM = true, AFTER_DRAIN = false;
    bf16_t* O;
    __device__ __forceinline__ void operator()(const acc_t& acc, const Unit& u, int wr, int wc, int fr, int fq) const {
        const int row0 = u.pm * BM + wr * 64 + fr, col0 = u.pn * HALF + wc * 32 + 8 * fq;
#pragma unroll
        for (int ai = 0; ai < 2; ++ai)
#pragma unroll
            for (int m = 0; m < 4; ++m) { const int row = row0 + ai * HALF + m * 16; f32x4 o[2];
#pragma unroll
                for (int n = 0; n < 2; ++n)
#pragma unroll
                    for (int j = 0; j < 4; ++j) o[n][j] = acc[ai][0][m][n][j] * sigmoidf_(acc[ai][1][m][n][j]);
                *(u32x4*)(O + (size_t)row * SSMW + col0) = pack8(o[0], o[1]); }
    }
};
struct EpiGate {
    static constexpr bool PERM = true, AFTER_DRAIN = false;
    bf16_t* S; const float* rstd; float wsc;
    __device__ __forceinline__ void operator()(const acc_t& acc, const Unit& u, int wr, int wc, int fr, int fq) const {
        const int row0 = u.pm * BM + wr * 64 + fr, col0 = u.pn * BM + wc * 32 + 8 * fq;
        float rsv[2][4];
#pragma unroll
        for (int ai = 0; ai < 2; ++ai)
#pragma unroll
            for (int m = 0; m < 4; ++m) rsv[ai][m] = rstd[row0 + ai * HALF + m * 16] * wsc;
#pragma unroll
        for (int ai = 0; ai < 2; ++ai)
#pragma unroll
            for (int m = 0; m < 4; ++m) { const int row = row0 + ai * HALF + m * 16; const float rs = rsv[ai][m]; bf16_t* rowp = S + (size_t)row * D + col0; u32x4 pk = {0u, 0u, 0u, 0u}; (void)rowp; (void)row;
#pragma unroll
                for (int bj = 0; bj < 2; ++bj) { f32x4 o[2];
#pragma unroll
                    for (int n = 0; n < 2; ++n)
#pragma unroll
                        for (int j = 0; j < 4; ++j) o[n][j] = sigmoidf_(acc[ai][bj][m][n][j] * rs);
#if S_U8 == 2
                    u32x2 w8 = {0u, 0u};
#pragma unroll
                    for (int j = 0; j < 4; ++j) { w8.x = __builtin_amdgcn_cvt_pk_u8_f32(o[0][j] * 255.0f, j, w8.x); w8.y = __builtin_amdgcn_cvt_pk_u8_f32(o[1][j] * 255.0f, j, w8.y); }
                    if (bj == 0) { pk.x = w8.x; pk.y = w8.y; } else { pk.z = w8.x; pk.w = w8.y; } }
                *((u32x4*)S + ((size_t)(u.pm * 4 + u.pn) * 8 + ai * 4 + m) * NTHREADS + ((wr * 4 + wc) * 64 + fq * 16 + fr)) = pk; }
#elif S_U8
                    u32x2 w8 = {0u, 0u};
#pragma unroll
                    for (int j = 0; j < 4; ++j) { w8.x = __builtin_amdgcn_cvt_pk_u8_f32(o[0][j] * 255.0f, j, w8.x); w8.y = __builtin_amdgcn_cvt_pk_u8_f32(o[1][j] * 255.0f, j, w8.y); }
                    *(u32x2*)((unsigned char*)S + (size_t)row * D + col0 + bj * HALF) = w8; } }
#else
                    *(u32x4*)(rowp + bj * HALF) = pack8(o[0], o[1]); } }
#endif
    }
};
#if EPI_NT
#define EPI_LD16(p) __builtin_nontemporal_load((const u32x4*)(p))
#else
#define EPI_LD16(p) (*(const u32x4*)(p))
#endif
template <bool FIRST> struct EpiMerge {
    static constexpr bool PERM = true, AFTER_DRAIN = false;
    const bf16_t* S; bf16_t* Mg; float sc;
    __device__ __forceinline__ void operator()(const acc_t& acc, const Unit& u, int wr, int wc, int fr, int fq) const {
        const int row0 = u.pm * BM + wr * 64 + fr, col0 = u.pn * BM + wc * 32 + 8 * fq;
#pragma unroll
        for (int ai = 0; ai < 2; ++ai) {
#if S_U8 == 2
            u32x4 sp[4]; u32x2 sv[4][2]; u32x4 gv[4][2];
#elif S_U8
            u32x2 sv[4][2]; u32x4 gv[4][2];
#else
            u32x4 sv[4][2], gv[4][2];
#endif
#pragma unroll
            for (int m = 0; m < 4; ++m) { const size_t off = (size_t)(row0 + ai * HALF + m * 16) * D + col0;
#if S_U8 == 2
                sp[m] = *((const u32x4*)S + ((size_t)(u.pm * 4 + u.pn) * 8 + ai * 4 + m) * NTHREADS + ((wr * 4 + wc) * 64 + fq * 16 + fr));
#endif
#pragma unroll
                for (int bj = 0; bj < 2; ++bj) {
#if S_U8 == 2
#elif S_U8
                    sv[m][bj] = *(const u32x2*)((const unsigned char*)S + off + bj * HALF);
#else
                    sv[m][bj] = EPI_LD16(S + off + bj * HALF);
#endif
                    if (!FIRST) gv[m][bj] = EPI_LD16(Mg + off + bj * HALF); } }
            asm volatile("" ::: "memory");
#pragma unroll
            for (int m = 0; m < 4; ++m) { const size_t off = (size_t)(row0 + ai * HALF + m * 16) * D + col0;
#pragma unroll
                for (int bj = 0; bj < 2; ++bj) { f32x4 s0, s1, g0, g1;
#if S_U8 == 2
                    sv[m][bj] = bj == 0 ? (u32x2){sp[m].x, sp[m].y} : (u32x2){sp[m].z, sp[m].w};
#endif
#if S_U8
                    { const unsigned wa = sv[m][bj].x, wb = sv[m][bj].y;
                      s0 = (f32x4){(float)((wa >> 0) & 0xffu), (float)((wa >> 8) & 0xffu), (float)((wa >> 16) & 0xffu), (float)((wa >> 24) & 0xffu)};
                      s1 = (f32x4){(float)((wb >> 0) & 0xffu), (float)((wb >> 8) & 0xffu), (float)((wb >> 16) & 0xffu), (float)((wb >> 24) & 0xffu)}; }
#else
                    unpack8(sv[m][bj], s0, s1);
#endif
                    if (FIRST) { g0 = (f32x4){0.f, 0.f, 0.f, 0.f}; g1 = g0; } else unpack8(gv[m][bj], g0, g1);
                    g0 += s0 * acc[ai][bj][m][0] * sc; g1 += s1 * acc[ai][bj][m][1] * sc;
                    *(u32x4*)(Mg + off + bj * HALF) = pack8(g0, g1); } }
            asm volatile("" ::: "memory");
        }
    }
};
#if XB16
struct EpiOut {
    static constexpr bool PERM = true, AFTER_DRAIN = false;
    const bf16_t* xa; bf16_t* xb; float* ss; unsigned char* h8;
    __device__ __forceinline__ void operator()(const acc_t& acc, const Unit& u, int wr, int wc, int fr, int fq) const {
        const int row0 = u.pm * BM + wr * 64 + fr, col0 = u.pn * BM + wc * 32 + 8 * fq;
#pragma unroll
        for (int ai = 0; ai < 2; ++ai) {
            u32x4 xv[4][2];
#pragma unroll
            for (int m = 0; m < 4; ++m) { const size_t off = (size_t)(row0 + ai * HALF + m * 16) * D + col0;
#pragma unroll
                for (int bj = 0; bj < 2; ++bj) xv[m][bj] = EPI_LD16(xa + off + bj * HALF); }
            asm volatile("" ::: "memory");
#pragma unroll
            for (int m = 0; m < 4; ++m) { const int row = row0 + ai * HALF + m * 16; const size_t off = (size_t)row * D + col0; float sq = 0.f;
#pragma unroll
                for (int bj = 0; bj < 2; ++bj) { f32x4 a0, a1; unpack8(xv[m][bj], a0, a1); a0 += acc[ai][bj][m][0]; a1 += acc[ai][bj][m][1];
                    *(u32x4*)(xb + off + bj * HALF) = pack8(a0, a1);
                    sq += ((a0[0] * a0[0] + a0[1] * a0[1]) + (a0[2] * a0[2] + a0[3] * a0[3])) + ((a1[0] * a1[0] + a1[1] * a1[1]) + (a1[2] * a1[2] + a1[3] * a1[3]));
                    if (Q_F8) { u32x2 w8; w8.x = pk4_fp8(a0[0], a0[1], a0[2], a0[3]); w8.y = pk4_fp8(a1[0], a1[1], a1[2], a1[3]); *(u32x2*)(h8 + off + bj * HALF) = w8; } }
                sq += shx<16>(sq); sq += shx<32>(sq);
                if (fq == 0) st_wt(ss + (size_t)row * 16 + u.pn * 4 + wc, sq); }
            asm volatile("" ::: "memory");
        }
    }
};
#else
struct EpiOut {
    static constexpr bool PERM = true, AFTER_DRAIN = false;
    const float* xin; float* xout; bf16_t* xg; const float* g; float* ss; unsigned char* h8;
    __device__ __forceinline__ void operator()(const acc_t& acc, const Unit& u, int wr, int wc, int fr, int fq) const {
        const int row0 = u.pm * BM + wr * 64 + fr, col0 = u.pn * BM + wc * 32 + 8 * fq;
        f32x4 gv[2][2];
#pragma unroll
        for (int bj = 0; bj < 2; ++bj)
#pragma unroll
            for (int n = 0; n < 2; ++n) gv[bj][n] = *(const f32x4*)(g + col0 + bj * HALF + 4 * n);
#pragma unroll
        for (int ai = 0; ai < 2; ++ai)
#pragma unroll
            for (int mh = 0; mh < 2; ++mh) {
                f32x4 xr[2][2][2];
#pragma unroll
                for (int mm = 0; mm < 2; ++mm) { const size_t off = (size_t)(row0 + ai * HALF + (2 * mh + mm) * 16) * D + col0;
#pragma unroll
                    for (int bj = 0; bj < 2; ++bj)
#pragma unroll
                        for (int n = 0; n < 2; ++n) xr[mm][bj][n] = *(const f32x4*)(xin + off + bj * HALF + 4 * n); }
                asm volatile("" ::: "memory");
#pragma unroll
                for (int mm = 0; mm < 2; ++mm) { const int m = 2 * mh + mm; const int row = row0 + ai * HALF + m * 16; const size_t off = (size_t)row * D + col0; float sq = 0.f;
#pragma unroll
                    for (int bj = 0; bj < 2; ++bj) { f32x4 x1[2], xs[2];
#pragma unroll
                        for (int n = 0; n < 2; ++n) { x1[n] = xr[mm][bj][n] + acc[ai][bj][m][n];
                            *(f32x4*)(xout + off + bj * HALF + 4 * n) = x1[n]; sq += (x1[n][0] * x1[n][0] + x1[n][1] * x1[n][1]) + (x1[n][2] * x1[n][2] + x1[n][3] * x1[n][3]); xs[n] = x1[n] * gv[bj][n]; }
                        *(u32x4*)(xg + off + bj * HALF) = pack8(xs[0], xs[1]);
                        if (Q_F8) { u32x2 w8; w8.x = pk4_fp8(xs[0][0], xs[0][1], xs[0][2], xs[0][3]); w8.y = pk4_fp8(xs[1][0], xs[1][1], xs[1][2], xs[1][3]); *(u32x2*)(h8 + off + bj * HALF) = w8; } }
                    sq += shx<16>(sq); sq += shx<32>(sq);
                    if (fq == 0) st_wt(ss + (size_t)row * 16 + u.pn * 4 + wc, sq); }
                asm volatile("" ::: "memory");
            }
    }
};
#endif
template <class Epi, class Sched, bool ALIGN_EPI = false, bool SP2 = false, bool F8 = false>
__device__ __forceinline__ void gemm_phase(PG8_LAS unsigned char* lds, const Gemm g, const Sched& S, const Epi& E, int tid0) {
    int tid_ = tid0; asm volatile("" : "+v"(tid_));
    const int tid = tid_, wid = __builtin_amdgcn_readfirstlane(tid >> 6), lane = tid & 63, wr = wid >> 2, wc = wid & 3, fr = lane & 15, fq = lane >> 4;
    const int K = g.K, nt = K / BK, lda = g.lda, ldb = g.ldb;
    unsigned voffA[2], voffB[2];
#pragma unroll
    for (int i = 0; i < 2; ++i) { int R, C; stage_rc(tid * 16 + i * 8192, R, C); const int Rb = Epi::PERM ? ((R & ~31) + perm32(R & 31)) : R;
        voffA[i] = (unsigned)(R * lda + C) * 2u; voffB[i] = (unsigned)(Rb * ldb + C) * 2u; }
    const size_t kstep = (size_t)(BK * 2);
    const size_t hstepA = (size_t)HALF * lda * 2, hstepB = (size_t)HALF * ldb * 2;
    const size_t tstepA = 2 * hstepA, tstepB = 2 * hstepB;
    const unsigned ldsw = (unsigned)wid * 1024u;
    const int aoff = lds_byte(wr * 64 + fr, fq * 8), boff = lds_byte(wc * 32 + fr, fq * 8);
#define PG8_SA(b, h) (((b) * 2 + (h)) * HTB)
#define PG8_SB(b, h) ((4 + (b) * 2 + (h)) * HTB)
#define PG8_STAGE(bufoff, gbase, voff) do { const char* gb_ = (const char*)(gbase); asm volatile("" : "+s"(gb_));     \
        _Pragma("unroll") for (int _i = 0; _i < 2; ++_i) { unsigned vo_ = (voff)[_i]; asm volatile("" : "+v"(vo_));       \
        __builtin_amdgcn_global_load_lds((const unsigned*)(gb_ + vo_), (PG8_LAS unsigned*)(lds + (bufoff) + ldsw + _i * 8192), 16, 0, 0); } } while (0)
#define PG8_LDA(dst, b, h) do { if constexpr (F8) { _Pragma("unroll") for (int m = 0; m < 4; ++m) { const i32x4_t lo_ = *(const PG8_LAS i32x4_t*)(lds + PG8_SA(b, h) + aoff + m * 2048), hi_ = *(const PG8_LAS i32x4_t*)(lds + PG8_SA(b, h) + aoff + m * 2048 + 1024); \
            dst##8[m] = __builtin_shufflevector(lo_, hi_, 0, 1, 2, 3, 4, 5, 6, 7); } } \
        else { _Pragma("unroll") for (int m = 0; m < 4; ++m) _Pragma("unroll") for (int k = 0; k < 2; ++k) dst[m][k] = *(const PG8_LAS bf16x8*)(lds + PG8_SA(b, h) + aoff + m * 2048 + k * 1024); } } while (0)
#define PG8_LDB(dst, b, h) do { if constexpr (F8) { _Pragma("unroll") for (int n = 0; n < 2; ++n) { const i32x4_t lo_ = *(const PG8_LAS i32x4_t*)(lds + PG8_SB(b, h) + boff + n * 2048), hi_ = *(const PG8_LAS i32x4_t*)(lds + PG8_SB(b, h) + boff + n * 2048 + 1024); \
            dst##8[n] = __builtin_shufflevector(lo_, hi_, 0, 1, 2, 3, 4, 5, 6, 7); } } \
        else { _Pragma("unroll") for (int n = 0; n < 2; ++n) _Pragma("unroll") for (int k = 0; k < 2; ++k) dst[n][k] = *(const PG8_LAS bf16x8*)(lds + PG8_SB(b, h) + boff + n * 2048 + k * 1024); } } while (0)
#define PG8_MMA(ai, bj, At, Bt) do { __builtin_amdgcn_s_setprio(1); _Pragma("unroll") for (int m = 0; m < 4; ++m) _Pragma("unroll") for (int n = 0; n < 2; ++n) { \
        if constexpr (F8) acc[ai][bj][m][n] = __builtin_amdgcn_mfma_scale_f32_16x16x128_f8f6f4(Bt##8[n], At##8[m], acc[ai][bj][m][n], 0, 0, 0, 0, 0, 0); \
        else { _Pragma("unroll") for (int k = 0; k < 2; ++k) acc[ai][bj][m][n] = __builtin_amdgcn_mfma_f32_16x16x32_bf16(Bt[n][k], At[m][k], acc[ai][bj][m][n], 0, 0, 0); } } __builtin_amdgcn_s_setprio(0); } while (0)
#define PG8_WAIT_V(n) asm volatile("s_waitcnt vmcnt(" #n ")" ::: "memory")
#define PG8_WAIT_L(n) asm volatile("s_waitcnt lgkmcnt(" #n ")" ::: "memory")
#define PG8_BAR __builtin_amdgcn_s_barrier()
#define PG8_SCHED __builtin_amdgcn_sched_barrier(0)
    Unit cur, nxt; int ui = 0;
    if (!S.next(0, cur)) return;
    f32x4 acc[2][2][4][2];
#pragma unroll
    for (int a = 0; a < 2; ++a)
#pragma unroll
        for (int b = 0; b < 2; ++b)
#pragma unroll
            for (int m = 0; m < 4; ++m)
#pragma unroll
                for (int n = 0; n < 2; ++n) acc[a][b][m][n] = (f32x4){0.f, 0.f, 0.f, 0.f};
    bf16x8 At[4][2], B0[2][2], B1[2][2];
    i32x8_t At8[4], B08[2], B18[2];
    const char* cA = (const char*)g.A + (size_t)cur.pm * tstepA; const char* cB = (const char*)g.Bt + (size_t)cur.pn * tstepB;
    S.a_ready(cur);
    if constexpr (SP2) {
        PG8_STAGE(PG8_SB(0, 0), cB, voffB); PG8_STAGE(PG8_SB(0, 1), cB + hstepB, voffB); PG8_STAGE(PG8_SA(0, 0), cA, voffA); PG8_STAGE(PG8_SA(0, 1), cA + hstepA, voffA);
        if (wr == 1) PG8_BAR;
        PG8_WAIT_V(2); PG8_BAR;
        PG8_STAGE(PG8_SB(1, 0), cB + kstep, voffB); PG8_STAGE(PG8_SA(1, 0), cA + kstep, voffA); PG8_STAGE(PG8_SB(1, 1), cB + hstepB + kstep, voffB);
        PG8_WAIT_V(6); PG8_BAR;
    } else {
        PG8_STAGE(PG8_SB(0, 0), cB, voffB); PG8_STAGE(PG8_SA(0, 0), cA, voffA); PG8_STAGE(PG8_SB(0, 1), cB + hstepB, voffB); PG8_STAGE(PG8_SA(0, 1), cA + hstepA, voffA);
        if (wr == 1) PG8_BAR;
        PG8_WAIT_V(4); PG8_BAR;
        PG8_STAGE(PG8_SB(1, 0), cB + kstep, voffB); PG8_STAGE(PG8_SA(1, 0), cA + kstep, voffA); PG8_STAGE(PG8_SB(1, 1), cB + hstepB + kstep, voffB);
        PG8_WAIT_V(6); PG8_BAR;
    }
    for (;;) {
        const bool has_next = S.next(ui + 1, nxt);
        const char* nA = has_next ? (const char*)g.A + (size_t)nxt.pm * tstepA : cA; const char* nB = has_next ? (const char*)g.Bt + (size_t)nxt.pn * tstepB : cB;
#pragma nounroll
        for (int t = 0; t < nt; t += 2) {
            const bool last = (t == nt - 2);
            const char* a1 = cA + (size_t)(t + 1) * kstep;
            const char* a2 = last ? nA : cA + (size_t)(t + 2) * kstep; const char* b2 = last ? nB : cB + (size_t)(t + 2) * kstep;
            const char* a3 = a2 + kstep; const char* b3 = b2 + kstep;
            if (last && has_next) S.a_ready(nxt);
            if constexpr (SP2) {
            PG8_LDB(B0, 0, 0); PG8_LDB(B1, 0, 1); PG8_SCHED; PG8_LDA(At, 0, 0); PG8_STAGE(PG8_SA(1, 1), a1 + hstepA, voffA);
            PG8_WAIT_V(8); PG8_WAIT_L(0); PG8_BAR; PG8_MMA(0, 0, At, B0); PG8_MMA(0, 1, At, B1); PG8_BAR; PG8_SCHED;
            PG8_LDA(At, 0, 1); PG8_STAGE(PG8_SB(0, 0), b2, voffB); PG8_STAGE(PG8_SB(0, 1), b2 + hstepB, voffB); PG8_STAGE(PG8_SA(0, 0), a2, voffA);
            PG8_WAIT_V(8); PG8_WAIT_L(0); PG8_BAR; PG8_MMA(1, 0, At, B0); PG8_MMA(1, 1, At, B1); PG8_BAR; PG8_SCHED;
            PG8_LDB(B0, 1, 0); PG8_LDB(B1, 1, 1); PG8_SCHED; PG8_LDA(At, 1, 0); PG8_STAGE(PG8_SA(0, 1), a2 + hstepA, voffA);
            PG8_WAIT_V(8); PG8_WAIT_L(0); PG8_BAR; PG8_MMA(0, 0, At, B0); PG8_MMA(0, 1, At, B1); PG8_BAR; PG8_SCHED;
            PG8_LDA(At, 1, 1); PG8_STAGE(PG8_SB(1, 0), b3, voffB); PG8_STAGE(PG8_SB(1, 1), b3 + hstepB, voffB); PG8_STAGE(PG8_SA(1, 0), a3, voffA);
            PG8_WAIT_V(8); PG8_WAIT_L(0); PG8_BAR; PG8_MMA(1, 0, At, B0); PG8_MMA(1, 1, At, B1); PG8_BAR; PG8_SCHED;
            } else {
            PG8_LDB(B0, 0, 0); PG8_SCHED; PG8_LDA(At, 0, 0); PG8_STAGE(PG8_SA(1, 1), a1 + hstepA, voffA);
            PG8_WAIT_L(8); PG8_BAR; PG8_WAIT_L(0); PG8_MMA(0, 0, At, B0); PG8_BAR; PG8_SCHED;
            PG8_LDB(B1, 0, 1); PG8_STAGE(PG8_SB(0, 0), b2, voffB);
            PG8_BAR; PG8_WAIT_L(0); PG8_MMA(0, 1, At, B1); PG8_BAR;
            PG8_LDA(At, 0, 1); PG8_STAGE(PG8_SA(0, 0), a2, voffA);
            PG8_BAR; PG8_WAIT_L(0); PG8_MMA(1, 0, At, B0); PG8_BAR; PG8_SCHED;
            PG8_STAGE(PG8_SB(0, 1), b2 + hstepB, voffB);
            PG8_WAIT_V(6); PG8_BAR; PG8_MMA(1, 1, At, B1); PG8_BAR;
            PG8_LDB(B0, 1, 0); PG8_SCHED; PG8_LDA(At, 1, 0); PG8_STAGE(PG8_SA(0, 1), a2 + hstepA, voffA);
            PG8_WAIT_L(8); PG8_BAR; PG8_WAIT_L(0); PG8_MMA(0, 0, At, B0); PG8_BAR; PG8_SCHED;
            PG8_LDB(B1, 1, 1); PG8_STAGE(PG8_SB(1, 0), b3, voffB);
            PG8_BAR; PG8_WAIT_L(0); PG8_MMA(0, 1, At, B1); PG8_BAR;
            PG8_LDA(At, 1, 1); PG8_STAGE(PG8_SA(1, 0), a3, voffA);
            PG8_BAR; PG8_WAIT_L(0); PG8_MMA(1, 0, At, B0); PG8_BAR; PG8_SCHED;
            PG8_STAGE(PG8_SB(1, 1), b3 + hstepB, voffB);
            PG8_WAIT_V(6); PG8_BAR; PG8_MMA(1, 1, At, B1); PG8_BAR;
            }
        }
        if constexpr (ALIGN_EPI) { if (wr == 0) PG8_BAR; }
        if constexpr (!Epi::AFTER_DRAIN) { int te = tid; if constexpr (F8) asm volatile("" : "+v"(te));
            E(acc, cur, wr, wc, te & 15, (te & 63) >> 4); S.done(cur); }
        if (!has_next) break;
#pragma unroll
        for (int a = 0; a < 2; ++a)
#pragma unroll
            for (int b = 0; b < 2; ++b)
#pragma unroll
                for (int m = 0; m < 4; ++m)
#pragma unroll
                    for (int n = 0; n < 2; ++n) acc[a][b][m][n] = (f32x4){0.f, 0.f, 0.f, 0.f};
        cur = nxt; cA = nA; cB = nB; ++ui;
        if constexpr (ALIGN_EPI) { if (wr == 1) PG8_BAR; }
    }
    PG8_WAIT_V(0);
    if constexpr (!ALIGN_EPI) { if (wr == 0) PG8_BAR; }
    PG8_BAR;
    if constexpr (Epi::AFTER_DRAIN) { E.fused(acc, cur, wr, wc, fr, fq, lds, wid, lane); S.done(cur); }
#undef PG8_SA
#undef PG8_SB
#undef PG8_STAGE
#undef PG8_LDA
#undef PG8_LDB
#undef PG8_MMA
#undef PG8_WAIT_V
#undef PG8_WAIT_L
#undef PG8_BAR
#undef PG8_SCHED
}
}
struct Args { const void* in[26]; float* out; unsigned char* ws; };
enum { I_X = 0, I_POS, I_N1G, I_WIN, I_POOLW, I_POOLS, I_PPROJ, I_ARE, I_AIM, I_LDT, I_BRE, I_BIM, I_CRE, I_CIM, I_SD, I_GLU, I_SPROJ, I_APROJ, I_WOUT, I_N2G, I_WQ, I_K1, I_K2, I_PU, I_PV, I_FG };

struct Ctx {
    int tid, lane, wave, G, bid;
    int gw, ngw;
    int gt, ngt;
    LAS unsigned char* lds;
};

__device__ __forceinline__ void cis_f(float ang, float& c, float& s) {
    const double r = (double)ang * 0.15915494309189535;
    const double fr = r - __builtin_rint(r);
    const float f = (float)fr;
    c = __builtin_amdgcn_cosf(f); s = __builtin_amdgcn_sinf(f);
}

template <class RowMap>
__device__ __forceinline__ void p0_transpose_item(const float* W, int K, int N, bf16_t* WT, RowMap rm, LAS float* scr, int item, int lane, const float* gk = nullptr) {
    const int nblk = N / 32, kb = item / nblk, nb = item % nblk, k0 = 64 * kb, n0 = 32 * nb;
#pragma unroll 8
    for (int i = 0; i < 32; ++i) { const int kk = 2 * i + (lane >> 5); scr[kk * 33 + (lane & 31)] = W[(size_t)(k0 + kk) * N + n0 + (lane & 31)] * (gk ? gk[k0 + kk] : 1.0f); }
    LDS_WAIT(); asm volatile("" ::: "memory");
    const int c = lane & 7;
#pragma unroll
    for (int j = 0; j < 4; ++j) { const int n = (lane >> 3) + 8 * j; const LAS float* s = scr + (8 * c) * 33 + n;
        u32x4 o; o.x = pk2(s[0 * 33], s[1 * 33]); o.y = pk2(s[2 * 33], s[3 * 33]); o.z = pk2(s[4 * 33], s[5 * 33]); o.w = pk2(s[6 * 33], s[7 * 33]);
        *(u32x4*)(WT + (size_t)rm(n0 + n) * K + k0 + 8 * c) = o; }
    LDS_WAIT(); asm volatile("" ::: "memory");
}
__device__ __forceinline__ void p0_transpose_item_f8(const float* W, int K, int N, unsigned char* WT8, int nbase, float sc, LAS float* scr, int item, int lane, const float* gk = nullptr) {
    const int nblk = N / 32, kb = item / nblk, nb = item % nblk, k0 = 64 * kb, n0 = 32 * nb;
#pragma unroll 8
    for (int i = 0; i < 32; ++i) { const int kk = 2 * i + (lane >> 5); scr[kk * 33 + (lane & 31)] = W[(size_t)(k0 + kk) * N + n0 + (lane & 31)] * (gk ? gk[k0 + kk] : 1.0f); }
    LDS_WAIT(); asm volatile("" ::: "memory");
    const int c = lane & 7;
#pragma unroll
    for (int j = 0; j < 4; ++j) { const int n = (lane >> 3) + 8 * j; const LAS float* s = scr + (8 * c) * 33 + n;
        u32x2 o; o.x = pk4_fp8(s[0 * 33] * sc, s[1 * 33] * sc, s[2 * 33] * sc, s[3 * 33] * sc); o.y = pk4_fp8(s[4 * 33] * sc, s[5 * 33] * sc, s[6 * 33] * sc, s[7 * 33] * sc);
        *(u32x2*)(WT8 + (size_t)(n0 + n - nbase) * K + k0 + 8 * c) = o; }
    LDS_WAIT(); asm volatile("" ::: "memory");
}
struct RmId { __device__ __forceinline__ int operator()(int n) const { return n; } };
struct RmGlu { __device__ __forceinline__ int operator()(int n) const { return 256 * ((n & 511) >> 7) + 128 * (n >> 9) + (n & 127); } };

__device__ __forceinline__ void convert_f16(const Ctx& C, const float* src, unsigned short* dst, size_t n8) {
    for (size_t i = C.gt; i < n8; i += C.ngt) { const f32x4 a = *(const f32x4*)(src + i * 8), b = *(const f32x4*)(src + i * 8 + 4);
        u32x4 o; o.x = pkh2(a[0], a[1]); o.y = pkh2(a[2], a[3]); o.z = pkh2(b[0], b[1]); o.w = pkh2(b[2], b[3]); *(u32x4*)(dst + i * 8) = o; }
}
__device__ __forceinline__ void norm_row(const float* xrow, const float* g, bf16_t* orow, unsigned char* h8row, float* rstd_out, int lane, float* frow = nullptr) {
    f32x4 v[4]; float s = 0.f;
#pragma unroll
    for (int j = 0; j < 4; ++j) { v[j] = *((const f32x4*)xrow + lane + 64 * j); s += (v[j][0] * v[j][0] + v[j][1] * v[j][1]) + (v[j][2] * v[j][2] + v[j][3] * v[j][3]); }
    s = wave_sum(s);
#pragma unroll
    for (int j = 0; j < 4; ++j) { const f32x4 gg = *((const f32x4*)g + lane + 64 * j); const f32x4 o = XB16 ? v[j] : v[j] * gg; u32x2 w; w.x = pk2(o[0], o[1]); w.y = pk2(o[2], o[3]); *((u32x2*)orow + lane + 64 * j) = w;
        if (GATE_F8) *((unsigned*)h8row + lane + 64 * j) = pk4_fp8(o[0], o[1], o[2], o[3]);
 }
    if (lane == 0) st_wt(rstd_out, __builtin_amdgcn_rsqf(s * (1.0f / D) + EPS));
}

__device__ __forceinline__ void quant_load(const float* usrc, const float* vsrc, int lane, f32x4 (&u)[4], f32x4 (&v)[4]) {
#pragma unroll
    for (int j = 0; j < 4; ++j) { u[j] = *((const f32x4*)usrc + 4 * lane + j); v[j] = *((const f32x4*)vsrc + 4 * lane + j); }
}
__device__ __forceinline__ void quant_finish(const f32x4 (&u)[4], const f32x4 (&v)[4], unsigned char* dst, int e, float* su_out, float* sv_out, int lane) {
    float mu = 0.f, mv = 0.f;
#pragma unroll
    for (int j = 0; j < 4; ++j) {
        mu = fmaxf(mu, fmaxf(fmaxf(fabsf(u[j][0]), fabsf(u[j][1])), fmaxf(fabsf(u[j][2]), fabsf(u[j][3])))); mv = fmaxf(mv, fmaxf(fmaxf(fabsf(v[j][0]), fabsf(v[j][1])), fmaxf(fabsf(v[j][2]), fabsf(v[j][3])))); }
    mu = wave_max(mu); mv = wave_max(mv);
    const float su = fmaxf(mu, 1e-30f) * (PEER_MFMA ? (1.0f / 6.0f) : (1.0f / 7.0f)), iu = 1.0f / su, sv = fmaxf(mv, 1e-30f) * (1.0f / 6.0f), iv = 1.0f / sv;
    unsigned w[4];
#if PEER_MFMA
#pragma unroll
    for (int dd = 0; dd < 2; ++dd) { unsigned t = 0u;
#pragma unroll
        for (int j = 0; j < 8; ++j) { const float x = u[2 * dd + (j >> 2)][j & 3] * iu, ax = fabsf(x);
            const unsigned c = (unsigned)(ax > 0.25f) + (unsigned)(ax > 0.75f) + (unsigned)(ax > 1.25f) + (unsigned)(ax > 1.75f) + (unsigned)(ax > 2.5f) + (unsigned)(ax > 3.5f) + (unsigned)(ax > 5.0f);
            t |= (c | (x < 0.f ? 8u : 0u)) << (4 * j); }
        w[dd] = t; }
#else
#pragma unroll
    for (int dd = 0; dd < 2; ++dd) { unsigned t = 0u;
#pragma unroll
        for (int j = 0; j < 8; ++j) { const float x = u[2 * dd + (j >> 2)][j & 3] * iu; int q = (int)rintf(x); q = q > 7 ? 7 : (q < -7 ? -7 : q); t |= ((unsigned)q & 15u) << (4 * j); }
        w[dd] = t; }
#endif
#pragma unroll
    for (int dd = 0; dd < 2; ++dd) { unsigned t = 0u;
        t = __builtin_amdgcn_cvt_scalef32_pk_fp4_f32(t, v[2 * dd][0] * iv, v[2 * dd][1] * iv, 1.0f, 0); t = __builtin_amdgcn_cvt_scalef32_pk_fp4_f32(t, v[2 * dd][2] * iv, v[2 * dd][3] * iv, 1.0f, 1);
        t = __builtin_amdgcn_cvt_scalef32_pk_fp4_f32(t, v[2 * dd + 1][0] * iv, v[2 * dd + 1][1] * iv, 1.0f, 2); t = __builtin_amdgcn_cvt_scalef32_pk_fp4_f32(t, v[2 * dd + 1][2] * iv, v[2 * dd + 1][3] * iv, 1.0f, 3); w[2 + dd] = t; }
#if PEER_SLICED
    *(u32x2*)(dst + (size_t)(lane >> 3) * MiB + (size_t)e * 64 + (lane & 7) * 8) = (u32x2){w[0], w[1]};
    *((u32x2*)(dst + 16 * MiB + (size_t)e * 512) + lane) = (u32x2){w[2], w[3]};
#elif PEER_MFMA
    *((u32x2*)(dst + (size_t)e * 1024) + lane) = (u32x2){w[0], w[1]};
    *((u32x2*)(dst + (size_t)e * 1024 + 512) + lane) = (u32x2){w[2], w[3]};
#else
    *((u32x4*)(dst + (size_t)e * 1024) + lane) = (u32x4){w[0], w[1], w[2], w[3]};
#endif
    if (lane == 0) { st_wt(su_out, su); st_wt(sv_out, sv); }
}
__device__ __forceinline__ void quant_expert(const float* usrc, const float* vsrc, unsigned char* dst, int e, float* su_out, float* sv_out, int lane) {
    f32x4 u[4], v[4]; quant_load(usrc, vsrc, lane, u, v); quant_finish(u, v, dst, e, su_out, sv_out, lane);
}
__device__ __forceinline__ void quant_rows(const float* pu, const float* pv, unsigned char* dst, float* su, float* sv, int e0, int eend, int estep, int lane) {
    if (e0 >= eend) return;
    f32x4 u[4], v[4]; quant_load(pu + (size_t)e0 * D, pv + (size_t)e0 * D, lane, u, v);
    for (int e = e0;;) {
        const int en = e + estep; f32x4 un[4], vn[4];
        if (en < eend) quant_load(pu + (size_t)en * D, pv + (size_t)en * D, lane, un, vn);
        quant_finish(u, v, dst, e, su + e, sv + e, lane);
        if (en >= eend) break;
#pragma unroll
        for (int j = 0; j < 4; ++j) { u[j] = un[j]; v[j] = vn[j]; }
        e = en;
    }
}

__device__ __forceinline__ void phase_prologue(const Ctx& C, const Args& a) {
    unsigned char* ws = a.ws;
    LAS float* scr = (LAS float*)(C.lds) + C.wave * (64 * 33);
    constexpr int I_WINI = 16 * 200, I_PP = 8 * 32, I_GL = 8 * 32, I_SP = 8 * 32, I_AP = 4 * 32, I_WO = 16 * 32, I_WQI = 16 * 64, I_LAYER = I_WINI + I_PP + I_GL + I_SP + I_AP + I_WO + I_WQI;
    for (int it = C.gw; it < DEPTH * I_LAYER; it += C.ngw) {
        const int l = it / I_LAYER; int r = it % I_LAYER; unsigned char* wl = ws + WS_W + (size_t)l * W_LAYER;
        if (GATE_F8 && r < I_WINI && (r % 200) >= NZ / 32) { p0_transpose_item_f8((const float*)a.in[I_WIN] + (size_t)l * D * IN_COLS, D, IN_COLS, wl + WO_WIN + (size_t)NZ * D * 2, NZ, GATE_WSC, scr, r, C.lane, XB16 ? (const float*)a.in[I_N1G] + (size_t)l * D : nullptr); continue; }
        if (r < I_WINI) { p0_transpose_item((const float*)a.in[I_WIN] + (size_t)l * D * IN_COLS, D, IN_COLS, (bf16_t*)(wl + WO_WIN), RmId(), scr, r, C.lane, XB16 ? (const float*)a.in[I_N1G] + (size_t)l * D : nullptr); continue; } r -= I_WINI;
        if (r < I_PP) { p0_transpose_item((const float*)a.in[I_PPROJ] + (size_t)l * POOLW * D, POOLW, D, (bf16_t*)(wl + WO_PPROJ), RmId(), scr, r, C.lane); continue; } r -= I_PP;
        if (r < I_GL) { p0_transpose_item((const float*)a.in[I_GLU] + (size_t)l * SSMW * 2 * SSMW, SSMW, 2 * SSMW, (bf16_t*)(wl + WO_GLU), RmGlu(), scr, r, C.lane); continue; } r -= I_GL;
        if (r < I_SP) { p0_transpose_item((const float*)a.in[I_SPROJ] + (size_t)l * SSMW * D, SSMW, D, (bf16_t*)(wl + WO_SPROJ), RmId(), scr, r, C.lane); continue; } r -= I_SP;
        if (r < I_AP) { p0_transpose_item((const float*)a.in[I_APROJ] + (size_t)l * AOUT * D, AOUT, D, (bf16_t*)(wl + WO_APROJ), RmId(), scr, r, C.lane); continue; } r -= I_AP;
        if (r < I_WO) { p0_transpose_item((const float*)a.in[I_WOUT] + (size_t)l * D * D, D, D, (bf16_t*)(wl + WO_WOUT), RmId(), scr, r, C.lane); continue; } r -= I_WO;
        if (Q_F8) p0_transpose_item_f8((const float*)a.in[I_WQ] + (size_t)l * D * PQ, D, PQ, wl + WO_WQ, 0, GATE_WSC, scr, r, C.lane, XB16 ? (const float*)a.in[I_N2G] + (size_t)l * D : nullptr);
        else p0_transpose_item((const float*)a.in[I_WQ] + (size_t)l * D * PQ, D, PQ, (bf16_t*)(wl + WO_WQ), RmId(), scr, r, C.lane, XB16 ? (const float*)a.in[I_N2G] + (size_t)l * D : nullptr);
    }
    for (int i = C.gt; i < DEPTH * 512 * 512; i += C.ngt) {
        const int l = i / (512 * 512), r = i % (512 * 512), n = r / 512, k = r % 512, gn = n >> 7, gk = k >> 7;
        float v = 0.f;
        if (gn == gk) v = ((const float*)a.in[I_POOLW])[((size_t)(l * 4 + gn) * 128 + (k & 127)) * 128 + (n & 127)] * ((const float*)a.in[I_POOLS])[l * POOLW + n];
        ((bf16_t*)(ws + WS_W + (size_t)l * W_LAYER + WO_POOL))[r] = (bf16_t)f2bf(v);
    }
    for (int i = C.gt; i < DEPTH * 2 * 128 * 128; i += C.ngt) {
        const int l = i / (2 * 16384), r = i % (2 * 16384), t = r / 16384, e = r % 16384;
        const float v = ((const float*)a.in[t ? I_K2 : I_K1])[(size_t)l * 16384 + e];
        ((bf16_t*)(ws + WS_W + (size_t)l * W_LAYER + (t ? WO_K2 : WO_K1)))[e] = (bf16_t)f2bf(v);
    }
    {
        const bool defer = TABQ_DEFER && C.G == 256;
        for (int l = 0; l < (defer ? 1 : DEPTH); ++l)
            quant_rows((const float*)a.in[I_PU] + (size_t)l * NEXP * D, (const float*)a.in[I_PV] + (size_t)l * NEXP * D, ws + WS_TAB + (size_t)l * TAB_LAYER,
                       (float*)(ws + WS_TSC + (size_t)l * 131072), (float*)(ws + WS_TSC + (size_t)l * 131072 + 65536), C.gw, NEXP, C.ngw, C.lane);
    }
    if (!ROPE_FLY)
    for (int i = C.gt; i < M * 32; i += C.ngt) {
        const int m = i >> 5, f = i & 31;
        const float invf = exp2f(-(float)f * (13.287712379549449f / 32.0f));
        const float ang = (float)((const int*)a.in[I_POS])[m] * invf;
        float c, s; cis_f(ang, c, s);
        ((f32x2*)(ws + WS_ROPE))[i] = (f32x2){c, s};
    }
    for (int i = C.gt; i < DEPTH * SSM_G * SSM_N; i += C.ngt) {
        const int l = i / (SSM_G * SSM_N), gn = i % (SSM_G * SSM_N), g = gn / SSM_N;
        unsigned char* sc = ws + WS_SSMC + (size_t)l * SSMC_LAYER;
        const float dt = expf(((const float*)a.in[I_LDT])[l * SSM_G + g]);
        const float ar = ((const float*)a.in[I_ARE])[i], ai = ((const float*)a.in[I_AIM])[i];
        const float decay = expf(ar * dt); float cc, ss; cis_f(ai * dt, cc, ss);
        const float abr = decay * cc, abi = decay * ss;
        const float den = ar * ar + ai * ai, nr = abr - 1.0f;
        const float kr = (nr * ar + abi * ai) / den, ki = (abi * ar - nr * ai) / den;
        ((f32x2*)sc)[gn] = (f32x2){abr, abi};
        double pr = (double)abr, pi = (double)abi;
#pragma unroll
        for (int q = 0; q < 8; ++q) { const double nr2 = pr * pr - pi * pi, ni2 = 2.0 * pr * pi; pr = nr2; pi = ni2; }
        ((f32x2*)(sc + 16384))[gn] = (f32x2){(float)pr, (float)pi};
        const float* br = (const float*)a.in[I_BRE] + (size_t)i * SSM_P; const float* bi = (const float*)a.in[I_BIM] + (size_t)i * SSM_P;
        f32x2* bb = (f32x2*)(sc + 32768) + (size_t)gn * SSM_P;
#pragma unroll
        for (int q = 0; q < SSM_P; ++q) bb[q] = (f32x2){kr * br[q] - ki * bi[q], kr * bi[q] + ki * br[q]};
    }
    for (int m = C.gw; m < M; m += C.ngw) norm_row((const float*)a.in[I_X] + (size_t)m * D, (const float*)a.in[I_N1G], (bf16_t*)(ws + WS_E) + (size_t)m * D, ws + WS_H8 + (size_t)m * D, (float*)(ws + WS_RSTD1) + m, C.lane);
}
constexpr int AT_K_OFF = 0, AT_V_OFF = 49152, AT_VROW = 160, AT_LDS = AT_V_OFF + 384 * AT_VROW;
constexpr float AT_QSCALE = 0.125f * 1.4426950408889634f;

#if ROPE_FLY
struct AttnRegs { u32x4 kx[2][2]; int kpos[2]; u32x4 vv[4]; u32x4 qx[2]; int qpos; };
__device__ __forceinline__ void rope8(int pos, int f0, f32x2 (&cs)[8]) {
#pragma unroll
    for (int q = 0; q < 8; ++q) { const float invf = fast_exp2(-(float)(f0 + q) * (13.287712379549449f / 32.0f)); const float rev = __builtin_amdgcn_fractf(((float)pos * invf) * 0.15915494309189535f);
        cs[q] = (f32x2){__builtin_amdgcn_cosf(rev), __builtin_amdgcn_sinf(rev)}; }
}
#else
struct AttnRegs { u32x4 kx[2][2]; f32x2 kr[2][8]; u32x4 vv[4]; u32x4 qx[2]; f32x2 qr[8]; };
#endif
struct AttnIdx { int b, head, grp, hs, dil, cls, nb, slot0; size_t rowb; };
__device__ __forceinline__ AttnIdx attn_idx(int it) {
    AttnIdx I; I.b = it / 768; const int rem = it % 768; I.head = rem >> 6; const int blk = rem & 63;
    I.grp = I.head >> 2; I.hs = I.head & 3; const int dsh = 2 * I.grp; I.dil = 1 << dsh; const int nbpc = 64 >> dsh; I.cls = blk / nbpc; I.nb = blk % nbpc;
    I.rowb = (size_t)I.b * SEQ; I.slot0 = 128 * (I.nb - 1); return I;
}
#if !ROPE_FLY
#error "the block-reuse attention path is written for ROPE_FLY"
#endif
__device__ __forceinline__ void attn_load_blk(const Ctx& C, const AttnIdx& I, int kb  , int s  , const bf16_t* zqkv, const int* pos, AttnRegs& R) {
    { const int e = C.tid, j = e >> 2, c = e & 3; const size_t m = I.rowb + (size_t)(128 * kb + j) * I.dil + I.cls;
      const bf16_t* kp = zqkv + m * QKVW + AW + I.head * 64 + 8 * c;
      R.kx[s][0] = *(const u32x4*)kp; R.kx[s][1] = *(const u32x4*)(kp + 32); R.kpos[s] = pos[m]; }
#pragma unroll
    for (int p = 0; p < 2; ++p) { const int e = C.tid + p * NTHREADS, j = e >> 3, c = e & 7;
        R.vv[2 * s + p] = *(const u32x4*)(zqkv + (I.rowb + (size_t)(128 * kb + j) * I.dil + I.cls) * QKVW + 2 * AW + I.head * 64 + 8 * c); }
}
__device__ __forceinline__ void attn_load(const Ctx& C, int it, bool both, const bf16_t* zqkv, const f32x2* rope, AttnRegs& R) {
    const AttnIdx I = attn_idx(it); const int* pos = (const int*)rope;
    attn_load_blk(C, I, I.nb, 1, zqkv, pos, R);
    if (both && I.nb > 0) attn_load_blk(C, I, I.nb - 1, 0, zqkv, pos, R);
    const int w = C.wave, ql = C.lane & 15, quad = C.lane >> 4;
    const size_t mq = I.rowb + (size_t)(128 * I.nb + 16 * w + ql) * I.dil + I.cls;
    const bf16_t* qp = zqkv + mq * QKVW + I.head * 64 + 8 * quad;
    R.qx[0] = *(const u32x4*)qp; R.qx[1] = *(const u32x4*)(qp + 32); R.qpos = pos[mq];
}
__device__ __forceinline__ void attn_store_blk(const Ctx& C, int hf  , int s, bool zero, const AttnRegs& R) {
    LAS unsigned char* Ks = C.lds + AT_K_OFF; LAS unsigned char* Vs = C.lds + AT_V_OFF;
    { const int e = C.tid, j = 128 * hf + (e >> 2), c = e & 3;
      u32x4 o1 = {0u, 0u, 0u, 0u}, o2 = o1;
      if (!zero) {
          const u32x4 x1 = R.kx[s][0], x2 = R.kx[s][1];
          unsigned w1[4] = {x1.x, x1.y, x1.z, x1.w}, w2[4] = {x2.x, x2.y, x2.z, x2.w}, r1[4], r2[4];
          f32x2 kcs[8]; rope8(R.kpos[s], 8 * c, kcs);
#pragma unroll
          for (int q = 0; q < 4; ++q) {
              const f32x2 cs0 = kcs[2 * q], cs1 = kcs[2 * q + 1];
              const float a0 = bflo(w1[q]), a1 = bfhi(w1[q]), b0 = bflo(w2[q]), b1 = bfhi(w2[q]);
              r1[q] = pk2(a0 * cs0[0] - b0 * cs0[1], a1 * cs1[0] - b1 * cs1[1]);
              r2[q] = pk2(b0 * cs0[0] + a0 * cs0[1], b1 * cs1[0] + a1 * cs1[1]);
          }
          o1 = (u32x4){r1[0], r1[1], r1[2], r1[3]}; o2 = (u32x4){r2[0], r2[1], r2[2], r2[3]};
      }
      *(LAS u32x4*)(Ks + j * 128 + ((c ^ (j & 7)) << 4)) = o1;
      *(LAS u32x4*)(Ks + j * 128 + (((c + 4) ^ (j & 7)) << 4)) = o2; }
#pragma unroll
    for (int p = 0; p < 2; ++p) { const int e = C.tid + p * NTHREADS, j = 128 * hf + (e >> 3), c = e & 7;
        u32x4 v = {0u, 0u, 0u, 0u};
        if (!zero) v = R.vv[2 * s + p];
        *(LAS u32x4*)(Vs + j * AT_VROW + c * 16) = v; }
}
__device__ __forceinline__ void attn_store(const Ctx& C, int it, bool both, const AttnRegs& R, bf16x8 (&qf)[2]) {
    const AttnIdx I = attn_idx(it);
    attn_store_blk(C, I.nb % 3, 1, false, R);
    if (both) attn_store_blk(C, (I.nb + 2) % 3, 0, I.nb == 0, R);
    {
        const u32x4 x1 = R.qx[0], x2 = R.qx[1];
        unsigned w1[4] = {x1.x, x1.y, x1.z, x1.w}, w2[4] = {x2.x, x2.y, x2.z, x2.w}, r1[4], r2[4];
        f32x2 qcs[8]; rope8(R.qpos, 8 * (C.lane >> 4), qcs);
#pragma unroll
        for (int q = 0; q < 4; ++q) {
            const f32x2 cs0 = qcs[2 * q] * AT_QSCALE, cs1 = qcs[2 * q + 1] * AT_QSCALE;
            const float a0 = bflo(w1[q]), a1 = bfhi(w1[q]), b0 = bflo(w2[q]), b1 = bfhi(w2[q]);
            r1[q] = pk2(a0 * cs0[0] - b0 * cs0[1], a1 * cs1[0] - b1 * cs1[1]);
            r2[q] = pk2(b0 * cs0[0] + a0 * cs0[1], b1 * cs1[0] + a1 * cs1[1]);
        }
        qf[0] = __builtin_bit_cast(bf16x8, (u32x4){r1[0], r1[1], r1[2], r1[3]}); qf[1] = __builtin_bit_cast(bf16x8, (u32x4){r2[0], r2[1], r2[2], r2[3]});
    }
}
__device__ __forceinline__ void attn_compute(const Ctx& C, int it, const bf16x8 (&qf)[2], bf16_t* og, float* lse_out) {
    const AttnIdx I = attn_idx(it);
    const int grp = I.grp, hs = I.hs, nb = I.nb;
    LAS unsigned char* Ks = C.lds + AT_K_OFF; LAS unsigned char* Vs = C.lds + AT_V_OFF;
    const int w = C.wave, ql = C.lane & 15, quad = C.lane >> 4;
    const size_t mq = I.rowb + (size_t)(128 * nb + 16 * w + ql) * I.dil + I.cls;
    const int slo = 128 * ((nb + 2) % 3), sup = 128 * (nb % 3);
    f32x4 st[9];
#pragma unroll
    for (int r = 0; r < 9; ++r) {
        const int lrow = 16 * (w + r) + ql, row = ((lrow & 128) ? sup : slo) + (lrow & 127);
        f32x4 acc = {0.f, 0.f, 0.f, 0.f};
#pragma unroll
        for (int kk = 0; kk < 2; ++kk) {
            const bf16x8 kf = *(const LAS bf16x8*)(Ks + row * 128 + (((4 * kk + quad) ^ (row & 7)) << 4));
            acc = __builtin_amdgcn_mfma_f32_16x16x32_bf16(kf, qf[kk], acc, 0, 0, 0);
        }
        st[r] = acc;
    }
    const float NEG = -INFINITY;
    float mx = NEG;
#pragma unroll
    for (int r = 0; r < 9; ++r)
#pragma unroll
        for (int i = 0; i < 4; ++i) {
            bool ok = true;
            if (r == 0) ok = (4 * quad + i >= ql);
            if (r == 8) ok = (4 * quad + i <= ql);
            if (nb == 0 && (w + r) < 8) ok = false;
            st[r][i] = ok ? st[r][i] : NEG;
            mx = fmaxf(mx, st[r][i]);
        }
    mx = fmaxf(mx, shx<16>(mx)); mx = fmaxf(mx, shx<32>(mx));
    float den = 0.f;
#pragma unroll
    for (int r = 0; r < 9; ++r)
#pragma unroll
        for (int i = 0; i < 4; ++i) { const float p = fast_exp2(st[r][i] - mx); st[r][i] = p; den += p; }
    den += shx<16>(den); den += shx<32>(den);
    f32x4 o[4];
#pragma unroll
    for (int mb = 0; mb < 4; ++mb) o[mb] = (f32x4){0.f, 0.f, 0.f, 0.f};
    const int li = C.lane & 15, trr = li >> 2, trc = li & 3;
#pragma unroll
    for (int jj = 0; jj < 5; ++jj) {
        u32x4 pw; pw.x = pk2(st[2 * jj][0], st[2 * jj][1]); pw.y = pk2(st[2 * jj][2], st[2 * jj][3]);
        if (jj < 4) { pw.z = pk2(st[2 * jj + 1][0], st[2 * jj + 1][1]); pw.w = pk2(st[2 * jj + 1][2], st[2 * jj + 1][3]); } else { pw.z = 0u; pw.w = 0u; }
        const bf16x8 pf = __builtin_bit_cast(bf16x8, pw);
        const int jb1 = w + 2 * jj; int jb2 = jb1 + 1; jb2 = jb2 > 15 ? 15 : jb2;
        const int l1 = 16 * jb1 + 4 * quad + trr, l2 = 16 * jb2 + 4 * quad + trr, row1 = ((l1 & 128) ? sup : slo) + (l1 & 127), row2 = ((l2 & 128) ? sup : slo) + (l2 & 127);
#pragma unroll
        for (int mb = 0; mb < 4; ++mb) {
            const v4i16_t lo = __builtin_amdgcn_ds_read_tr16_b64_v4i16((LAS v4i16_t*)(Vs + row1 * AT_VROW + (16 * mb + 4 * trc) * 2));
            const v4i16_t hi = __builtin_amdgcn_ds_read_tr16_b64_v4i16((LAS v4i16_t*)(Vs + row2 * AT_VROW + (16 * mb + 4 * trc) * 2));
            const bf16x8 vf = {lo[0], lo[1], lo[2], lo[3], hi[0], hi[1], hi[2], hi[3]};
            o[mb] = __builtin_amdgcn_mfma_f32_16x16x32_bf16(vf, pf, o[mb], 0, 0, 0);
        }
    }
    const float rden = 1.0f / den;
    bf16_t* op = og + ((size_t)grp * M + mq) * AOUT + hs * 64 + 4 * quad;
#pragma unroll
    for (int mb = 0; mb < 4; ++mb) { u32x2 wv; wv.x = pk2(o[mb][0] * rden, o[mb][1] * rden); wv.y = pk2(o[mb][2] * rden, o[mb][3] * rden); *(u32x2*)(op + 16 * mb) = wv; }
    if (quad == 0) st_wt(lse_out + ((size_t)grp * M + mq) * 4 + hs, (mx + __builtin_amdgcn_logf(den)) * 0.6931471805599453f);
}

__device__ __forceinline__ void attn_items(const Ctx& C, const bf16_t* zqkv, const f32x2* rope, bf16_t* og, float* lse_out) {
    constexpr int NI = BATCH * 768; const int per = (NI + C.G - 1) / C.G, lo = C.bid * per, hi = (lo + per) < NI ? (lo + per) : NI;
    int it = lo; if (it >= hi) return;
    AttnRegs R; attn_load(C, it, true, zqkv, rope, R);
    bf16x8 qf[2];
    attn_store(C, it, true, R, qf);
    __syncthreads();
    for (;;) {
        const int nxt = it + 1; const bool nboth = (nxt & ((64 >> (2 * (((nxt % 768) >> 6) >> 2))) - 1)) == 0;
        if (nxt < hi) attn_load(C, nxt, nboth, zqkv, rope, R);
        attn_compute(C, it, qf, og, lse_out);
        if (nxt >= hi) break;
        if (nboth) __syncthreads();
        attn_store(C, nxt, nboth, R, qf);
        __syncthreads();
        it = nxt;
    }
    __syncthreads();
}
typedef float f32x16 __attribute__((ext_vector_type(16)));
constexpr int SS_TILE = 32 * 256;
__device__ __forceinline__ void cstep(float& sr, float& si, float ar, float ai, float xr, float xi) { const float nr = fmaf(ar, sr, fmaf(-ai, si, xr)), ni = fmaf(ar, si, fmaf(ai, sr, xi)); sr = nr; si = ni; }
template <bool OUT>
__device__ __forceinline__ void ssm_item(const Ctx& C, int it, const bf16_t* zps, const unsigned char* sc, f32x2* send, const float* cre, const float* cim, const float* dsk, bf16_t* ssmy) {
    const int b = it / (NCH * SSM_G), rem = it % (NCH * SSM_G), c = rem / SSM_G, g = rem % SSM_G;
    const int lane = C.lane, n = lane & 31, hi = lane >> 5, tl = lane & 15, quad = lane >> 4;
    const f32x2 ab0 = ((const f32x2*)sc)[g * SSM_N + n], ab1 = ((const f32x2*)sc)[g * SSM_N + 32 + n];
    bf16x8 bfr[4];
    { const f32x4* p0 = (const f32x4*)(sc + 32768) + (size_t)(g * SSM_N + n) * 8 + 4 * hi; const f32x4* p1 = (const f32x4*)(sc + 32768) + (size_t)(g * SSM_N + 32 + n) * 8 + 4 * hi;
      const f32x4 a0 = p0[0], a1 = p0[1], a2 = p0[2], a3 = p0[3], c0 = p1[0], c1 = p1[1], c2 = p1[2], c3 = p1[3];
      bfr[0] = __builtin_bit_cast(bf16x8, (u32x4){pk2(a0[0], a0[2]), pk2(a1[0], a1[2]), pk2(a2[0], a2[2]), pk2(a3[0], a3[2])});
      bfr[2] = __builtin_bit_cast(bf16x8, (u32x4){pk2(a0[1], a0[3]), pk2(a1[1], a1[3]), pk2(a2[1], a2[3]), pk2(a3[1], a3[3])});
      bfr[1] = __builtin_bit_cast(bf16x8, (u32x4){pk2(c0[0], c0[2]), pk2(c1[0], c1[2]), pk2(c2[0], c2[2]), pk2(c3[0], c3[2])});
      bfr[3] = __builtin_bit_cast(bf16x8, (u32x4){pk2(c0[1], c0[3]), pk2(c1[1], c1[3]), pk2(c2[1], c2[3]), pk2(c3[1], c3[3])}); }
    float s0r = 0.f, s0i = 0.f, s1r = 0.f, s1i = 0.f;
    float p0r = ab0[0], p0i = ab0[1], p1r = ab1[0], p1i = ab1[1];
    if (!OUT) {
#pragma unroll
        for (int q = 0; q < 4; ++q) { const float t0 = p0r * p0r - p0i * p0i, t1 = 2.f * p0r * p0i, t2 = p1r * p1r - p1i * p1i, t3 = 2.f * p1r * p1i; p0r = t0; p0i = t1; p1r = t2; p1i = t3; }
    }
    bf16x8 cf[4]; float dq[4];
    LAS unsigned char* tile = C.lds + C.wave * SS_TILE;
    if (OUT) {
        const f32x2 aC0 = ((const f32x2*)(sc + 16384))[g * SSM_N + n], aC1 = ((const f32x2*)(sc + 16384))[g * SSM_N + 32 + n];
        const f32x2* sp = send + ((size_t)(b * NCH) * SSM_G + g) * SSM_N + n;
        f32x2 sv0[NCH], sv1[NCH];
#pragma unroll
        for (int k = 0; k < NCH; ++k) { const int kc = k < c ? k : 0; sv0[k] = sp[(size_t)kc * SSM_G * SSM_N]; sv1[k] = sp[(size_t)kc * SSM_G * SSM_N + 32]; }
#pragma unroll
        for (int k = 0; k < NCH; ++k) if (k < c) { cstep(s0r, s0i, aC0[0], aC0[1], sv0[k][0], sv0[k][1]); cstep(s1r, s1i, aC1[0], aC1[1], sv1[k][0], sv1[k][1]); }
        const float* crp = cre + ((size_t)g * SSM_P + tl) * SSM_N; const float* cip = cim + ((size_t)g * SSM_P + tl) * SSM_N;
#pragma unroll
        for (int kk = 0; kk < 4; ++kk) { const float* src = (kk < 2 ? crp : cip) + (kk & 1) * 32 + 8 * quad; const float sg = kk < 2 ? 1.f : -1.f;
            const f32x4 a = *(const f32x4*)src * sg, bq = *(const f32x4*)(src + 4) * sg;
            cf[kk] = __builtin_bit_cast(bf16x8, (u32x4){pk2(a[0], a[1]), pk2(a[2], a[3]), pk2(bq[0], bq[1]), pk2(bq[2], bq[3])}); }
#pragma unroll
        for (int i = 0; i < 4; ++i) dq[i] = dsk[g * SSM_P + 4 * quad + i];
    }
    const size_t m0 = (size_t)b * SEQ + (size_t)c * CH;
    const int tau = 16 * ((n >> 2) & 1) + (n & 3) + 4 * (n >> 3);
    const bf16_t* up = zps + (m0 + tau) * 1024 + POOLW + g * SSM_P + 8 * hi;
    const bf16_t* ue = zps + (m0 + tl) * 1024 + POOLW + g * SSM_P + 4 * quad;
    bf16x8 ua = *(const bf16x8*)up;
    u32x2 ue0 = {0u, 0u}, ue1 = {0u, 0u};
    if (OUT) { ue0 = *(const u32x2*)ue; ue1 = *(const u32x2*)(ue + 16 * 1024); }
    for (int blk = 0; blk < CH / 32; ++blk) {
        const bf16x8 ucur = ua; const u32x2 uc0 = ue0, uc1 = ue1;
        if (blk + 1 < CH / 32) { ua = *(const bf16x8*)(up + (size_t)(blk + 1) * 32 * 1024); if (OUT) { ue0 = *(const u32x2*)(ue + (size_t)(blk + 1) * 32 * 1024); ue1 = *(const u32x2*)(ue + (size_t)((blk + 1) * 32 + 16) * 1024); } }
        f32x16 xr0 = {}, xr1 = {}, xi0 = {}, xi1 = {};
        xr0 = __builtin_amdgcn_mfma_f32_32x32x16_bf16(ucur, bfr[0], xr0, 0, 0, 0);
        xr1 = __builtin_amdgcn_mfma_f32_32x32x16_bf16(ucur, bfr[1], xr1, 0, 0, 0);
        xi0 = __builtin_amdgcn_mfma_f32_32x32x16_bf16(ucur, bfr[2], xi0, 0, 0, 0);
        xi1 = __builtin_amdgcn_mfma_f32_32x32x16_bf16(ucur, bfr[3], xi1, 0, 0, 0);
        float e0r = hi ? 0.f : s0r, e0i = hi ? 0.f : s0i, e1r = hi ? 0.f : s1r, e1i = hi ? 0.f : s1i;
#pragma unroll
        for (int r = 0; r < 16; ++r) { cstep(e0r, e0i, ab0[0], ab0[1], xr0[r], xi0[r]); cstep(e1r, e1i, ab1[0], ab1[1], xr1[r], xi1[r]); }
        const float q0r = shx<32>(e0r), q0i = shx<32>(e0i), q1r = shx<32>(e1r), q1i = shx<32>(e1i);
        if (!OUT) {
            float f0r = e0r, f0i = e0i, f1r = e1r, f1i = e1i;
            { const float nr = fmaf(p0r, q0r, fmaf(-p0i, q0i, f0r)), ni = fmaf(p0r, q0i, fmaf(p0i, q0r, f0i)); f0r = nr; f0i = ni; }
            { const float nr = fmaf(p1r, q1r, fmaf(-p1i, q1i, f1r)), ni = fmaf(p1r, q1i, fmaf(p1i, q1r, f1i)); f1r = nr; f1i = ni; }
            const float g0r = shx<32>(f0r), g0i = shx<32>(f0i), g1r = shx<32>(f1r), g1i = shx<32>(f1i);
            s0r = hi ? f0r : g0r; s0i = hi ? f0i : g0i; s1r = hi ? f1r : g1r; s1i = hi ? f1i : g1i;
        } else {
            float t0r = hi ? q0r : s0r, t0i = hi ? q0i : s0i, t1r = hi ? q1r : s1r, t1i = hi ? q1i : s1i;
#pragma unroll
            for (int r = 0; r < 16; ++r) { cstep(t0r, t0i, ab0[0], ab0[1], xr0[r], xi0[r]); xr0[r] = t0r; xi0[r] = t0i; cstep(t1r, t1i, ab1[0], ab1[1], xr1[r], xi1[r]); xr1[r] = t1r; xi1[r] = t1i; }
            const float g0r = shx<32>(t0r), g0i = shx<32>(t0i), g1r = shx<32>(t1r), g1i = shx<32>(t1i);
            s0r = hi ? t0r : g0r; s0i = hi ? t0i : g0i; s1r = hi ? t1r : g1r; s1i = hi ? t1i : g1i;
#pragma unroll
            for (int r = 0; r < 16; ++r) { LAS unsigned char* rowp = tile + (16 * hi + r) * 256 + (n & 7) * 2; const int cb = n >> 3;
                const unsigned wre = pk2(xr0[r], xr1[r]), wim = pk2(xi0[r], xi1[r]);
                *(LAS bf16_t*)(rowp + (((cb) ^ r) << 4)) = (bf16_t)(wre & 0xffffu); *(LAS bf16_t*)(rowp + (((cb + 4) ^ r) << 4)) = (bf16_t)(wre >> 16);
                *(LAS bf16_t*)(rowp + (((cb + 8) ^ r) << 4)) = (bf16_t)(wim & 0xffffu); *(LAS bf16_t*)(rowp + (((cb + 12) ^ r) << 4)) = (bf16_t)(wim >> 16); }
            LDS_WAIT(); asm volatile("" ::: "memory");
#pragma unroll
            for (int h2 = 0; h2 < 2; ++h2) {
                f32x4 y = {0.f, 0.f, 0.f, 0.f};
#pragma unroll
                for (int kk = 0; kk < 4; ++kk) { const bf16x8 sf = *(const LAS bf16x8*)(tile + (16 * h2 + tl) * 256 + (((4 * kk + quad) ^ tl) << 4)); y = __builtin_amdgcn_mfma_f32_16x16x32_bf16(cf[kk], sf, y, 0, 0, 0); }
                const size_t m = m0 + 32 * blk + 16 * h2 + tl;
                const u32x2 uu = h2 ? uc1 : uc0;
                const float uf[4] = {bflo(uu.x), bfhi(uu.x), bflo(uu.y), bfhi(uu.y)};
                float o[4];
#pragma unroll
                for (int i = 0; i < 4; ++i) o[i] = gelu_tanh(y[i] + dq[i] * uf[i]);
                u32x2 wv; wv.x = pk2(o[0], o[1]); wv.y = pk2(o[2], o[3]);
                *(u32x2*)(ssmy + m * SSMW + g * SSM_P + 4 * quad) = wv;
            }
            LDS_WAIT(); asm volatile("" ::: "memory");
        }
    }
    if (!OUT && hi == 0) { f32x2* dst = send + (((size_t)b * NCH + c) * SSM_G + g) * SSM_N + n; dst[0] = (f32x2){s0r, s0i}; dst[32] = (f32x2){s1r, s1i}; }
}

template <int WIN>
__device__ __forceinline__ void pool_run(const bf16_t* zps, bf16_t* pooled, int m0, int c) {
    const int t0 = m0 & (SEQ - 1);
    u32x4 v[15 + WIN];
#pragma unroll
    for (int j = 0; j < 15 + WIN; ++j) { const int dt = j - (WIN - 1); v[j] = (u32x4){0u, 0u, 0u, 0u}; if (t0 + dt >= 0) v[j] = *(const u32x4*)(zps + (size_t)(m0 + dt) * 1024 + 8 * c); }
    float s[8];
#pragma unroll
    for (int e = 0; e < 8; ++e) s[e] = 0.f;
#pragma unroll
    for (int j = 0; j < WIN - 1; ++j) { s[0] += bflo(v[j].x); s[1] += bfhi(v[j].x); s[2] += bflo(v[j].y); s[3] += bfhi(v[j].y); s[4] += bflo(v[j].z); s[5] += bfhi(v[j].z); s[6] += bflo(v[j].w); s[7] += bfhi(v[j].w); }
#pragma unroll
    for (int k = 0; k < 16; ++k) {
        const u32x4 cur = v[WIN - 1 + k];
        s[0] += bflo(cur.x); s[1] += bfhi(cur.x); s[2] += bflo(cur.y); s[3] += bfhi(cur.y); s[4] += bflo(cur.z); s[5] += bfhi(cur.z); s[6] += bflo(cur.w); s[7] += bfhi(cur.w);
        const int cnt = (t0 + k + 1) < WIN ? (t0 + k + 1) : WIN; const float inv = 1.0f / (float)cnt;
        u32x4 o; o.x = pk2(s[0] * inv - bflo(cur.x), s[1] * inv - bfhi(cur.x)); o.y = pk2(s[2] * inv - bflo(cur.y), s[3] * inv - bfhi(cur.y));
        o.z = pk2(s[4] * inv - bflo(cur.z), s[5] * inv - bfhi(cur.z)); o.w = pk2(s[6] * inv - bflo(cur.w), s[7] * inv - bfhi(cur.w));
        *(u32x4*)(pooled + (size_t)(m0 + k) * POOLW + 8 * c) = o;
        const u32x4 old = v[k];
        s[0] -= bflo(old.x); s[1] -= bfhi(old.x); s[2] -= bflo(old.y); s[3] -= bfhi(old.y); s[4] -= bflo(old.z); s[5] -= bfhi(old.z); s[6] -= bflo(old.w); s[7] -= bfhi(old.w);
    }
}
__device__ __forceinline__ void pool_items(const Ctx& C, const bf16_t* zps, bf16_t* pooled) {
    for (int w = C.gw; w < (M / 64) * 4; w += C.ngw) {
        const int gi = w & 3, m0 = 64 * (w >> 2) + 16 * (C.lane >> 4), c = 16 * gi + (C.lane & 15);
        if (gi == 0) pool_run<2>(zps, pooled, m0, c); else if (gi == 1) pool_run<4>(zps, pooled, m0, c); else if (gi == 2) pool_run<8>(zps, pooled, m0, c); else pool_run<16>(zps, pooled, m0, c);
    }
}
__device__ __forceinline__ void attn_merge_items(const Ctx& C, const bf16_t* og, const float* lse, bf16_t* attn) {
    for (int i = C.gt; i < M * 32; i += C.ngt) {
        const int m = i >> 5, c = i & 31, hs = c >> 3;
        const float l0 = lse[((size_t)0 * M + m) * 4 + hs], l1 = lse[((size_t)1 * M + m) * 4 + hs], l2 = lse[((size_t)2 * M + m) * 4 + hs];
        const float mx = fmaxf(l0, fmaxf(l1, l2));
        float w0 = __expf(l0 - mx), w1 = __expf(l1 - mx), w2 = __expf(l2 - mx); const float inv = 1.0f / (w0 + w1 + w2); w0 *= inv; w1 *= inv; w2 *= inv;
        const u32x4 a = *(const u32x4*)(og + ((size_t)0 * M + m) * AOUT + 8 * c), bq = *(const u32x4*)(og + ((size_t)1 * M + m) * AOUT + 8 * c), cq = *(const u32x4*)(og + ((size_t)2 * M + m) * AOUT + 8 * c);
        u32x4 o;
        o.x = pk2(w0 * bflo(a.x) + w1 * bflo(bq.x) + w2 * bflo(cq.x), w0 * bfhi(a.x) + w1 * bfhi(bq.x) + w2 * bfhi(cq.x));
        o.y = pk2(w0 * bflo(a.y) + w1 * bflo(bq.y) + w2 * bflo(cq.y), w0 * bfhi(a.y) + w1 * bfhi(bq.y) + w2 * bfhi(cq.y));
        o.z = pk2(w0 * bflo(a.z) + w1 * bflo(bq.z) + w2 * bflo(cq.z), w0 * bfhi(a.z) + w1 * bfhi(bq.z) + w2 * bfhi(cq.z));
        o.w = pk2(w0 * bflo(a.w) + w1 * bflo(bq.w) + w2 * bflo(cq.w), w0 * bfhi(a.w) + w1 * bfhi(bq.w) + w2 * bfhi(cq.w));
        *(u32x4*)(attn + (size_t)m * AOUT + 8 * c) = o;
    }
}
constexpr int TK_KEYS = 65536, TK_CIJ = TK_KEYS, TK_WSCR = TK_KEYS + 256, TK_LDS = TK_WSCR + 8 * 1024;
__device__ __forceinline__ void topk_stage_keys(const Ctx& C, const bf16_t* k1, const bf16_t* k2) {
#pragma unroll
    for (int p = 0; p < 8; ++p) { const int e = C.tid + p * NTHREADS, tab = e >> 11, row = (e >> 4) & 127, ch = e & 15;
        const u32x4 v = *(const u32x4*)((tab ? k2 : k1) + row * 128 + ch * 8);
        *(LAS u32x4*)(C.lds + tab * 32768 + row * 256 + ((ch ^ (row & 15)) << 4)) = v; }
    if (C.tid < 64) { int c = C.tid, i = 0, j = 0, found = 0, cnt = 0;
        for (int ii = 0; ii < 16; ++ii) for (int jj = 0; jj < 16; ++jj) if ((ii + 1) * (jj + 1) <= 16) { if (cnt == c) { i = ii; j = jj; found = 1; } ++cnt; }
        *(LAS unsigned char*)(C.lds + TK_CIJ + c) = (unsigned char)(found ? ((i << 4) | j) : 0); }
}
template <int N> __device__ __forceinline__ void bitonic_sort_desc(float (&a)[N]) {
#pragma unroll
    for (int k = 2; k <= N; k <<= 1)
#pragma unroll
        for (int j = k >> 1; j > 0; j >>= 1)
#pragma unroll
            for (int i = 0; i < N; ++i) { const int l = i ^ j; if (l > i) { const bool desc = (i & k) == 0; const float hi = fmaxf(a[i], a[l]), lo = fminf(a[i], a[l]); a[i] = desc ? hi : lo; a[l] = desc ? lo : hi; } }
}
template <int N> __device__ __forceinline__ void bitonic_merge_desc(float (&a)[N]) {
#pragma unroll
    for (int j = N >> 1; j > 0; j >>= 1)
#pragma unroll
        for (int i = 0; i < N; ++i) { const int l = i ^ j; if (l > i) { const float hi = fmaxf(a[i], a[l]), lo = fminf(a[i], a[l]); a[i] = hi; a[l] = lo; } }
}
template <int MASK>
__device__ __forceinline__ void merge_lanes16(float (&top)[16]) {
    float c[16];
#pragma unroll
    for (int i = 0; i < 16; ++i) c[i] = fmaxf(top[i], shx<MASK>(top[15 - i]));
    bitonic_merge_desc<16>(c);
#pragma unroll
    for (int i = 0; i < 16; ++i) top[i] = c[i];
}
struct TkQ { bf16x8 q[2][4]; };
__device__ __forceinline__ void topk_load(const Ctx& C, int it, const bf16_t* qbuf, TkQ& Q) {
    const int tg = it >> 3, h = it & 7, tl = C.lane & 15, quad = C.lane >> 4;
    const bf16_t* qrow = qbuf + ((size_t)16 * tg + tl) * PQ + h * 256 + 8 * quad;
#pragma unroll
    for (int t = 0; t < 2; ++t)
#pragma unroll
        for (int kk = 0; kk < 4; ++kk) Q.q[t][kk] = *(const bf16x8*)(qrow + 128 * t + 32 * kk);
}
__device__ __forceinline__ void topk_table(const Ctx& C, int tab, const bf16x8 (&qf)[4], float (&top)[16]) {
    const int tl = C.lane & 15, quad = C.lane >> 4;
    float v[32];
#pragma unroll
    for (int mb = 0; mb < 8; ++mb) {
        f32x4 acc = {0.f, 0.f, 0.f, 0.f}; const int row = 16 * mb + tl;
#pragma unroll
        for (int kk = 0; kk < 4; ++kk) { const bf16x8 kf = *(const LAS bf16x8*)(C.lds + tab * 32768 + row * 256 + (((4 * kk + quad) ^ (row & 15)) << 4));
            acc = __builtin_amdgcn_mfma_f32_16x16x32_bf16(kf, qf[kk], acc, 0, 0, 0); }
#pragma unroll
        for (int i = 0; i < 4; ++i) { const float sc_ = acc[i]; v[4 * mb + i] = bitsf((fbits(sc_) & ~127u) | (unsigned)(16 * mb + 4 * quad + i)); }
    }
#pragma unroll
    for (int k = 2; k <= 16; k <<= 1)
#pragma unroll
        for (int j = k >> 1; j > 0; j >>= 1)
#pragma unroll
            for (int i = 0; i < 32; ++i) { const int l = i ^ j; if (l > i) { const bool desc = (i & k) == 0; const float hi = fmaxf(v[i], v[l]), lo = fminf(v[i], v[l]); v[i] = desc ? hi : lo; v[l] = desc ? lo : hi; } }
#pragma unroll
    for (int i = 0; i < 16; ++i) top[i] = fmaxf(v[i], v[16 + i]);
    bitonic_merge_desc<16>(top);
    merge_lanes16<16>(top); merge_lanes16<32>(top);
}

__device__ __forceinline__ void topk_item(const Ctx& C, int it, const TkQ& Q, int* idx, float* gate) {
    const int tg = it >> 3, h = it & 7, tl = C.lane & 15, quad = C.lane >> 4;
    const size_t m = (size_t)16 * tg + tl;
    float t1[16], t2[16];
    topk_table(C, 0, Q.q[0], t1);
    __builtin_amdgcn_sched_barrier(0);
    topk_table(C, 1, Q.q[1], t2);
    __builtin_amdgcn_sched_barrier(0);
    constexpr int CI[50] = {0,0,0,0,0,0,0,0,0,0,0,0,0,0,0,0,1,1,1,1,1,1,1,1,2,2,2,2,2,3,3,3,3,4,4,4,5,5,6,6,7,7,8,9,10,11,12,13,14,15};
    constexpr int CJ[50] = {0,1,2,3,4,5,6,7,8,9,10,11,12,13,14,15,0,1,2,3,4,5,6,7,0,1,2,3,4,0,1,2,3,0,1,2,0,1,0,1,0,1,0,0,0,0,0,0,0,0};
    float c1[16], c2[16];
#pragma unroll
    for (int i = 0; i < 16; ++i) { c1[i] = bitsf(fbits(t1[i]) & ~127u); c2[i] = bitsf(fbits(t2[i]) & ~127u); }
    LAS unsigned char* wscr = C.lds + TK_WSCR + C.wave * 1024 + tl * 32;
    {
        unsigned p1 = 0u, p2 = 0u;
#pragma unroll
        for (int i = 0; i < 4; ++i) { const unsigned a = quad == 0 ? fbits(t1[i]) : quad == 1 ? fbits(t1[4 + i]) : quad == 2 ? fbits(t1[8 + i]) : fbits(t1[12 + i]);
            const unsigned b = quad == 0 ? fbits(t2[i]) : quad == 1 ? fbits(t2[4 + i]) : quad == 2 ? fbits(t2[8 + i]) : fbits(t2[12 + i]);
            p1 |= (a & 127u) << (8 * i); p2 |= (b & 127u) << (8 * i); }
        *(LAS unsigned*)(wscr + 4 * quad) = p1; *(LAS unsigned*)(wscr + 16 + 4 * quad) = p2;
    }
    float cv[16];
#pragma unroll
    for (int s = 0; s < 16; ++s) {
        float vv = -INFINITY;
        if (s < 13) {
#pragma unroll
            for (int qd = 0; qd < 4; ++qd) { const int c = 4 * s + qd;
                if (c < 50) { const float sum = c1[CI[c < 50 ? c : 0]] + c2[CJ[c < 50 ? c : 0]];
                    const float pv = bitsf((fbits(sum) & ~63u) | (unsigned)c);
                    if (quad == qd) vv = pv; } } }
        cv[s] = vv;
    }
    bitonic_sort_desc<16>(cv);
    merge_lanes16<16>(cv); merge_lanes16<32>(cv);
    float ex[16], sum = 0.f;
#pragma unroll
    for (int r = 0; r < 16; ++r) { ex[r] = __expf(cv[r] - cv[0]); sum += ex[r]; }
    const float inv = 1.0f / sum;
    int oe[4]; float og_[4];
#pragma unroll
    for (int i = 0; i < 4; ++i) {
        const float rvv = quad == 0 ? cv[i] : quad == 1 ? cv[4 + i] : quad == 2 ? cv[8 + i] : cv[12 + i];
        og_[i] = (quad == 0 ? ex[i] : quad == 1 ? ex[4 + i] : quad == 2 ? ex[8 + i] : ex[12 + i]) * inv;
        const unsigned c = fbits(rvv) & 63u;
        const unsigned ij = *(const LAS unsigned char*)(C.lds + TK_CIJ + c);
        const unsigned e1 = *(const LAS unsigned char*)(wscr + (ij >> 4)), e2 = *(const LAS unsigned char*)(wscr + 16 + (ij & 15u));
        oe[i] = (int)((e1 * NKEYS + e2) & (NEXP - 1));
    }
    *(int4*)(idx + m * 128 + h * 16 + 4 * quad) = make_int4(oe[0], oe[1], oe[2], oe[3]);
    *(f32x4*)(gate + m * 128 + h * 16 + 4 * quad) = (f32x4){og_[0], og_[1], og_[2], og_[3]};
}
__device__ __forceinline__ void topk_items(const Ctx& C, const bf16_t* qbuf, int* idx, float* gate) {
    constexpr int NI = (M / 16) * PH;
    int it = C.gw; if (it >= NI) return;
    TkQ Q; topk_load(C, it, qbuf, Q);
    for (;;) {
        const int nxt = it + C.ngw; TkQ Qn;
        if (nxt < NI) topk_load(C, nxt, qbuf, Qn);
        topk_item(C, it, Q, idx, gate);
        if (nxt >= NI) break;
        Q = Qn; it = nxt;
    }
}
__device__ __forceinline__ int topk_own_item(const pg8::StaticOrder& S, int wave, int k) { pg8::Unit u; if (!S.next(k >> 1, u)) return -1; return (16 * u.pm + wave + 8 * (k & 1)) * PH + u.pn; }
__device__ __forceinline__ void topk_own_items(const Ctx& C, const pg8::StaticOrder& S, const bf16_t* qbuf, int* idx, float* gate) {
    int k = 0, it = topk_own_item(S, C.wave, 0); if (it < 0) return;
    TkQ Q; topk_load(C, it, qbuf, Q);
    for (;;) {
        const int nxt = topk_own_item(S, C.wave, k + 1); TkQ Qn;
        if (nxt >= 0) topk_load(C, nxt, qbuf, Qn);
        topk_item(C, it, Q, idx, gate);
        if (nxt < 0) break;
        Q = Qn; it = nxt; ++k;
    }
}
#if TAB_BITS == 8
typedef u32x4 tabv_t;
#else
typedef u32x2 tabv_t;
#endif
constexpr int TABROW = D * TAB_BITS / 8;
__device__ __forceinline__ void peer_load8(const unsigned char* tab, int e0, int e1, int kbase, int lane, tabv_t (&buf)[8]) {
#pragma unroll
    for (int e = 0; e < 8; ++e) { const int k = kbase + e; const int ex = __builtin_amdgcn_readlane(k < 64 ? e0 : e1, k & 63);
        buf[e] = *((const tabv_t*)(tab + (size_t)ex * TABROW) + lane); }
}
__device__ __forceinline__ float dot16(const tabv_t& a, const unsigned (&hh)[8]) {
    float d = 0.f;
#if TAB_BITS == 8
    const unsigned w[4] = {a.x, a.y, a.z, a.w};
#pragma unroll
    for (int q = 0; q < 4; ++q) {
        d = __builtin_amdgcn_fdot2(__builtin_amdgcn_cvt_scalef32_pk_f16_fp8(w[q], 1.0f, false), as_h2(hh[2 * q]), d, false);
        d = __builtin_amdgcn_fdot2(__builtin_amdgcn_cvt_scalef32_pk_f16_fp8(w[q], 1.0f, true), as_h2(hh[2 * q + 1]), d, false);
    }
#else
    const unsigned w[2] = {a.x, a.y};
#pragma unroll
    for (int dd = 0; dd < 2; ++dd) {
        d = __builtin_amdgcn_fdot2(__builtin_amdgcn_cvt_scalef32_pk_f16_fp4(w[dd], 1.0f, 0), as_h2(hh[4 * dd + 0]), d, false);
        d = __builtin_amdgcn_fdot2(__builtin_amdgcn_cvt_scalef32_pk_f16_fp4(w[dd], 1.0f, 1), as_h2(hh[4 * dd + 1]), d, false);
        d = __builtin_amdgcn_fdot2(__builtin_amdgcn_cvt_scalef32_pk_f16_fp4(w[dd], 1.0f, 2), as_h2(hh[4 * dd + 2]), d, false);
        d = __builtin_amdgcn_fdot2(__builtin_amdgcn_cvt_scalef32_pk_f16_fp4(w[dd], 1.0f, 3), as_h2(hh[4 * dd + 3]), d, false);
    }
#endif
    return d;
}
__device__ __forceinline__ float reduce8(const float (&d)[8], int lane) {
    const bool b5 = lane & 32, b4 = lane & 16, b3 = lane & 8;
    float r4[4];
#pragma unroll
    for (int i = 0; i < 4; ++i) { const float keep = b5 ? d[4 + i] : d[i], send = b5 ? d[i] : d[4 + i]; r4[i] = keep + shx<32>(send); }
    float r2[2];
#pragma unroll
    for (int i = 0; i < 2; ++i) { const float keep = b4 ? r4[2 + i] : r4[i], send = b4 ? r4[i] : r4[2 + i]; r2[i] = keep + shx<16>(send); }
    float r1; { const float keep = b3 ? r2[1] : r2[0], send = b3 ? r2[0] : r2[1]; r1 = keep + shx<8>(send); }
    r1 += shx<4>(r1); r1 += shx<2>(r1); r1 += shx<1>(r1);
    return r1;
}
#if TAB_BITS == 4
__device__ __forceinline__ int idot16(const tabv_t& a, const unsigned (&hq)[4]) {
    const int s_hi = __builtin_amdgcn_sdot8((int)a.y, (int)hq[1], __builtin_amdgcn_sdot8((int)a.x, (int)hq[0], 0, false), false);
    const int s_lo = __builtin_amdgcn_sdot8((int)a.y, (int)hq[3], __builtin_amdgcn_sdot8((int)a.x, (int)hq[2], 0, false), false);
    return 16 * s_hi + s_lo;
}
__device__ __forceinline__ int reduce8i(const int (&d)[8], int lane) {
    const bool b5 = lane & 32, b4 = lane & 16, b3 = lane & 8;
    int r4[4];
#pragma unroll
    for (int i = 0; i < 4; ++i) { const int keep = b5 ? d[4 + i] : d[i], send = b5 ? d[i] : d[4 + i]; r4[i] = keep + shx<32>(send); }
    int r2[2];
#pragma unroll
    for (int i = 0; i < 2; ++i) { const int keep = b4 ? r4[2 + i] : r4[i], send = b4 ? r4[i] : r4[2 + i]; r2[i] = keep + shx<16>(send); }
    int r1; { const int keep = b3 ? r2[1] : r2[0], send = b3 ? r2[0] : r2[1]; r1 = keep + shx<8>(send); }
    r1 += shx<4>(r1); r1 += shx<2>(r1); r1 += shx<1>(r1);
    return r1;
}
__device__ __forceinline__ void peer_dots(const tabv_t (&buf)[8], const unsigned (&hq)[4], int grp, int lane, float& a0, float& a1) {
    int d[8];
#pragma unroll
    for (int e = 0; e < 8; ++e) d[e] = idot16(buf[e], hq);
    const int r1 = reduce8i(d, lane);
    const int e = lane & 7, src = ((e >> 2) & 1) * 32 + ((e >> 1) & 1) * 16 + (e & 1) * 8;
    const float val = (float)shfl_idx(r1, src);
    if ((lane >> 3) == (grp & 7)) { if (grp < 8) a0 = val; else a1 = val; }
}
#else
__device__ __forceinline__ void peer_dots(const tabv_t (&buf)[8], const unsigned (&hh)[8], int grp, int lane, float& a0, float& a1) {
    float d[8];
#pragma unroll
    for (int e = 0; e < 8; ++e) d[e] = dot16(buf[e], hh);
    const float r1 = reduce8(d, lane);
    const int e = lane & 7, src = ((e >> 2) & 1) * 32 + ((e >> 1) & 1) * 16 + (e & 1) * 8;
    const float val = shfl_idx(r1, src);
    if ((lane >> 3) == (grp & 7)) { if (grp < 8) a0 = val; else a1 = val; }
}
#endif
__device__ __forceinline__ void peer_fma8(const tabv_t (&buf)[8], float c0, float c1, int kbase, float (&acc)[16]) {
#pragma unroll
    for (int e = 0; e < 8; ++e) { const int k = kbase + e; const float ck = bitsf((unsigned)__builtin_amdgcn_readlane((int)fbits(k < 64 ? c0 : c1), k & 63));
#if TAB_BITS == 4
        const unsigned w4[2] = {buf[e].x, buf[e].y};
#pragma unroll
        for (int dd = 0; dd < 2; ++dd) {
            const h2_t p0 = __builtin_amdgcn_cvt_scalef32_pk_f16_fp4(w4[dd], 1.0f, 0), p1 = __builtin_amdgcn_cvt_scalef32_pk_f16_fp4(w4[dd], 1.0f, 1),
                       p2 = __builtin_amdgcn_cvt_scalef32_pk_f16_fp4(w4[dd], 1.0f, 2), p3 = __builtin_amdgcn_cvt_scalef32_pk_f16_fp4(w4[dd], 1.0f, 3);
            acc[8 * dd + 0] = fmaf((float)p0[0], ck, acc[8 * dd + 0]); acc[8 * dd + 1] = fmaf((float)p0[1], ck, acc[8 * dd + 1]);
            acc[8 * dd + 2] = fmaf((float)p1[0], ck, acc[8 * dd + 2]); acc[8 * dd + 3] = fmaf((float)p1[1], ck, acc[8 * dd + 3]);
            acc[8 * dd + 4] = fmaf((float)p2[0], ck, acc[8 * dd + 4]); acc[8 * dd + 5] = fmaf((float)p2[1], ck, acc[8 * dd + 5]);
            acc[8 * dd + 6] = fmaf((float)p3[0], ck, acc[8 * dd + 6]); acc[8 * dd + 7] = fmaf((float)p3[1], ck, acc[8 * dd + 7]); }
#else
        const unsigned w[4] = {buf[e].x, buf[e].y, buf[e].z, buf[e].w};
#pragma unroll
        for (int q = 0; q < 4; ++q) { const h2_t lo = __builtin_amdgcn_cvt_scalef32_pk_f16_fp8(w[q], 1.0f, false), hi = __builtin_amdgcn_cvt_scalef32_pk_f16_fp8(w[q], 1.0f, true);
            acc[4 * q] = fmaf((float)lo[0], ck, acc[4 * q]); acc[4 * q + 1] = fmaf((float)lo[1], ck, acc[4 * q + 1]);
            acc[4 * q + 2] = fmaf((float)hi[0], ck, acc[4 * q + 2]); acc[4 * q + 3] = fmaf((float)hi[1], ck, acc[4 * q + 3]); }
#endif
    }
}
struct PeerTok { int e0, e1; float g0, g1, su0, su1, sv0, sv1; };
__device__ __forceinline__ void peer_tok_idx(PeerTok& T, int m, const int* idx, const float* gate, int lane) {
    T.e0 = idx[(size_t)m * 128 + lane]; T.e1 = idx[(size_t)m * 128 + 64 + lane]; T.g0 = gate[(size_t)m * 128 + lane]; T.g1 = gate[(size_t)m * 128 + 64 + lane];
}
__device__ __forceinline__ void peer_tok_scales(PeerTok& T, const float* scU, const float* scV) { T.su0 = scU[T.e0]; T.su1 = scU[T.e1]; T.sv0 = scV[T.e0]; T.sv1 = scV[T.e1]; }
__device__ __forceinline__ void peer_issue_f(int grp, const unsigned char* tab, const PeerTok& T, int lane, u32x4 (&buf)[8]) {
#pragma unroll
    for (int e = 0; e < 8; ++e) { const int k = 8 * grp + e; const int ex = __builtin_amdgcn_readlane(k < 64 ? T.e0 : T.e1, k & 63);
        buf[e] = *((const u32x4*)(tab + (size_t)ex * 1024) + lane); }
}
__device__ __forceinline__ void peer_group(const u32x4 (&buf)[8], const unsigned (&hq)[4], int grp, int lane, const PeerTok& T, float sh, h2_t (&acc)[8]) {
    int d[8];
#pragma unroll
    for (int e = 0; e < 8; ++e) { const u32x2 up = {buf[e].x, buf[e].y}; d[e] = idot16(up, hq); }
    const int r1 = reduce8i(d, lane);
    const int el = lane & 7, src = ((el >> 2) & 1) * 32 + ((el >> 1) & 1) * 16 + (el & 1) * 8;
    const float a = (float)shfl_idx(r1, src);
    const bool lo = grp < 8;
    const float c = ABL_PEER ? 0.f : (lo ? T.g0 : T.g1) * gelu_tanh(a * ((lo ? T.su0 : T.su1) * sh)) * (lo ? T.sv0 : T.sv1);
    const unsigned cpk = pkh2(c, c);
#pragma unroll
    for (int e = 0; e < 8; ++e) { const h2_t ck = as_h2((unsigned)__builtin_amdgcn_readlane((int)cpk, 8 * (grp & 7) + e));
        const unsigned w4[2] = {buf[e].z, buf[e].w};
#pragma unroll
        for (int dd = 0; dd < 2; ++dd) {
#pragma unroll
            for (int sl = 0; sl < 4; ++sl) { h2_t pv;
                if (sl == 0) pv = __builtin_amdgcn_cvt_scalef32_pk_f16_fp4(w4[dd], 1.0f, 0); else if (sl == 1) pv = __builtin_amdgcn_cvt_scalef32_pk_f16_fp4(w4[dd], 1.0f, 1);
                else if (sl == 2) pv = __builtin_amdgcn_cvt_scalef32_pk_f16_fp4(w4[dd], 1.0f, 2); else pv = __builtin_amdgcn_cvt_scalef32_pk_f16_fp4(w4[dd], 1.0f, 3);
                acc[4 * dd + sl] = __builtin_elementwise_fma(pv, ck, acc[4 * dd + sl]); } } }
}
template <bool LAST, bool DRY = false>
__device__ __forceinline__ void peer_tokens(const Ctx& C, int m0, int step, const unsigned char* tab, const float* scU, const float* scV, const int* idx, const float* gate, const float* ss2,
                                            float* xs, bf16_t* xg, const float* gnext, float* rstd1, const float* g2 = nullptr, bf16_t* xo = nullptr, unsigned char* h8p = nullptr) {
    const int lane = C.lane;
    if (m0 >= M) return;
    PeerTok T, Tn;
    peer_tok_idx(T, m0, idx, gate, lane); peer_tok_scales(T, scU, scV);
#if PEER_RING == 3
    u32x4 bA[8], bB[8], bC[8];
#else
    u32x4 bA[8], bB[8];
#endif
    int tokpar = 0;
    for (int m = m0; m < M; m += step) {
        const int mn = m + step; const bool has_next = mn < M;
        peer_issue_f(0, tab, T, lane, bA);
#if PEER_RING == 3
        peer_issue_f(1, tab, T, lane, bB);
#endif
        if (has_next) peer_tok_idx(Tn, mn, idx, gate, lane);
#if PEER_RESDMA
        { LAS unsigned char* slot = C.lds + C.wave * 4096;
#if XB16
#pragma unroll
          for (int j = 0; j < 2; ++j) __builtin_amdgcn_global_load_lds((const unsigned*)((const u32x4*)(xg + (size_t)m * D) + 2 * lane + j), (LAS unsigned*)(slot + j * 1024), 16, 0, 0);
#else
#pragma unroll
          for (int j = 0; j < 4; ++j) __builtin_amdgcn_global_load_lds((const unsigned*)((const f32x4*)(xs + (size_t)m * D) + 4 * lane + j), (LAS unsigned*)(slot + j * 1024), 16, 0, 0);
#endif
        }
#endif
        const float rs = pg8::row_rs(ss2, m);
        unsigned hh[4]; float sh;
        {
#if PEER_HDMA
          LAS unsigned char* hslot = C.lds + 32768 + C.wave * 4096 + (tokpar << 11);
          u32x4 x0, x1;
          if (m == m0) { x0 = *((const u32x4*)(xg + (size_t)m * D) + 2 * lane); x1 = *((const u32x4*)(xg + (size_t)m * D) + 2 * lane + 1); }
          else { x0 = *(const LAS u32x4*)(hslot + lane * 16); x1 = *(const LAS u32x4*)(hslot + 1024 + lane * 16); LDS_WAIT(); asm volatile("" ::: "memory"); }
          if (has_next) { LAS unsigned char* nslot = C.lds + 32768 + C.wave * 4096 + ((tokpar ^ 1) << 11);
#pragma unroll
              for (int j = 0; j < 2; ++j) __builtin_amdgcn_global_load_lds((const unsigned*)((const u32x4*)(xg + (size_t)mn * D) + 2 * lane + j), (LAS unsigned*)(nslot + j * 1024), 16, 0, 0); }
          tokpar ^= 1;
#else
          const u32x4 x0 = *((const u32x4*)(xg + (size_t)m * D) + 2 * lane), x1 = *((const u32x4*)(xg + (size_t)m * D) + 2 * lane + 1);
#endif
          const unsigned w[8] = {x0.x, x0.y, x0.z, x0.w, x1.x, x1.y, x1.z, x1.w};
          float hv[16]; float mxh = 0.f;
#pragma unroll
          for (int q = 0; q < 8; ++q) { hv[2 * q] = bflo(w[q]) * rs; hv[2 * q + 1] = bfhi(w[q]) * rs; }
#if XB16
#pragma unroll
          for (int q = 0; q < 4; ++q) { const f32x4 gq = *((const f32x4*)g2 + 4 * lane + q); hv[4 * q] *= gq[0]; hv[4 * q + 1] *= gq[1]; hv[4 * q + 2] *= gq[2]; hv[4 * q + 3] *= gq[3]; }
#endif
#pragma unroll
          for (int q = 0; q < 16; ++q) mxh = fmaxf(mxh, fabsf(hv[q]));
          mxh = wave_max(mxh);
          sh = fmaxf(mxh, 1e-30f) * (1.0f / 119.0f); const float inv = 1.0f / sh;
#pragma unroll
          for (int dd = 0; dd < 2; ++dd) { unsigned th = 0u, tl = 0u;
#pragma unroll
              for (int j = 0; j < 8; ++j) { const int q8 = (int)rintf(hv[8 * dd + j] * inv), hi = (q8 + 8) >> 4, lo = q8 - (hi << 4); th |= ((unsigned)hi & 15u) << (4 * j); tl |= ((unsigned)lo & 15u) << (4 * j); }
              hh[dd] = th; hh[2 + dd] = tl; } }
        h2_t acc[8];
#pragma unroll
        for (int i = 0; i < 8; ++i) acc[i] = (h2_t){(_Float16)0.f, (_Float16)0.f};
#if PEER_RING == 3
#pragma unroll 1
        for (int j = 0; j < 15; j += 3) {
            peer_issue_f(j + 2, tab, T, lane, bC); peer_group(bA, hh, j, lane, T, sh, acc);
            peer_issue_f(j + 3, tab, T, lane, bA); peer_group(bB, hh, j + 1, lane, T, sh, acc);
            if (j + 4 < 16) peer_issue_f(j + 4, tab, T, lane, bB);
            peer_group(bC, hh, j + 2, lane, T, sh, acc);
        }
        peer_group(bA, hh, 15, lane, T, sh, acc);
#else
#pragma unroll 1
        for (int j = 0; j < 16; j += 2) {
            peer_issue_f(j + 1, tab, T, lane, bB); peer_group(bA, hh, j, lane, T, sh, acc);
            if (j + 2 < 16) peer_issue_f(j + 2, tab, T, lane, bA);
            peer_group(bB, hh, j + 1, lane, T, sh, acc);
        }
#endif
#if PEER_RESDMA
        asm volatile("s_waitcnt vmcnt(0)" ::: "memory");
        f32x4 x[4];
        { LAS unsigned char* slot = C.lds + C.wave * 4096;
#if XB16
          const u32x4 x0 = *(const LAS u32x4*)(slot + lane * 16), x1 = *(const LAS u32x4*)(slot + 1024 + lane * 16);
          x[0] = (f32x4){bflo(x0.x), bfhi(x0.x), bflo(x0.y), bfhi(x0.y)}; x[1] = (f32x4){bflo(x0.z), bfhi(x0.z), bflo(x0.w), bfhi(x0.w)};
          x[2] = (f32x4){bflo(x1.x), bfhi(x1.x), bflo(x1.y), bfhi(x1.y)}; x[3] = (f32x4){bflo(x1.z), bfhi(x1.z), bflo(x1.w), bfhi(x1.w)};
#else
#pragma unroll
          for (int j = 0; j < 4; ++j) x[j] = *(const LAS f32x4*)(slot + j * 1024 + lane * 16);
#endif
          LDS_WAIT(); asm volatile("" ::: "memory"); }
        if (has_next) peer_tok_scales(Tn, scU, scV);
        float* xr = xs + (size_t)m * D;
#else
        if (has_next) peer_tok_scales(Tn, scU, scV);
        float* xr = xs + (size_t)m * D;
        f32x4 x[4];
#endif
#if PEER_RESDMA
#elif XB16
        { const u32x4 x0 = *((const u32x4*)(xg + (size_t)m * D) + 2 * lane), x1 = *((const u32x4*)(xg + (size_t)m * D) + 2 * lane + 1);
          x[0] = (f32x4){bflo(x0.x), bfhi(x0.x), bflo(x0.y), bfhi(x0.y)}; x[1] = (f32x4){bflo(x0.z), bfhi(x0.z), bflo(x0.w), bfhi(x0.w)};
          x[2] = (f32x4){bflo(x1.x), bfhi(x1.x), bflo(x1.y), bfhi(x1.y)}; x[3] = (f32x4){bflo(x1.z), bfhi(x1.z), bflo(x1.w), bfhi(x1.w)}; }
#else
#pragma unroll
        for (int j = 0; j < 4; ++j) x[j] = *((const f32x4*)xr + 4 * lane + j);
#endif
        float sq = 0.f;
#pragma unroll
        for (int j = 0; j < 4; ++j)
#pragma unroll
            for (int i = 0; i < 4; ++i) { x[j][i] += (float)acc[2 * j + (i >> 1)][i & 1]; sq += x[j][i] * x[j][i]; }
        sq = wave_sum(sq);
        const float rn = __builtin_amdgcn_rsqf(sq * (1.0f / D) + EPS);
        if (!(DRY && rn != 12345.678f)) {
        f32x4 gg[4];
        if (LAST || !XB16) {
#pragma unroll
        for (int j = 0; j < 4; ++j) gg[j] = *((const f32x4*)gnext + 4 * lane + j);
        }
        if (LAST) {
#pragma unroll
            for (int j = 0; j < 4; ++j) *((f32x4*)xr + 4 * lane + j) = x[j] * gg[j] * rn;
        } else {
#if XB16
            u32x4 o0, o1; const f32x4 y0 = x[0], y1 = x[1], y2 = x[2], y3 = x[3];
#else
#pragma unroll
            for (int j = 0; j < 4; ++j) *((f32x4*)xr + 4 * lane + j) = x[j];
            u32x4 o0, o1; const f32x4 y0 = x[0] * gg[0], y1 = x[1] * gg[1], y2 = x[2] * gg[2], y3 = x[3] * gg[3];
#endif
            o0.x = pk2(y0[0], y0[1]); o0.y = pk2(y0[2], y0[3]); o0.z = pk2(y1[0], y1[1]); o0.w = pk2(y1[2], y1[3]);
            o1.x = pk2(y2[0], y2[1]); o1.y = pk2(y2[2], y2[3]); o1.z = pk2(y3[0], y3[1]); o1.w = pk2(y3[2], y3[3]);
#if XB16 && OUT_PREFILL == 2
            xr[16 * lane] = 0.f;
#endif
            bf16_t* const xw = XB16 ? xo : xg;
            *((u32x4*)(xw + (size_t)m * D) + 2 * lane) = o0; *((u32x4*)(xw + (size_t)m * D) + 2 * lane + 1) = o1;
            if (GATE_F8) { u32x4 o8; o8.x = pk4_fp8(y0[0], y0[1], y0[2], y0[3]); o8.y = pk4_fp8(y1[0], y1[1], y1[2], y1[3]); o8.z = pk4_fp8(y2[0], y2[1], y2[2], y2[3]); o8.w = pk4_fp8(y3[0], y3[1], y3[2], y3[3]);
                *((u32x4*)(h8p + (size_t)m * D) + lane) = o8; }
            if (lane == 0) st_wt(rstd1 + m, rn);
        }
        }
        T = Tn;
    }
}

constexpr int PS_WAVE = 12800, PS_AC = 0, PS_EID = 8192, PS_SH = 12288;
__device__ __forceinline__ void peer_fma8_v(const u32x2 (&buf)[8], unsigned cp0, unsigned cp1, int kbase, h2_t (&acc)[8]) {
#pragma unroll
    for (int e = 0; e < 8; ++e) { const int k = kbase + e; const h2_t ck = as_h2((unsigned)__builtin_amdgcn_readlane((int)(k < 64 ? cp0 : cp1), k & 63));
        const unsigned w4[2] = {buf[e].x, buf[e].y};
#pragma unroll
        for (int dd = 0; dd < 2; ++dd) {
#pragma unroll
            for (int sl = 0; sl < 4; ++sl) { h2_t pv;
                if (sl == 0) pv = __builtin_amdgcn_cvt_scalef32_pk_f16_fp4(w4[dd], 1.0f, 0); else if (sl == 1) pv = __builtin_amdgcn_cvt_scalef32_pk_f16_fp4(w4[dd], 1.0f, 1);
                else if (sl == 2) pv = __builtin_amdgcn_cvt_scalef32_pk_f16_fp4(w4[dd], 1.0f, 2); else pv = __builtin_amdgcn_cvt_scalef32_pk_f16_fp4(w4[dd], 1.0f, 3);
                acc[4 * dd + sl] = __builtin_elementwise_fma(pv, ck, acc[4 * dd + sl]); } } }
}
__device__ __forceinline__ void peer_load8_v(const unsigned char* tabV, int e0, int e1, int kbase, int lane, u32x2 (&buf)[8]) {
#pragma unroll
    for (int e = 0; e < 8; ++e) { const int k = kbase + e; const int ex = __builtin_amdgcn_readlane(k < 64 ? e0 : e1, k & 63);
        buf[e] = *((const u32x2*)(tabV + (size_t)ex * 512) + lane); }
}
__device__ __forceinline__ void ps_issue(LAS unsigned char* wl, int i, const unsigned char* uslice, int r, int p, u32x2 (&rows)[16]) {
    const u32x4 w0 = *(const LAS u32x4*)(wl + PS_EID + i * 256 + r * 32), w1 = *(const LAS u32x4*)(wl + PS_EID + i * 256 + r * 32 + 16);
    const unsigned w[8] = {w0.x, w0.y, w0.z, w0.w, w1.x, w1.y, w1.z, w1.w};
#pragma unroll
    for (int j = 0; j < 16; ++j) { const unsigned e = (j & 1) ? (w[j >> 1] >> 16) : (w[j >> 1] & 0xffffu); rows[j] = *(const u32x2*)(uslice + (size_t)e * 64 + p * 8); }
}
__device__ __forceinline__ void ps_consume(LAS unsigned char* wl, int i, const u32x2 (&rows)[16], const u32x4& hq4, int lane) {
    const unsigned hq[4] = {hq4.x, hq4.y, hq4.z, hq4.w};
    int d[16];
#pragma unroll
    for (int j = 0; j < 16; ++j) d[j] = idot16(rows[j], hq);
    const bool b2 = lane & 4, b1 = lane & 2, b0 = lane & 1;
    int r8[8], r4[4], r2[2];
#pragma unroll
    for (int k = 0; k < 8; ++k) { const int keep = b2 ? d[8 + k] : d[k], send = b2 ? d[k] : d[8 + k]; r8[k] = keep + shx<4>(send); }
#pragma unroll
    for (int k = 0; k < 4; ++k) { const int keep = b1 ? r8[4 + k] : r8[k], send = b1 ? r8[k] : r8[4 + k]; r4[k] = keep + shx<2>(send); }
#pragma unroll
    for (int k = 0; k < 2; ++k) { const int keep = b0 ? r4[2 + k] : r4[k], send = b0 ? r4[k] : r4[2 + k]; r2[k] = keep + shx<1>(send); }
    LAS int* ap = (LAS int*)(wl + PS_AC + i * 512) + (lane >> 3) * 16 + 2 * (lane & 7);
    const int o0 = ap[0], o1 = ap[1]; ap[0] = o0 + r2[0]; ap[1] = o1 + r2[1];
}
template <bool LAST, bool DRY = false>
__device__ __forceinline__ void peer_sweep(const Ctx& C, const unsigned char* tabUs, const unsigned char* tabV, const float* scU, const float* scV, const int* idx, const float* gate, const float* ss2,
                                           float* xs, bf16_t* xg, const float* gnext, float* rstd1, unsigned char* hqbuf) {
    const int lane = C.lane, r = lane >> 3, p = lane & 7;
    LAS unsigned char* wl = C.lds + C.wave * PS_WAVE;
#pragma unroll 1
    for (int i = 0; i < 16; ++i) {
        const int m = C.gw + i * C.ngw;
        const int e0 = idx[(size_t)m * 128 + lane], e1 = idx[(size_t)m * 128 + 64 + lane];
        const int p0 = (lane & 7) * 16 + (lane >> 3), p1 = p0 + 8;
        *(LAS unsigned short*)(wl + PS_EID + i * 256 + p0 * 2) = (unsigned short)e0; *(LAS unsigned short*)(wl + PS_EID + i * 256 + p1 * 2) = (unsigned short)e1;
        ((LAS int*)(wl + PS_AC + i * 512))[lane] = 0; ((LAS int*)(wl + PS_AC + i * 512))[64 + lane] = 0;
        const float rs = pg8::row_rs(ss2, m);
        const u32x4 x0 = *((const u32x4*)(xg + (size_t)m * D) + 2 * lane), x1 = *((const u32x4*)(xg + (size_t)m * D) + 2 * lane + 1);
        const unsigned w[8] = {x0.x, x0.y, x0.z, x0.w, x1.x, x1.y, x1.z, x1.w};
        float hv[16]; float mxh = 0.f;
#pragma unroll
        for (int q = 0; q < 8; ++q) { hv[2 * q] = bflo(w[q]) * rs; hv[2 * q + 1] = bfhi(w[q]) * rs; mxh = fmaxf(mxh, fmaxf(fabsf(hv[2 * q]), fabsf(hv[2 * q + 1]))); }
        mxh = wave_max(mxh);
        const float sh = fmaxf(mxh, 1e-30f) * (1.0f / 119.0f), inv = 1.0f / sh;
        unsigned hh[4];
#pragma unroll
        for (int dd = 0; dd < 2; ++dd) { unsigned th = 0u, tl = 0u;
#pragma unroll
            for (int j = 0; j < 8; ++j) { const int q8 = (int)rintf(hv[8 * dd + j] * inv), hi = (q8 + 8) >> 4, lo = q8 - (hi << 4); th |= ((unsigned)hi & 15u) << (4 * j); tl |= ((unsigned)lo & 15u) << (4 * j); }
            hh[dd] = th; hh[2 + dd] = tl; }
        *((u32x4*)(hqbuf + (size_t)m * 1024) + lane) = (u32x4){hh[0], hh[1], hh[2], hh[3]};
        if (lane == 0) ((LAS float*)(wl + PS_SH))[i] = sh;
    }
    asm volatile("s_waitcnt vmcnt(0) lgkmcnt(0)" ::: "memory");
#pragma unroll 1
    for (int s = 0; s < 8; ++s) {
        const unsigned char* uslice = tabUs + (size_t)s * MiB;
        u32x2 rA[16], rB[16]; u32x4 hA, hB;
        ps_issue(wl, 0, uslice, r, p, rA); hA = *((const u32x4*)(hqbuf + (size_t)C.gw * 1024) + s * 8 + p);
#pragma unroll 1
        for (int i = 0; i < 16; i += 2) {
            ps_issue(wl, i + 1, uslice, r, p, rB); hB = *((const u32x4*)(hqbuf + (size_t)(C.gw + (i + 1) * C.ngw) * 1024) + s * 8 + p);
            ps_consume(wl, i, rA, hA, lane);
            if (i + 2 < 16) { ps_issue(wl, i + 2, uslice, r, p, rA); hA = *((const u32x4*)(hqbuf + (size_t)(C.gw + (i + 2) * C.ngw) * 1024) + s * 8 + p); }
            ps_consume(wl, i + 1, rB, hB, lane);
        }
    }
#pragma unroll 1
    for (int i = 0; i < 16; ++i) {
        const int m = C.gw + i * C.ngw; const float sh = ((LAS float*)(wl + PS_SH))[i];
#pragma unroll
        for (int hf = 0; hf < 2; ++hf) { const int pos = lane + 64 * hf, k = (pos & 15) * 8 + (pos >> 4);
            const int e = *(LAS unsigned short*)(wl + PS_EID + i * 256 + pos * 2); const int a = ((LAS int*)(wl + PS_AC + i * 512))[pos];
            const float g = gate[(size_t)m * 128 + k], su = scU[e], sv = scV[e];
            const float c = ABL_PEER ? 0.f : g * gelu_tanh((float)a * (su * sh)) * sv;
            ((LAS float*)(wl + PS_AC + i * 512))[pos] = c; }
    }
#pragma unroll 1
    for (int i = 0; i < 16; ++i) {
        const int m = C.gw + i * C.ngw;
        const int e0 = idx[(size_t)m * 128 + lane], e1 = idx[(size_t)m * 128 + 64 + lane];
        const int p0 = (lane & 7) * 16 + (lane >> 3);
        const float c0 = ((LAS float*)(wl + PS_AC + i * 512))[p0], c1 = ((LAS float*)(wl + PS_AC + i * 512))[p0 + 8];
        h2_t acc[8];
#pragma unroll
        for (int q = 0; q < 8; ++q) acc[q] = (h2_t){(_Float16)0.f, (_Float16)0.f};
        const unsigned cp0 = pkh2(c0, c0), cp1 = pkh2(c1, c1);
        u32x2 bA[8], bB[8];
        peer_load8_v(tabV, e0, e1, 0, lane, bA);
#pragma unroll 1
        for (int j = 0; j < 16; j += 2) {
            peer_load8_v(tabV, e0, e1, 8 * (j + 1), lane, bB); peer_fma8_v(bA, cp0, cp1, 8 * j, acc);
            if (j + 2 < 16) peer_load8_v(tabV, e0, e1, 8 * (j + 2), lane, bA);
            peer_fma8_v(bB, cp0, cp1, 8 * (j + 1), acc);
        }
        float* xr = xs + (size_t)m * D;
        f32x4 x[4];
#pragma unroll
        for (int j = 0; j < 4; ++j) x[j] = *((const f32x4*)xr + 4 * lane + j);
        float sq = 0.f;
#pragma unroll
        for (int j = 0; j < 4; ++j)
#pragma unroll
            for (int q = 0; q < 4; ++q) { x[j][q] += (float)acc[2 * j + (q >> 1)][q & 1]; sq += x[j][q] * x[j][q]; }
        sq = wave_sum(sq);
        const float rn = __builtin_amdgcn_rsqf(sq * (1.0f / D) + EPS);
        if (!(DRY && rn != 12345.678f)) {
        f32x4 gg[4];
#pragma unroll
        for (int j = 0; j < 4; ++j) gg[j] = *((const f32x4*)gnext + 4 * lane + j);
        if (LAST) {
#pragma unroll
            for (int j = 0; j < 4; ++j) *((f32x4*)xr + 4 * lane + j) = x[j] * gg[j] * rn;
        } else {
#pragma unroll
            for (int j = 0; j < 4; ++j) *((f32x4*)xr + 4 * lane + j) = x[j];
            u32x4 o0, o1; const f32x4 y0 = x[0] * gg[0], y1 = x[1] * gg[1], y2 = x[2] * gg[2], y3 = x[3] * gg[3];
            o0.x = pk2(y0[0], y0[1]); o0.y = pk2(y0[2], y0[3]); o0.z = pk2(y1[0], y1[1]); o0.w = pk2(y1[2], y1[3]);
            o1.x = pk2(y2[0], y2[1]); o1.y = pk2(y2[2], y2[3]); o1.z = pk2(y3[0], y3[1]); o1.w = pk2(y3[2], y3[3]);
            *((u32x4*)(xg + (size_t)m * D) + 2 * lane) = o0; *((u32x4*)(xg + (size_t)m * D) + 2 * lane + 1) = o1;
            if (GATE_F8) { u32x4 o8; o8.x = pk4_fp8(y0[0], y0[1], y0[2], y0[3]); o8.y = pk4_fp8(y1[0], y1[1], y1[2], y1[3]); o8.z = pk4_fp8(y2[0], y2[1], y2[2], y2[3]); o8.w = pk4_fp8(y3[0], y3[1], y3[2], y3[3]);
                *((u32x4*)((unsigned char*)xg + (WS_H8 - WS_E) + (size_t)m * D) + lane) = o8; }
            if (lane == 0) st_wt(rstd1 + m, rn);
        }
        }
    }
}

typedef int v8i_t __attribute__((ext_vector_type(8)));
constexpr int PM_WAVE = 2048, PM_H = 0, PM_A = 1024;
#define PM_MFMA8(ACC, UA, BF, SC) asm volatile("s_nop 4\n\t" \
    "v_mfma_scale_f32_16x16x128_f8f6f4 %0, %1, %9, %0, %17, %17 op_sel_hi:[0,0,0] cbsz:4\n\t" \
    "v_mfma_scale_f32_16x16x128_f8f6f4 %0, %2, %10, %0, %17, %17 op_sel_hi:[0,0,0] cbsz:4\n\t" \
    "v_mfma_scale_f32_16x16x128_f8f6f4 %0, %3, %11, %0, %17, %17 op_sel_hi:[0,0,0] cbsz:4\n\t" \
    "v_mfma_scale_f32_16x16x128_f8f6f4 %0, %4, %12, %0, %17, %17 op_sel_hi:[0,0,0] cbsz:4\n\t" \
    "v_mfma_scale_f32_16x16x128_f8f6f4 %0, %5, %13, %0, %17, %17 op_sel_hi:[0,0,0] cbsz:4\n\t" \
    "v_mfma_scale_f32_16x16x128_f8f6f4 %0, %6, %14, %0, %17, %17 op_sel_hi:[0,0,0] cbsz:4\n\t" \
    "v_mfma_scale_f32_16x16x128_f8f6f4 %0, %7, %15, %0, %17, %17 op_sel_hi:[0,0,0] cbsz:4\n\t" \
    "v_mfma_scale_f32_16x16x128_f8f6f4 %0, %8, %16, %0, %17, %17 op_sel_hi:[0,0,0] cbsz:4\n\t" \
    "s_nop 15\n\ts_nop 7" \
    : "+v"(ACC) : "v"(UA[0]), "v"(UA[1]), "v"(UA[2]), "v"(UA[3]), "v"(UA[4]), "v"(UA[5]), "v"(UA[6]), "v"(UA[7]), \
      "v"(BF[0]), "v"(BF[1]), "v"(BF[2]), "v"(BF[3]), "v"(BF[4]), "v"(BF[5]), "v"(BF[6]), "v"(BF[7]), "v"(SC))
struct TokM { int e0, e1; float g0, g1, su0, su1, sv0, sv1; int er[8]; };
__device__ __forceinline__ void tokm_idx(TokM& T, int m, const int* idx, const float* gate, int lane) {
    T.e0 = idx[(size_t)m * 128 + lane]; T.e1 = idx[(size_t)m * 128 + 64 + lane]; T.g0 = gate[(size_t)m * 128 + lane]; T.g1 = gate[(size_t)m * 128 + 64 + lane];
#pragma unroll
    for (int mb = 0; mb < 8; ++mb) T.er[mb] = idx[(size_t)m * 128 + 16 * mb + (lane & 15)];
}
__device__ __forceinline__ void tokm_scales(TokM& T, const float* scU, const float* scV) { T.su0 = scU[T.e0]; T.su1 = scU[T.e1]; T.sv0 = scV[T.e0]; T.sv1 = scV[T.e1]; }
__device__ __forceinline__ void pm_issue_u(const unsigned char* tab, int er, int quad, u32x4 (&ua)[8]) {
    const u32x4* bp = (const u32x4*)(tab + (size_t)er * 1024 + 16 * quad);
#pragma unroll
    for (int kb = 0; kb < 8; ++kb) ua[kb] = bp[4 * kb];
}
__device__ __forceinline__ void pm_issue_v(int grp, const unsigned char* tab, const TokM& T, int lane, u32x2 (&buf)[8]) {
#pragma unroll
    for (int e = 0; e < 8; ++e) { const int k = 8 * grp + e; const int ex = __builtin_amdgcn_readlane(k < 64 ? T.e0 : T.e1, k & 63);
        buf[e] = *((const u32x2*)(tab + (size_t)ex * 1024 + 512) + lane); }
}
__device__ __forceinline__ void pm_fma_v(const u32x2 (&buf)[8], unsigned cp0, unsigned cp1, int grp, h2_t (&acc)[8]) {
#pragma unroll
    for (int e = 0; e < 8; ++e) { const int k = 8 * grp + e; const h2_t ck = as_h2((unsigned)__builtin_amdgcn_readlane((int)(k < 64 ? cp0 : cp1), k & 63));
        const unsigned w4[2] = {buf[e].x, buf[e].y};
#pragma unroll
        for (int dd = 0; dd < 2; ++dd) {
#pragma unroll
            for (int sl = 0; sl < 4; ++sl) { h2_t pv;
                if (sl == 0) pv = __builtin_amdgcn_cvt_scalef32_pk_f16_fp4(w4[dd], 1.0f, 0); else if (sl == 1) pv = __builtin_amdgcn_cvt_scalef32_pk_f16_fp4(w4[dd], 1.0f, 1);
                else if (sl == 2) pv = __builtin_amdgcn_cvt_scalef32_pk_f16_fp4(w4[dd], 1.0f, 2); else pv = __builtin_amdgcn_cvt_scalef32_pk_f16_fp4(w4[dd], 1.0f, 3);
                acc[4 * dd + sl] = __builtin_elementwise_fma(pv, ck, acc[4 * dd + sl]); } } }
}
template <bool LAST, bool DRY = false>
__device__ __forceinline__ void peer_tokens_mf(const Ctx& C, int m0, int step, const unsigned char* tab, const float* scU, const float* scV, const int* idx, const float* gate, const float* ss2,
                                               float* xs, bf16_t* xg, const float* gnext, float* rstd1) {
    const int lane = C.lane, n16 = lane & 15, quad = lane >> 4;
    if (m0 >= M) return;
    LAS unsigned char* wl = C.lds + C.wave * PM_WAVE;
    TokM T, Tn;
    tokm_idx(T, m0, idx, gate, lane); tokm_scales(T, scU, scV);
    unsigned e8m0_one = 0x7F7F7F7Fu; asm volatile("" : "+v"(e8m0_one));
    for (int m = m0; m < M; m += step) {
        const int mn = m + step; const bool has_next = mn < M;
        u32x4 uA[8], uB[8];
        pm_issue_u(tab, T.er[0], quad, uA);
        if (has_next) tokm_idx(Tn, mn, idx, gate, lane);
        const float rs = pg8::row_rs(ss2, m);
        float sh;
        { const u32x4 x0 = *((const u32x4*)(xg + (size_t)m * D) + 2 * lane), x1 = *((const u32x4*)(xg + (size_t)m * D) + 2 * lane + 1);
          const unsigned w[8] = {x0.x, x0.y, x0.z, x0.w, x1.x, x1.y, x1.z, x1.w};
          float hv[16]; float mxh = 0.f;
#pragma unroll
          for (int q = 0; q < 8; ++q) { hv[2 * q] = bflo(w[q]) * rs; hv[2 * q + 1] = bfhi(w[q]) * rs; mxh = fmaxf(mxh, fmaxf(fabsf(hv[2 * q]), fabsf(hv[2 * q + 1]))); }
          mxh = wave_max(mxh);
          sh = fmaxf(mxh, 1e-30f) * (1.0f / 240.0f); const float inv = 1.0f / sh;
          unsigned hb[4];
#pragma unroll
          for (int q = 0; q < 4; ++q) { unsigned t = __builtin_amdgcn_cvt_pk_fp8_f32(hv[4 * q] * inv, hv[4 * q + 1] * inv, 0u, false); hb[q] = __builtin_amdgcn_cvt_pk_fp8_f32(hv[4 * q + 2] * inv, hv[4 * q + 3] * inv, t, true); }
          *(LAS u32x4*)(wl + PM_H + 16 * lane) = (u32x4){hb[0], hb[1], hb[2], hb[3]}; }
        v8i_t bfr[8];
#pragma unroll
        for (int kb = 0; kb < 8; ++kb) { const u32x4 b0 = *(const LAS u32x4*)(wl + PM_H + 128 * kb + 16 * quad), b1 = *(const LAS u32x4*)(wl + PM_H + 128 * kb + 64 + 16 * quad);
            bfr[kb] = (v8i_t){(int)b0.x, (int)b0.y, (int)b0.z, (int)b0.w, (int)b1.x, (int)b1.y, (int)b1.z, (int)b1.w}; }
#pragma unroll
        for (int mb = 0; mb < 8; ++mb) {
            if (mb + 1 < 8) { if (mb & 1) pm_issue_u(tab, T.er[mb + 1], quad, uA); else pm_issue_u(tab, T.er[mb + 1], quad, uB); }
            f32x4 acc = {0.f, 0.f, 0.f, 0.f};
            if (mb & 1) PM_MFMA8(acc, uB, bfr, e8m0_one); else PM_MFMA8(acc, uA, bfr, e8m0_one);
            *(LAS f32x4*)(wl + PM_A + (16 * mb + 4 * quad) * 4) = acc;
        }
        const float a0 = ((const LAS float*)(wl + PM_A))[lane], a1 = ((const LAS float*)(wl + PM_A))[64 + lane];
        const float c0 = ABL_PEER ? 0.f : T.g0 * gelu_tanh(a0 * (T.su0 * sh)) * T.sv0, c1 = ABL_PEER ? 0.f : T.g1 * gelu_tanh(a1 * (T.su1 * sh)) * T.sv1;
        const unsigned cp0 = pkh2(c0, c0), cp1 = pkh2(c1, c1);
        if (has_next) tokm_scales(Tn, scU, scV);
        h2_t acc[8];
#pragma unroll
        for (int i = 0; i < 8; ++i) acc[i] = (h2_t){(_Float16)0.f, (_Float16)0.f};
        u32x2 vA[8], vB[8];
        pm_issue_v(0, tab, T, lane, vA);
#pragma unroll 1
        for (int j = 0; j < 16; j += 2) {
            pm_issue_v(j + 1, tab, T, lane, vB); pm_fma_v(vA, cp0, cp1, j, acc);
            if (j + 2 < 16) pm_issue_v(j + 2, tab, T, lane, vA);
            pm_fma_v(vB, cp0, cp1, j + 1, acc);
        }
        float* xr = xs + (size_t)m * D;
        f32x4 x[4];
#pragma unroll
        for (int j = 0; j < 4; ++j) x[j] = *((const f32x4*)xr + 4 * lane + j);
        float sq = 0.f;
#pragma unroll
        for (int j = 0; j < 4; ++j)
#pragma unroll
            for (int i = 0; i < 4; ++i) { x[j][i] += (float)acc[2 * j + (i >> 1)][i & 1]; sq += x[j][i] * x[j][i]; }
        sq = wave_sum(sq);
        const float rn = __builtin_amdgcn_rsqf(sq * (1.0f / D) + EPS);
        if (!(DRY && rn != 12345.678f)) {
        f32x4 gg[4];
#pragma unroll
        for (int j = 0; j < 4; ++j) gg[j] = *((const f32x4*)gnext + 4 * lane + j);
        if (LAST) {
#pragma unroll
            for (int j = 0; j < 4; ++j) *((f32x4*)xr + 4 * lane + j) = x[j] * gg[j] * rn;
        } else {
#pragma unroll
            for (int j = 0; j < 4; ++j) *((f32x4*)xr + 4 * lane + j) = x[j];
            u32x4 o0, o1; const f32x4 y0 = x[0] * gg[0], y1 = x[1] * gg[1], y2 = x[2] * gg[2], y3 = x[3] * gg[3];
            o0.x = pk2(y0[0], y0[1]); o0.y = pk2(y0[2], y0[3]); o0.z = pk2(y1[0], y1[1]); o0.w = pk2(y1[2], y1[3]);
            o1.x = pk2(y2[0], y2[1]); o1.y = pk2(y2[2], y2[3]); o1.z = pk2(y3[0], y3[1]); o1.w = pk2(y3[2], y3[3]);
            *((u32x4*)(xg + (size_t)m * D) + 2 * lane) = o0; *((u32x4*)(xg + (size_t)m * D) + 2 * lane + 1) = o1;
            if (GATE_F8) { u32x4 o8; o8.x = pk4_fp8(y0[0], y0[1], y0[2], y0[3]); o8.y = pk4_fp8(y1[0], y1[1], y1[2], y1[3]); o8.z = pk4_fp8(y2[0], y2[1], y2[2], y2[3]); o8.w = pk4_fp8(y3[0], y3[1], y3[2], y3[3]);
                *((u32x4*)((unsigned char*)xg + (WS_H8 - WS_E) + (size_t)m * D) + lane) = o8; }
            if (lane == 0) st_wt(rstd1 + m, rn);
        }
        }
        T = Tn;
    }
}
typedef __attribute__((address_space(1))) unsigned gu32;
#define XB_TMO      128
#define XB_XCNT(j)  (256  + 64 * (j))
#define XB_XSUB(j)  (1280 + 64 * (j))
#define XB_XGEN(j)  (2304 + 64 * (j))
#define XB_TOP      3328
#define XB_TOPGEN   3392
#define XCD_BAR_WORDS 3456
#define XB_SPIN_CAP (1u << 18)

__device__ __forceinline__ unsigned xb_ld(unsigned* p)              { return __hip_atomic_load(p, __ATOMIC_RELAXED, __HIP_MEMORY_SCOPE_AGENT); }
__device__ __forceinline__ unsigned xb_add(unsigned* p, unsigned v) { return __hip_atomic_fetch_add(p, v, __ATOMIC_RELAXED, __HIP_MEMORY_SCOPE_AGENT); }
__device__ __forceinline__ unsigned xb_xcc_id() { return (unsigned)__builtin_amdgcn_s_getreg((3 << 11) | 20) & 0xFu; }
#define XB_SPIN(cond, bar) do { unsigned _sp = 0; while (cond) { __builtin_amdgcn_s_sleep(1); \
    if ((++_sp & 255u) == 0u) { if (xb_ld(&(bar)[XB_TMO])) break; if (_sp > XB_SPIN_CAP) { atomicAdd(&(bar)[XB_TMO], 1u); break; } } } } while (0)

struct XcdBarrier {
    unsigned* bar; unsigned x;
    volatile LAS unsigned* st;
};

__device__ __forceinline__ XcdBarrier xcd_barrier_post(unsigned* bar, volatile LAS unsigned* st) {
    XcdBarrier b; b.bar = bar; b.x = xb_xcc_id(); b.st = st;
    if (threadIdx.x == 0) (void)xb_add(&bar[XB_XCNT(b.x)], 1u);
    return b;
}
__device__ __forceinline__ void xcd_barrier_complete(unsigned* bar, unsigned x, unsigned& nloc, unsigned& nx) {
    const unsigned G = gridDim.x * gridDim.y * gridDim.z;
    unsigned sum, cnt, mine, sp = 0u;
    for (;;) {
        sum = 0u; cnt = 0u; mine = 0u;
#pragma unroll
        for (unsigned j = 0; j < 16; ++j) { const unsigned c = xb_ld(&bar[XB_XCNT(j)]); sum += c; cnt += (c > 0u) ? 1u : 0u; mine = (j == x) ? c : mine; }
        if (sum == G) break;
        __builtin_amdgcn_s_sleep(1);
        if ((++sp & 255u) == 0u) { if (xb_ld(&bar[XB_TMO])) break; if (sp > XB_SPIN_CAP) { atomicAdd(&bar[XB_TMO], 1u); break; } }
    }
    nloc = mine > 0u ? mine : 1u; nx = cnt > 0u ? cnt : 1u;
}

template <bool FIRST>
__device__ __forceinline__ void xcd_barrier(unsigned* bar_, volatile LAS unsigned* st_, int tid0) {
    XcdBarrier b; b.bar = bar_; b.x = xb_xcc_id(); b.st = st_;
    asm volatile("s_waitcnt vmcnt(0)" ::: "memory");
#if XB_SAFE == 8
    __builtin_amdgcn_fence(__ATOMIC_RELEASE, "agent");
    asm volatile("s_waitcnt vmcnt(0)" ::: "memory");
#endif
    __syncthreads();
    if (tid0 == 0) {
        unsigned* bar = b.bar;
        __builtin_amdgcn_s_waitcnt(0);
#if XB_SAFE == 4
        __builtin_amdgcn_fence(__ATOMIC_RELEASE, "");
        asm volatile("s_waitcnt vmcnt(0)" ::: "memory");
#endif
#if XB_SAFE == 1 || XB_SAFE == 2 || XB_SAFE == 5 || XB_SAFE == 8
        __builtin_amdgcn_fence(__ATOMIC_RELEASE, "agent");
        asm volatile("s_waitcnt vmcnt(0)" ::: "memory");
#endif
        unsigned nloc = b.st[0], nx = b.st[1];
        if constexpr (FIRST) { xcd_barrier_complete(bar, b.x, nloc, nx); b.st[0] = nloc; b.st[1] = nx; }
        const unsigned old = xb_add(&bar[XB_XSUB(b.x)], 1u);
        const unsigned gen = old / nloc;
        if (old + 1u == (gen + 1u) * nloc) {
            __builtin_amdgcn_fence(__ATOMIC_RELEASE, "agent");
            asm volatile("s_waitcnt vmcnt(0)" ::: "memory");
            const unsigned og = xb_add(&bar[XB_TOP], 1u);
            const unsigned tg = og / nx;
            if (og + 1u == (tg + 1u) * nx) xb_add(&bar[XB_TOPGEN], 1u);
            else XB_SPIN(xb_ld(&bar[XB_TOPGEN]) == tg, bar);
#if XB_SAFE == 4 || XB_SAFE == 5 || XB_SAFE == 6 || XB_SAFE == 8
            __builtin_amdgcn_fence(__ATOMIC_ACQUIRE, "");
#endif
            __builtin_amdgcn_fence(__ATOMIC_ACQUIRE, "agent");
            xb_add(&bar[XB_XGEN(b.x)], 1u);
            asm volatile("s_waitcnt vmcnt(0)" ::: "memory");
        } else {
            XB_SPIN(xb_ld(&bar[XB_XGEN(b.x)]) == gen, bar);
#if XB_SAFE == 4
            __builtin_amdgcn_fence(__ATOMIC_ACQUIRE, "");
#endif
            __builtin_amdgcn_fence(__ATOMIC_ACQUIRE, "agent");
            asm volatile("s_waitcnt vmcnt(0)" ::: "memory");
        }
    }
    __syncthreads();
#if XB_SAFE == 1 || XB_SAFE == 3
    __builtin_amdgcn_fence(__ATOMIC_ACQUIRE, "agent");
    asm volatile("s_waitcnt vmcnt(0)" ::: "memory");
    __syncthreads();
#endif
}

constexpr int LDS_BYTES = 147456;
#ifndef MK_SYNC_CG
#define MK_SYNC_CG 1
#endif

__device__ __forceinline__ int lane_now() { int l; asm volatile("v_mbcnt_lo_u32_b32 %0, -1, 0\n\tv_mbcnt_hi_u32_b32 %0, -1, %0" : "=v"(l)); return l; }
__device__ __forceinline__ Ctx make_ctx(LAS unsigned char* lds, int tidx) {
    Ctx C; int tid = tidx; asm volatile("" : "+v"(tid));
    C.tid = tid; C.lane = tid & 63; C.wave = __builtin_amdgcn_readfirstlane(tid >> 6); C.G = gridDim.x; C.bid = blockIdx.x;
    C.gw = C.bid * NWAVES + C.wave; C.ngw = C.G * NWAVES; C.gt = C.bid * NTHREADS + tid; C.ngt = C.G * NTHREADS; C.lds = lds;
    return C;
}
template <class Epi, bool F8 = false>
__device__ __forceinline__ void run_gemm(const Ctx& C, const bf16_t* A, int lda, const bf16_t* Bt, int ldb, int N, int K, const Epi& E) {
    pg8::Gemm g{A, Bt, M, N, K, lda, ldb}; pg8::StaticOrder S; S.init(M, N, C.G, C.bid);
    pg8::gemm_phase<Epi, pg8::StaticOrder, true, true, F8>(C.lds, g, S, E, C.tid);
}

__device__ __forceinline__ const void* karg(int i) {
    const __attribute__((address_space(4))) unsigned long long* ka = (const __attribute__((address_space(4))) unsigned long long*)__builtin_amdgcn_kernarg_segment_ptr();
    int z = 0; asm volatile("" : "+s"(z));
    return (const void*)(const __attribute__((address_space(1))) void*)ka[i + z];
}
#define KWS() ((unsigned char*)karg(27))
#define KIN(i) ((const float*)karg(i))


#if PEER_SLICED
#define PEER_CALL(LAST_, DRY_) PEER_CALL_S_<LAST_, DRY_>
template <bool LAST, bool DRY>
__device__ __forceinline__ void PEER_CALL_S_(const Ctx& C, unsigned char* ws, const unsigned char* tab, const float* scU, const float* scV, const int* idx, const float* gate, const float* ssp, float* xs, bf16_t* xg, const float* gn, float* rstd1) {
    peer_sweep<LAST, DRY>(C, tab, tab + 16 * MiB, scU, scV, idx, gate, ssp, xs, xg, gn, rstd1, ws + WS_HQ);
}
#else
#define PEER_CALL(LAST_, DRY_) PEER_CALL_T_<LAST_, DRY_>
template <bool LAST, bool DRY>
__device__ __forceinline__ void PEER_CALL_T_(const Ctx& C, unsigned char* ws, const unsigned char* tab, const float* scU, const float* scV, const int* idx, const float* gate, const float* ssp, float* xs, bf16_t* xg, const float* gn, float* rstd1, const float* g2 = nullptr, bf16_t* xo = nullptr) {
#if PEER_MFMA
    peer_tokens_mf<LAST, DRY>(C, C.gw, C.ngw, tab, scU, scV, idx, gate, ssp, xs, xg, gn, rstd1);
#else
    peer_tokens<LAST, DRY>(C, C.gw, C.ngw, tab, scU, scV, idx, gate, ssp, xs, xg, gn, rstd1, g2, xo, ws + WS_H8);
#endif
}
#endif
#ifndef XB16_INPLACE
#define XB16_INPLACE 1
#endif

#ifndef DBG_WHAT
#define DBG_WHAT 0
#endif
#define DBG_DUMP_RET() do { const Ctx C = MKCTX(); unsigned char* ws = KWS(); float* o = (float*)karg(26); \
    for (size_t i = C.gt; i < (size_t)M * D; i += C.ngt) { const size_t m = i >> 10; const int c = (int)(i & 1023); float v; \
      if (DBG_WHAT == 0) v = bflo((unsigned)((const bf16_t*)(ws + WS_E))[i]); else if (DBG_WHAT == 2) v = bflo((unsigned)((const bf16_t*)(ws + WS_F))[i]); else if (DBG_WHAT == 3) v = bflo((unsigned)((const bf16_t*)(ws + WS_C))[i]); \
      else if (DBG_WHAT == 5) v = bflo((unsigned)((const bf16_t*)(ws + WS_D))[m * QKVW + c]) + 2.0f * bflo((unsigned)((const bf16_t*)(ws + WS_D))[m * QKVW + 1024 + c]); \
      else v = bflo((unsigned)((const bf16_t*)(ws + WS_D))[m * PQ + c]) + 3.0f * bflo((unsigned)((const bf16_t*)(ws + WS_D))[m * PQ + 1024 + c]); \
      o[i] = v; } return; } while (0)
#ifndef DBG_STOP
#define DBG_STOP 0
#endif
#ifndef DBG_LAYER
#define DBG_LAYER 1
#endif
#ifndef DUP_PHASE
#define DUP_PHASE 0
#endif
#ifndef STAG_P1
#define STAG_P1 0
#endif
#ifndef STAG_P5
#define STAG_P5 0
#endif
#ifndef STAG_P6
#define STAG_P6 0
#endif
#ifndef STAG_P7
#define STAG_P7 0
#endif
__device__ __forceinline__ void stagger(unsigned ticks) {
    if (ticks != 0u && blockIdx.x >= 128u) { const unsigned long long t0 = (unsigned long long)wall_clock64(); while ((unsigned long long)wall_clock64() - t0 < ticks) __builtin_amdgcn_s_sleep(16); }
}
#ifndef DUP_LAYER
#define DUP_LAYER -1
#endif
__global__ void __launch_bounds__(NTHREADS, 2) mk_fwd(Args args) {
    extern __shared__ __attribute__((aligned(16))) unsigned char lds_raw[];
    cg::grid_group grid = cg::this_grid();
    const int wid0 = __builtin_amdgcn_readfirstlane((int)threadIdx.x >> 6);
#define TIDX() ((wid0 << 6) | lane_now())
#define MKCTX() make_ctx((LAS unsigned char*)lds_raw, TIDX())
    volatile LAS unsigned* bst = (volatile LAS unsigned*)((LAS unsigned char*)lds_raw + 131072 + 64);
    if (threadIdx.x < 2) bst[threadIdx.x] = 0u;
    __syncthreads();
    (void)xcd_barrier_post((unsigned*)(args.ws + WS_CTL) + 4096, bst);
#define GRID_SYNC() xcd_barrier<false>((unsigned*)(KWS() + WS_CTL) + 4096, (volatile LAS unsigned*)((LAS unsigned char*)lds_raw + 131072 + 64), TIDX())
#define GRID_SYNC_FIRST() xcd_barrier<true>((unsigned*)(KWS() + WS_CTL) + 4096, (volatile LAS unsigned*)((LAS unsigned char*)lds_raw + 131072 + 64), TIDX())
#define GRID_SYNC_CG() do { asm volatile("s_waitcnt vmcnt(0)" ::: "memory"); grid.sync(); if (threadIdx.x == 0) { __builtin_amdgcn_fence(__ATOMIC_ACQUIRE, ""); asm volatile("s_waitcnt vmcnt(0)" ::: "memory"); } __syncthreads(); } while (0)

    for (int rep_ = 0; rep_ < (DUP_PHASE == 10 ? 2 : 1); ++rep_) { const Ctx C = MKCTX(); phase_prologue(C, args); }
#if XB16 && OUT_PREFILL == 1
    { const Ctx C = MKCTX(); f32x4* o = (f32x4*)karg(26); for (size_t i = C.gt; i < (size_t)M * D / 4; i += C.ngt) o[i] = (f32x4){3.0f, 3.0f, 3.0f, 3.0f}; }
#endif
    if (gridDim.y == 0x7fffffffu) GRID_SYNC_CG();
    GRID_SYNC_FIRST();

    if (DUP_PHASE == 11) { for (int rep_ = 0; rep_ < 10; ++rep_) GRID_SYNC(); }
    for (int l = 0; l < DEPTH; ++l) {
#define WL(ws) ((ws) + WS_W + (size_t)l * W_LAYER)
#if XB16 && !XB16_INPLACE
        static_assert(DEPTH == 2, "residual buffer rotation is written for two layers");
#define XA_(ws) (l == 0 ? (bf16_t*)((ws) + WS_E) : (bf16_t*)((unsigned char*)karg(26) + 64 * MiB))
#define X1_(ws) (l == 0 ? (bf16_t*)karg(26) : (bf16_t*)((ws) + WS_E))
#define X2_(ws) ((bf16_t*)((unsigned char*)karg(26) + 64 * MiB))
#else
#define XA_(ws) ((bf16_t*)((ws) + WS_E))
#define X1_(ws) ((bf16_t*)((ws) + WS_E))
#define X2_(ws) ((bf16_t*)((ws) + WS_E))
#endif
        const size_t o_rstd = l == 0 ? WS_RSTD1 : WS_L1, o_lse = l == 0 ? WS_LSE : WS_L1 + 1 * MiB, o_send = l == 0 ? WS_SEND : WS_L1 + 3 * MiB, o_ssp = l == 0 ? WS_SSP : WS_L1 + 5 * MiB;
        const size_t o_rstd_next = WS_L1;
        for (int rep_ = 0; rep_ < ((DUP_PHASE == 1 && (DUP_LAYER < 0 || DUP_LAYER == l)) ? 2 : 1); ++rep_) {
        stagger(STAG_P1);
        { const Ctx C = MKCTX(); unsigned char* ws = KWS(); pg8::EpiZ E{(bf16_t*)(ws + WS_C), (bf16_t*)(ws + WS_D), (const float*)(ws + o_rstd)};
          run_gemm(C, (const bf16_t*)XA_(ws), D, (const bf16_t*)(WL(ws) + WO_WIN), D, NZ, D, E);
#if TABQ_DEFER
          static_assert(DEPTH == 2, "deferred table conversion is written for two layers");
          if (C.G == 256 && C.bid >= 128) { const int iw = (C.bid - 128) * NWAVES + C.wave;
              quant_rows(KIN(I_PU) + (size_t)NEXP * D, KIN(I_PV) + (size_t)NEXP * D, ws + WS_TAB + TAB_LAYER, (float*)(ws + WS_TSC + 131072), (float*)(ws + WS_TSC + 131072 + 65536), (NEXP / 2) * l + iw, (NEXP / 2) * (l + 1), 1024, C.lane);
 }
#endif
        }
        GRID_SYNC();
        }
#if DBG_STOP >= 11 && DBG_STOP <= 18
        if (DBG_STOP == 10 + 1 && l == DBG_LAYER) DBG_DUMP_RET();
#endif
        for (int rep_ = 0; rep_ < ((DUP_PHASE == 2 && (DUP_LAYER < 0 || DUP_LAYER == l)) ? 2 : 1); ++rep_) {
        for (int r2_ = 0; r2_ < (DUP_PHASE == 21 ? 2 : 1); ++r2_)
        { const Ctx C = MKCTX(); unsigned char* ws = KWS();
          attn_items(C, (const bf16_t*)(ws + WS_D), ROPE_FLY ? (const f32x2*)KIN(I_POS) : (const f32x2*)(ws + WS_ROPE), (bf16_t*)(ws + WS_F), (float*)(ws + o_lse)); }
        for (int r2_ = 0; r2_ < (DUP_PHASE == 22 ? 2 : 1); ++r2_)
        { const Ctx C = MKCTX(); unsigned char* ws = KWS();
          for (int it = C.gw; it < BATCH * NCH * SSM_G; it += C.ngw) ssm_item<false>(C, it, (const bf16_t*)(ws + WS_C), ws + WS_SSMC + (size_t)l * SSMC_LAYER, (f32x2*)(ws + o_send), nullptr, nullptr, nullptr, nullptr); }
        GRID_SYNC();
        }
#if DBG_STOP >= 11 && DBG_STOP <= 18
        if (DBG_STOP == 10 + 2 && l == DBG_LAYER) DBG_DUMP_RET();
#endif
        for (int rep_ = 0; rep_ < ((DUP_PHASE == 3 && (DUP_LAYER < 0 || DUP_LAYER == l)) ? 2 : 1); ++rep_) {
        for (int r2_ = 0; r2_ < (DUP_PHASE == 31 ? 2 : 1); ++r2_)
        { const Ctx C = MKCTX(); unsigned char* ws = KWS();
          const float* cre = KIN(I_CRE) + (size_t)l * SSM_G * SSM_P * SSM_N; const float* cim = KIN(I_CIM) + (size_t)l * SSM_G * SSM_P * SSM_N; const float* dsk = KIN(I_SD) + (size_t)l * SSMW;
          for (int it = C.gw; it < BATCH * NCH * SSM_G; it += C.ngw)
              ssm_item<true>(C, it, (const bf16_t*)(ws + WS_C), ws + WS_SSMC + (size_t)l * SSMC_LAYER, (f32x2*)(ws + o_send), cre, cim, dsk, (bf16_t*)(ws + WS_D + 32 * MiB)); }
        for (int r2_ = 0; r2_ < (DUP_PHASE == 32 ? 2 : 1); ++r2_)
        { const Ctx C = MKCTX(); unsigned char* ws = KWS();
          pool_items(C, (const bf16_t*)(ws + WS_C), (bf16_t*)(ws + WS_D));
          attn_merge_items(C, (const bf16_t*)(ws + WS_F), (const float*)(ws + o_lse), (bf16_t*)(ws + WS_D + 64 * MiB));
          }
        GRID_SYNC();
        }
#if DBG_STOP >= 11 && DBG_STOP <= 18
        if (DBG_STOP == 10 + 3 && l == DBG_LAYER) DBG_DUMP_RET();
#endif
        for (int rep_ = 0; rep_ < ((DUP_PHASE == 4 && (DUP_LAYER < 0 || DUP_LAYER == l)) ? 2 : 1); ++rep_) {
        { const Ctx C = MKCTX(); unsigned char* ws = KWS(); pg8::EpiPlain E{(bf16_t*)(ws + WS_C), POOLW, nullptr};
          run_gemm(C, (const bf16_t*)(ws + WS_D), POOLW, (const bf16_t*)(WL(ws) + WO_POOL), POOLW, POOLW, POOLW, E); }
        { const Ctx C = MKCTX(); unsigned char* ws = KWS(); pg8::EpiGlu E{(bf16_t*)(ws + WS_C + 32 * MiB)};
          run_gemm(C, (const bf16_t*)(ws + WS_D + 32 * MiB), SSMW, (const bf16_t*)(WL(ws) + WO_GLU), SSMW, 2 * SSMW, SSMW, E); }
        GRID_SYNC();
        }
#if DBG_STOP >= 11 && DBG_STOP <= 18
        if (DBG_STOP == 10 + 4 && l == DBG_LAYER) DBG_DUMP_RET();
#endif
        for (int rep_ = 0; rep_ < ((DUP_PHASE == 5 && (DUP_LAYER < 0 || DUP_LAYER == l)) ? 2 : 1); ++rep_) {
#if GATE_F8
#define GATE_GEMM(b) { const Ctx C = MKCTX(); unsigned char* ws = KWS(); pg8::EpiGate E{(bf16_t*)(ws + WS_D + 80 * MiB), (const float*)(ws + o_rstd), 1.0f / GATE_WSC}; \
          run_gemm<pg8::EpiGate, true>(C, (const bf16_t*)(ws + WS_H8), D / 2, (const bf16_t*)(WL(ws) + WO_WIN + (size_t)NZ * D * 2 + (size_t)(b) * D * D), D / 2, D, D / 2, E); }
#else
#define GATE_GEMM(b) { const Ctx C = MKCTX(); unsigned char* ws = KWS(); pg8::EpiGate E{(bf16_t*)(ws + WS_D + 80 * MiB), (const float*)(ws + o_rstd), 1.0f}; \
          run_gemm(C, (const bf16_t*)XA_(ws), D, (const bf16_t*)(WL(ws) + WO_WIN) + (size_t)(NZ + (b) * D) * D, D, D, D, E); }
#endif
        stagger(STAG_P5);
        GATE_GEMM(0)
        { const Ctx C = MKCTX(); unsigned char* ws = KWS(); pg8::EpiMerge<true> E{(const bf16_t*)(ws + WS_D + 80 * MiB), (bf16_t*)(ws + WS_F), ABL_POOL ? 0.f : (S_U8 ? 1.0f / 255.0f : 1.f)};
          run_gemm(C, (const bf16_t*)(ws + WS_C), POOLW, (const bf16_t*)(WL(ws) + WO_PPROJ), POOLW, D, POOLW, E); }
        GATE_GEMM(1)
        { const Ctx C = MKCTX(); unsigned char* ws = KWS(); pg8::EpiMerge<false> E{(const bf16_t*)(ws + WS_D + 80 * MiB), (bf16_t*)(ws + WS_F), ABL_SSM ? 0.f : (S_U8 ? 1.0f / 255.0f : 1.f)};
          run_gemm(C, (const bf16_t*)(ws + WS_C + 32 * MiB), SSMW, (const bf16_t*)(WL(ws) + WO_SPROJ), SSMW, D, SSMW, E); }
        GATE_GEMM(2)
        { const Ctx C = MKCTX(); unsigned char* ws = KWS(); pg8::EpiMerge<false> E{(const bf16_t*)(ws + WS_D + 80 * MiB), (bf16_t*)(ws + WS_F), ABL_ATTN ? 0.f : (S_U8 ? 1.0f / 255.0f : 1.f)};
          run_gemm(C, (const bf16_t*)(ws + WS_D + 64 * MiB), AOUT, (const bf16_t*)(WL(ws) + WO_APROJ), AOUT, D, AOUT, E); }
        GRID_SYNC();
        }
#if DBG_STOP >= 11 && DBG_STOP <= 18
        if (DBG_STOP == 10 + 5 && l == DBG_LAYER) DBG_DUMP_RET();
#endif
        for (int rep_ = 0; rep_ < ((DUP_PHASE == 6 && (DUP_LAYER < 0 || DUP_LAYER == l)) ? 2 : 1); ++rep_) {
        stagger(STAG_P6);
        { const Ctx C = MKCTX(); unsigned char* ws = KWS(); float* xs = (float*)karg(26);
#if XB16
          pg8::EpiOut E{(const bf16_t*)XA_(ws), X1_(ws), (float*)(ws + o_ssp), ws + WS_H8};
#else
          pg8::EpiOut E{l == 0 ? KIN(I_X) : (const float*)xs, xs, (bf16_t*)(ws + WS_E), KIN(I_N2G) + (size_t)l * D, (float*)(ws + o_ssp), ws + WS_H8};
#endif
          run_gemm(C, (const bf16_t*)(ws + WS_F), D, (const bf16_t*)(WL(ws) + WO_WOUT), D, D, D, E); }
        GRID_SYNC();
        }
#if DBG_STOP >= 11 && DBG_STOP <= 18
        if (DBG_STOP == 10 + 6 && l == DBG_LAYER) DBG_DUMP_RET();
#endif
        for (int rep_ = 0; rep_ < ((DUP_PHASE == 7 && (DUP_LAYER < 0 || DUP_LAYER == l)) ? 2 : 1); ++rep_) {
        stagger(STAG_P7);
#if Q_F8
        { const Ctx C = MKCTX(); unsigned char* ws = KWS(); pg8::EpiPlain E{(bf16_t*)(ws + WS_D), PQ, (const float*)(ws + o_ssp), 1.0f / GATE_WSC};
          run_gemm<pg8::EpiPlain, true>(C, (const bf16_t*)(ws + WS_H8), D / 2, (const bf16_t*)(WL(ws) + WO_WQ), D / 2, PQ, D / 2, E); }
#else
        { const Ctx C = MKCTX(); unsigned char* ws = KWS(); pg8::EpiPlain E{(bf16_t*)(ws + WS_D), PQ, (const float*)(ws + o_ssp)};
          run_gemm(C, (const bf16_t*)X1_(ws), D, (const bf16_t*)(WL(ws) + WO_WQ), D, PQ, D, E); }
#endif
#if FUSE78
        { const Ctx C = MKCTX(); unsigned char* ws = KWS();
          asm volatile("s_waitcnt vmcnt(0)" ::: "memory"); __syncthreads();
          topk_stage_keys(C, (const bf16_t*)(WL(ws) + WO_K1), (const bf16_t*)(WL(ws) + WO_K2));
          __syncthreads();
          pg8::StaticOrder S; S.init(M, PQ, C.G, C.bid);
          topk_own_items(C, S, (const bf16_t*)(ws + WS_D), (int*)(ws + WS_C), (float*)(ws + WS_C + 16 * MiB)); }
#endif
        GRID_SYNC();
        }
#if DBG_STOP >= 11 && DBG_STOP <= 18
        if (DBG_STOP == 10 + 7 && l == DBG_LAYER) DBG_DUMP_RET();
#endif
#if !FUSE78
        for (int rep_ = 0; rep_ < ((DUP_PHASE == 8 && (DUP_LAYER < 0 || DUP_LAYER == l)) ? 2 : 1); ++rep_) {
        { const Ctx C = MKCTX(); unsigned char* ws = KWS();
          topk_stage_keys(C, (const bf16_t*)(WL(ws) + WO_K1), (const bf16_t*)(WL(ws) + WO_K2));
          __syncthreads();
          topk_items(C, (const bf16_t*)(ws + WS_D), (int*)(ws + WS_C), (float*)(ws + WS_C + 16 * MiB)); }
        GRID_SYNC();
        }
#endif
#if DBG_STOP >= 11 && DBG_STOP <= 18
        if (DBG_STOP == 10 + 8 && l == DBG_LAYER) DBG_DUMP_RET();
#endif
#if DBG_STOP == 28 || DBG_STOP == 27
        if (l == DBG_LAYER) { const Ctx C = MKCTX(); unsigned char* ws = KWS(); float* o = (float*)karg(26);
          if (DBG_STOP == 28) { const int* pi = (const int*)(ws + WS_C); for (size_t i = C.gt; i < (size_t)M * D; i += C.ngt) { const size_t m = i >> 10; const int c = (int)(i & 1023); o[i] = c < 128 ? (float)pi[m * 128 + c] : 0.f; } }
          else { const bf16_t* q = (const bf16_t*)(ws + WS_D); for (size_t i = C.gt; i < (size_t)M * D; i += C.ngt) { const size_t m = i >> 10; const int c = (int)(i & 1023); o[i] = bflo((unsigned)q[m * PQ + c]) + bflo((unsigned)q[m * PQ + 1024 + c]) * 3.0f; } }
          return; }
#endif
        if (l + 1 < DEPTH) {
            { const Ctx C = MKCTX(); unsigned char* ws = KWS(); float* xs = (float*)karg(26); const float* gn = KIN(I_N1G) + (size_t)(l + 1) * D;
              if (DUP_PHASE == 9) { PEER_CALL(false, true)(C, ws, ws + WS_TAB + (size_t)l * TAB_LAYER, (const float*)(ws + WS_TSC + (size_t)l * 131072), (const float*)(ws + WS_TSC + (size_t)l * 131072 + 65536), (const int*)(ws + WS_C), (const float*)(ws + WS_C + 16 * MiB),
                                                                     (const float*)(ws + o_ssp), xs, X1_(ws), gn, (float*)(ws + o_rstd_next), KIN(I_N2G) + (size_t)l * D, X2_(ws)); }
              PEER_CALL(false, false)(C, ws, ws + WS_TAB + (size_t)l * TAB_LAYER, (const float*)(ws + WS_TSC + (size_t)l * 131072), (const float*)(ws + WS_TSC + (size_t)l * 131072 + 65536), (const int*)(ws + WS_C), (const float*)(ws + WS_C + 16 * MiB),
                                                                     (const float*)(ws + o_ssp), xs, X1_(ws), gn, (float*)(ws + o_rstd_next), KIN(I_N2G) + (size_t)l * D, X2_(ws)); }
            GRID_SYNC();
#if DBG_STOP == 6
            DBG_DUMP_RET();
#endif
        } else {
            const Ctx C = MKCTX(); unsigned char* ws = KWS(); float* xs = (float*)karg(26); const float* gn = KIN(I_FG);
            PEER_CALL(true, false)(C, ws, ws + WS_TAB + (size_t)l * TAB_LAYER, (const float*)(ws + WS_TSC + (size_t)l * 131072), (const float*)(ws + WS_TSC + (size_t)l * 131072 + 65536), (const int*)(ws + WS_C), (const float*)(ws + WS_C + 16 * MiB),
                                                                  (const float*)(ws + o_ssp), xs, X1_(ws), gn, (float*)(ws + o_rstd_next), KIN(I_N2G) + (size_t)l * D, X2_(ws));
#ifdef PROBE_END_RELEASE
            asm volatile("s_waitcnt vmcnt(0)" ::: "memory"); __syncthreads();
            if (TIDX() == 0) { __builtin_amdgcn_fence(__ATOMIC_RELEASE, ""); asm volatile("s_waitcnt vmcnt(0)" ::: "memory"); }
#endif
        }
    }
}

extern "C" void kernel_launch(void* const* d_in, const int* in_sizes, int n_in, void* d_out, int out_size, void* d_ws, size_t ws_size, hipStream_t stream) {
    static int grid = 0;
    if (grid == 0) {
        if (n_in != 26 || in_sizes[0] != M * D || out_size != M * D || ws_size < WS_END) { fprintf(stderr, "kernel_launch: unexpected shapes (n_in %d, in0 %d, out %d, ws %zu); nothing launched\n", n_in, n_in > 0 ? in_sizes[0] : -1, out_size, ws_size); grid = -1; return; }
        int dev = 0, cus = 0, per_cu = 0;
        if (hipGetDevice(&dev) != hipSuccess || hipDeviceGetAttribute(&cus, hipDeviceAttributeMultiprocessorCount, dev) != hipSuccess) { grid = -1; return; }
        if (hipFuncSetAttribute((const void*)mk_fwd, hipFuncAttributeMaxDynamicSharedMemorySize, LDS_BYTES) != hipSuccess) { fprintf(stderr, "kernel_launch: hipFuncSetAttribute failed\n"); grid = -1; return; }
        if (hipOccupancyMaxActiveBlocksPerMultiprocessor(&per_cu, (const void*)mk_fwd, NTHREADS, LDS_BYTES) != hipSuccess || per_cu < 1) { fprintf(stderr, "kernel_launch: occupancy query says %d\n", per_cu); grid = -1; (void)hipGetLastError(); return; }
        grid = cus;
    }
    if (grid < 0) return;
    (void)hipMemsetAsync((char*)d_ws + WS_CTL, 0, CTL_BYTES, stream);
    Args a{};
    for (int i = 0; i < 26; ++i) a.in[i] = d_in[i];
    a.out = (float*)d_out; a.ws = (unsigned char*)d_ws;
    void* kargs[] = {&a};
    const hipError_t e = hipLaunchCooperativeKernel((const void*)mk_fwd, dim3(grid), dim3(NTHREADS), kargs, LDS_BYTES, stream);
    if (e != hipSuccess) fprintf(stderr, "kernel_launch: cooperative launch failed: %s (grid %d)\n", hipGetErrorString(e), grid);
}
```

```cpp
#define XB16 1
#include <hip/hip_runtime.h>
#include <hip/hip_cooperative_groups.h>
#include <cstdio>
#include <cstdint>
namespace cg = cooperative_groups;

#ifndef TAB_BITS
#define TAB_BITS 4
#endif
#ifndef GATE_F8
#define GATE_F8 1
#endif
#ifndef XB16
#define XB16 0
#endif
#if XB16 && (PEER_SLICED || PEER_MFMA)
#error "XB16 is implemented for the fused token-major PEER path only"
#endif
#ifndef PEER_RESDMA
#define PEER_RESDMA 1
#endif
#ifndef PEER_HDMA
#define PEER_HDMA 0
#endif
#ifndef FUSE78
#define FUSE78 1
#endif
#if FUSE78 && Q_F8
#error "FUSE78 is wired for the bf16 q GEMM call"
#endif
#ifndef TABQ_DEFER
#define TABQ_DEFER 1
#endif
#ifndef ROPE_FLY
#define ROPE_FLY 1
#endif
#ifndef OUT_PREFILL
#define OUT_PREFILL 1
#endif
#ifndef S_U8
#define S_U8 2
#endif
#ifndef Q_F8
#define Q_F8 0
#endif
constexpr float GATE_WSC = 64.0f;
#ifndef PEER_DRAIN
#define PEER_DRAIN 0
#endif
#ifndef PEER_MFMA
#define PEER_MFMA 0
#endif
#ifndef EPI_NT
#define EPI_NT 0
#endif
#ifndef PEER_SLICED
#define PEER_SLICED 0
#endif
#ifndef XB_SAFE
#define XB_SAFE 5
#endif
#ifndef PEER_RING
#define PEER_RING 2
#endif
#ifndef PEER_XTOK
#define PEER_XTOK 1
#endif
#ifndef ABL_POOL
#define ABL_POOL 0
#endif
#ifndef ABL_SSM
#define ABL_SSM 0
#endif
#ifndef ABL_ATTN
#define ABL_ATTN 0
#endif
#ifndef ABL_PEER
#define ABL_PEER 0
#endif
constexpr int D = 1024, BATCH = 4, SEQ = 8192, M = BATCH * SEQ, DEPTH = 2;
constexpr int IN_COLS = 6400, NZ = 3328;
constexpr int POOLW = 512, SSMW = 512, AW = 768, AOUT = 256, QKVW = 2304;
constexpr int SSM_G = 32, SSM_P = 16, SSM_N = 64;
constexpr int CH = 256, NCH = SEQ / CH;
constexpr int PH = 8, NKEYS = 128, TOPK = 16, NEXP = 16384, PQ = 2048;
constexpr float EPS = 1e-6f;
constexpr int NWAVES = 8, NTHREADS = 512;

constexpr size_t MiB = 1u << 20;
constexpr size_t WS_CTL = 0;
constexpr size_t WS_W = 1 * MiB, W_LAYER = 23 * MiB;
constexpr size_t WO_WIN = 0, WO_POOL = 13107200, WO_PPROJ = WO_POOL + 524288, WO_GLU = WO_PPROJ + 1048576, WO_SPROJ = WO_GLU + 1048576,
                 WO_APROJ = WO_SPROJ + 1048576, WO_WOUT = WO_APROJ + 524288, WO_WQ = WO_WOUT + 2097152, WO_K1 = WO_WQ + 4194304, WO_K2 = WO_K1 + 32768, WO_END = WO_K2 + 32768;
static_assert(WO_END <= W_LAYER, "weights");
constexpr size_t WS_SSMC = 47 * MiB, SSMC_LAYER = 512 * 1024;
constexpr size_t WS_ROPE = 48 * MiB;
constexpr size_t WS_RSTD1 = 56 * MiB, WS_SS2 = WS_RSTD1 + 131072, WS_LSE = WS_SS2 + 131072  , WS_SEND = WS_LSE + 3 * (size_t)M * 16  ;
constexpr size_t WS_TAB = 60 * MiB, TAB_LAYER = 32 * MiB;
constexpr size_t WS_TSC = 59 * MiB + 768 * 1024;
constexpr size_t WS_C = 124 * MiB;
constexpr size_t WS_D = 188 * MiB;
constexpr size_t WS_E = 332 * MiB;
constexpr size_t WS_F = 396 * MiB;
constexpr size_t WS_SSP = 460 * MiB;
constexpr size_t WS_L1 = 462 * MiB, L1_SIZE = 8 * MiB;
constexpr size_t WS_HQ = 470 * MiB;
constexpr size_t WS_H8 = WS_HQ;
constexpr size_t WS_END = 502 * MiB;
constexpr size_t CTL_BYTES = 1 * MiB;
static_assert(WS_SEND + (size_t)BATCH * NCH * 32 * 64 * 8 <= WS_TSC && WS_TSC + 2 * 131072 <= 60 * MiB && WS_TAB + 2 * TAB_LAYER <= WS_C, "small");

#define LAS __attribute__((address_space(3)))
typedef unsigned short bf16_t;
typedef short bf16x8 __attribute__((ext_vector_type(8)));
typedef float f32x4 __attribute__((ext_vector_type(4)));
typedef float f32x2 __attribute__((ext_vector_type(2)));
typedef unsigned u32x4 __attribute__((ext_vector_type(4)));
typedef unsigned u32x2 __attribute__((ext_vector_type(2)));
typedef _Float16 h2_t __attribute__((ext_vector_type(2)));
typedef __bf16 b2_t __attribute__((ext_vector_type(2)));
typedef short v4i16_t __attribute__((ext_vector_type(4)));

__device__ __forceinline__ unsigned f2bf(float f) { unsigned u = __builtin_bit_cast(unsigned, f); return (u + 0x7fffu + ((u >> 16) & 1u)) >> 16; }
__device__ __forceinline__ unsigned pk2(float lo, float hi) { f32x2 v = {lo, hi}; b2_t b = __builtin_convertvector(v, b2_t); return __builtin_bit_cast(unsigned, b); }
__device__ __forceinline__ unsigned pk4_fp8(float a, float b, float c, float d) {
    a = __builtin_fminf(__builtin_fmaxf(a, -448.f), 448.f); b = __builtin_fminf(__builtin_fmaxf(b, -448.f), 448.f); c = __builtin_fminf(__builtin_fmaxf(c, -448.f), 448.f); d = __builtin_fminf(__builtin_fmaxf(d, -448.f), 448.f);
    int w = __builtin_amdgcn_cvt_pk_fp8_f32(a, b, 0, false); w = __builtin_amdgcn_cvt_pk_fp8_f32(c, d, w, true); return (unsigned)w;
}
__device__ __forceinline__ float bflo(unsigned w) { return __builtin_bit_cast(float, w << 16); }
__device__ __forceinline__ float bfhi(unsigned w) { return __builtin_bit_cast(float, w & 0xffff0000u); }
__device__ __forceinline__ unsigned pkh2(float lo, float hi) { h2_t h = {(_Float16)lo, (_Float16)hi}; return __builtin_bit_cast(unsigned, h); }
__device__ __forceinline__ float fast_exp2(float x) { return __builtin_amdgcn_exp2f(x); }
__device__ __forceinline__ float fast_rcp(float x) { return __builtin_amdgcn_rcpf(x); }
__device__ __forceinline__ float sigmoidf_(float x) { return fast_rcp(1.0f + fast_exp2(-1.4426950408889634f * x)); }
__device__ __forceinline__ float gelu_tanh(float x) { const float u = 1.5957691216057308f * (x + 0.044715f * x * x * x); return x * sigmoidf_(u); }
__device__ __forceinline__ unsigned fbits(float f) { return __builtin_bit_cast(unsigned, f); }
__device__ __forceinline__ float bitsf(unsigned u) { return __builtin_bit_cast(float, u); }
template <int MASK> __device__ __forceinline__ unsigned shx_u(unsigned v) {
    if constexpr (MASK < 32) return (unsigned)__builtin_amdgcn_ds_swizzle((int)v, 0x1F | (MASK << 10));
    else { const auto r = __builtin_amdgcn_permlane32_swap(v, v, false, false);
           return (unsigned)__builtin_amdgcn_update_dpp((int)r[1], (int)r[0], 0xE4, 0xC, 0xF, false); }
}
template <int MASK> __device__ __forceinline__ float shx(float v) { return bitsf(shx_u<MASK>(fbits(v))); }
template <int MASK> __device__ __forceinline__ int shx(int v) { return (int)shx_u<MASK>((unsigned)v); }
__device__ __forceinline__ float shfl_idx(float v, int src) { return bitsf((unsigned)__builtin_amdgcn_ds_bpermute(src << 2, (int)fbits(v))); }
__device__ __forceinline__ int shfl_idx(int v, int src) { return __builtin_amdgcn_ds_bpermute(src << 2, v); }
__device__ __forceinline__ float wave_sum(float v) { v += shx<1>(v); v += shx<2>(v); v += shx<4>(v); v += shx<8>(v); v += shx<16>(v); v += shx<32>(v); return v; }
__device__ __forceinline__ float wave_max(float v) { v = fmaxf(v, shx<1>(v)); v = fmaxf(v, shx<2>(v)); v = fmaxf(v, shx<4>(v)); v = fmaxf(v, shx<8>(v)); v = fmaxf(v, shx<16>(v)); v = fmaxf(v, shx<32>(v)); return v; }
__device__ __forceinline__ h2_t as_h2(unsigned w) { return __builtin_bit_cast(h2_t, w); }
__device__ __forceinline__ void st_wt(float* p, float v) { __hip_atomic_store(p, v, __ATOMIC_RELAXED, __HIP_MEMORY_SCOPE_AGENT); }
#define LDS_WAIT() asm volatile("s_waitcnt lgkmcnt(0)" ::: "memory")
#define VM_WAIT() asm volatile("s_waitcnt vmcnt(0)" ::: "memory")
namespace pg8 {
#define PG8_LAS __attribute__((address_space(3)))
constexpr int BM = 256, BK = 64, HALF = 128, HTB = HALF * BK * 2  , STAGE_BYTES = 8 * HTB, NXCD = 8, WGM = 8;
__host__ __device__ __forceinline__ int lds_byte(int r, int c) { const int st = (r >> 4) * 2 + (c >> 5), rr = r & 15, cc = c & 31, ob = rr * 64 + cc * 2; return st * 1024 + (ob ^ (((ob >> 9) & 1) << 5)); }
__host__ __device__ __forceinline__ void stage_rc(int b, int& R, int& C) { const int st = b / 1024, sb = b % 1024, swz = sb ^ (((sb >> 9) & 1) << 5); R = (st >> 1) * 16 + swz / 64; C = (st & 1) * 32 + (swz % 64) / 2; }
__host__ __device__ __forceinline__ int perm32(int rho) { const int n = rho >> 4, i = rho & 15; return 8 * (i >> 2) + 4 * n + (i & 3); }

typedef int i32x8_t __attribute__((ext_vector_type(8)));
typedef int i32x4_t __attribute__((ext_vector_type(4)));
__device__ __forceinline__ i32x8_t cat8(const bf16x8 a, const bf16x8 b) { const i32x4_t x = __builtin_bit_cast(i32x4_t, a), y = __builtin_bit_cast(i32x4_t, b); return __builtin_shufflevector(x, y, 0, 1, 2, 3, 4, 5, 6, 7); }
struct Unit { int pm, pn; };
struct Gemm { const bf16_t* A; const bf16_t* Bt; int M, N, K, lda, ldb; };

struct StaticOrder {
    int nM, nN, nwg, G, c;
    __host__ __device__ void init(int M_, int N_, int G_, int c_) { nM = M_ / BM; nN = N_ / BM; nwg = nM * nN; G = G_; c = c_; }
    __host__ __device__ bool next(int i, Unit& u) const {
        const long L = (long)i * G + c; if (L >= nwg) return false;
        int wgid = (int)L; { const int q = nwg / NXCD, r = nwg % NXCD, xcd = wgid % NXCD, off = wgid / NXCD; wgid = (xcd < r ? xcd * (q + 1) : r * (q + 1) + (xcd - r) * q) + off; }
        const int nig = WGM * nN, gid = wgid / nig, fm = gid * WGM, gsz = (nM - fm) < WGM ? (nM - fm) : WGM;
        u.pm = fm + ((wgid % nig) % gsz); u.pn = (wgid % nig) / gsz; return true;
    }
    __device__ __forceinline__ void a_ready(const Unit&) const {}
    __device__ __forceinline__ void done(const Unit&) const {}
};

typedef f32x4 acc_t[2][2][4][2];

__device__ __forceinline__ u32x4 pack8(const f32x4& a, const f32x4& b) { u32x4 w; w.x = pk2(a[0], a[1]); w.y = pk2(a[2], a[3]); w.z = pk2(b[0], b[1]); w.w = pk2(b[2], b[3]); return w; }
__device__ __forceinline__ void unpack8(const u32x4& w, f32x4& a, f32x4& b) { a = (f32x4){bflo(w.x), bfhi(w.x), bflo(w.y), bfhi(w.y)}; b = (f32x4){bflo(w.z), bfhi(w.z), bflo(w.w), bfhi(w.w)}; }

__device__ __forceinline__ float row_rs(const float* ssp, int row) {
    const f32x4* p = (const f32x4*)(ssp + (size_t)row * 16); const f32x4 a = p[0], b = p[1], c = p[2], d = p[3];
    const float s = ((a[0] + a[1]) + (a[2] + a[3])) + ((b[0] + b[1]) + (b[2] + b[3])) + ((c[0] + c[1]) + (c[2] + c[3])) + ((d[0] + d[1]) + (d[2] + d[3]));
    return __builtin_amdgcn_rsqf(s * (1.0f / D) + EPS);
}
struct EpiZ {
    static constexpr bool PERM = true, AFTER_DRAIN = false;
    bf16_t* zps; bf16_t* zqkv; const float* rstd;
    __device__ __forceinline__ void operator()(const acc_t& acc, const Unit& u, int wr, int wc, int fr, int fq) const {
        const int row0 = u.pm * BM + wr * 64 + fr;
        bf16_t* base; int ldc, colt;
        if (u.pn < 4) { base = zps; ldc = 1024; colt = u.pn * BM; } else { base = zqkv; ldc = QKVW; colt = (u.pn - 4) * BM; }
        const int col0 = colt + wc * 32 + 8 * fq;
        float rsv[2][4];
#pragma unroll
        for (int ai = 0; ai < 2; ++ai)
#pragma unroll
            for (int m = 0; m < 4; ++m) rsv[ai][m] = rstd[row0 + ai * HALF + m * 16];
#pragma unroll
        for (int ai = 0; ai < 2; ++ai)
#pragma unroll
            for (int m = 0; m < 4; ++m) { const int row = row0 + ai * HALF + m * 16; const float rs = rsv[ai][m]; bf16_t* rowp = base + (size_t)row * ldc + col0;
#pragma unroll
                for (int bj = 0; bj < 2; ++bj) *(u32x4*)(rowp + bj * HALF) = pack8(acc[ai][bj][m][0] * rs, acc[ai][bj][m][1] * rs); }
    }
};
struct EpiPlain {
    static constexpr bool PERM = true, AFTER_DRAIN = false;
    bf16_t* O; int ldc; const float* ss; float wsc = 1.0f;
    __device__ __forceinline__ void operator()(const acc_t& acc, const Unit& u, int wr, int wc, int fr, int fq) const {
        const int row0 = u.pm * BM + wr * 64 + fr, col0 = u.pn * BM + wc * 32 + 8 * fq;
        float rsv[2][4];
#pragma unroll
        for (int ai = 0; ai < 2; ++ai)
#pragma unroll
            for (int m = 0; m < 4; ++m) rsv[ai][m] = ss ? row_rs(ss, row0 + ai * HALF + m * 16) * wsc : 1.0f;
#pragma unroll
        for (int ai = 0; ai < 2; ++ai)
#pragma unroll
            for (int m = 0; m < 4; ++m) { const int row = row0 + ai * HALF + m * 16; const float rs = rsv[ai][m]; bf16_t* rowp = O + (size_t)row * ldc + col0;
#pragma unroll
                for (int bj = 0; bj < 2; ++bj) *(u32x4*)(rowp + bj * HALF) = pack8(acc[ai][bj][m][0] * rs, acc[ai][bj][m][1] * rs); }
    }
};
struct EpiGlu {
    static constexpr bool PERM = true, AFTER_DRAIN = false;
    bf16_t* O;
    __device__ __forceinline__ void operator()(const acc_t& acc, const Unit& u, int wr, int wc, int fr, int fq) const {
        const int row0 = u.pm * BM + wr * 64 + fr, col0 = u.pn * HALF + wc * 32 + 8 * fq;
#pragma unroll
        for (int ai = 0; ai < 2; ++ai)
#pragma unroll
            for (int m = 0; m < 4; ++m) { const int row = row0 + ai * HALF + m * 16; f32x4 o[2];
#pragma unroll
                for (int n = 0; n < 2; ++n)
#pragma unroll
                    for (int j = 0; j < 4; ++j) o[n][j] = acc[ai][0][m][n][j] * sigmoidf_(acc[ai][1][m][n][j]);
                *(u32x4*)(O + (size_t)row * SSMW + col0) = pack8(o[0], o[1]); }
    }
};
struct EpiGate {
    static constexpr bool PERM = true, AFTER_DRAIN = false;
    bf16_t* S; const float* rstd; float wsc;
    __device__ __forceinline__ void operator()(const acc_t& acc, const Unit& u, int wr, int wc, int fr, int fq) const {
        const int row0 = u.pm * BM + wr * 64 + fr, col0 = u.pn * BM + wc * 32 + 8 * fq;
        float rsv[2][4];
#pragma unroll
        for (int ai = 0; ai < 2; ++ai)
#pragma unroll
            for (int m = 0; m < 4; ++m) rsv[ai][m] = rstd[row0 + ai * HALF + m * 16] * wsc;
#pragma unroll
        for (int ai = 0; ai < 2; ++ai)
#pragma unroll
            for (int m = 0; m < 4; ++m) { const int row = row0 + ai * HALF + m * 16; const float rs = rsv[ai][m]; bf16_t* rowp = S + (size_t)row * D + col0; u32x4 pk = {0u, 0u, 0u, 0u}; (void)rowp; (void)row;
#pragma unroll
                for (int bj = 0; bj < 2; ++bj) { f32x4 o[2];
#pragma unroll
                    for (int n = 0; n < 2; ++n)
#pragma unroll
                        for (int j = 0; j < 4; ++j) o[n][j] = sigmoidf_(acc[ai][bj][m][n][j] * rs);
#if S_U8 == 2
                    u32x2 w8 = {0u, 0u};
#pragma unroll
                    for (int j = 0; j < 4; ++j) { w8.x = __builtin_amdgcn_cvt_pk_u8_f32(o[0][j] * 255.0f, j, w8.x); w8.y = __builtin_amdgcn_cvt_pk_u8_f32(o[1][j] * 255.0f, j, w8.y); }
                    if (bj == 0) { pk.x = w8.x; pk.y = w8.y; } else { pk.z = w8.x; pk.w = w8.y; } }
                *((u32x4*)S + ((size_t)(u.pm * 4 + u.pn) * 8 + ai * 4 + m) * NTHREADS + ((wr * 4 + wc) * 64 + fq * 16 + fr)) = pk; }
#elif S_U8
                    u32x2 w8 = {0u, 0u};
#pragma unroll
                    for (int j = 0; j < 4; ++j) { w8.x = __builtin_amdgcn_cvt_pk_u8_f32(o[0][j] * 255.0f, j, w8.x); w8.y = __builtin_amdgcn_cvt_pk_u8_f32(o[1][j] * 255.0f, j, w8.y); }
                    *(u32x2*)((unsigned char*)S + (size_t)row * D + col0 + bj * HALF) = w8; } }
#else
                    *(u32x4*)(rowp + bj * HALF) = pack8(o[0], o[1]); } }
#endif
    }
};
#if EPI_NT
#define EPI_LD16(p) __builtin_nontemporal_load((const u32x4*)(p))
#else
#define EPI_LD16(p) (*(const u32x4*)(p))
#endif
template <bool FIRST> struct EpiMerge {
    static constexpr bool PERM = true, AFTER_DRAIN = false;
    const bf16_t* S; bf16_t* Mg; float sc;
    __device__ __forceinline__ void operator()(const acc_t& acc, const Unit& u, int wr, int wc, int fr, int fq) const {
        const int row0 = u.pm * BM + wr * 64 + fr, col0 = u.pn * BM + wc * 32 + 8 * fq;
#pragma unroll
        for (int ai = 0; ai < 2; ++ai) {
#if S_U8 == 2
            u32x4 sp[4]; u32x2 sv[4][2]; u32x4 gv[4][2];
#elif S_U8
            u32x2 sv[4][2]; u32x4 gv[4][2];
#else
            u32x4 sv[4][2], gv[4][2];
#endif
#pragma unroll
            for (int m = 0; m < 4; ++m) { const size_t off = (size_t)(row0 + ai * HALF + m * 16) * D + col0;
#if S_U8 == 2
                sp[m] = *((const u32x4*)S + ((size_t)(u.pm * 4 + u.pn) * 8 + ai * 4 + m) * NTHREADS + ((wr * 4 + wc) * 64 + fq * 16 + fr));
#endif
#pragma unroll
                for (int bj = 0; bj < 2; ++bj) {
#if S_U8 == 2
#elif S_U8
                    sv[m][bj] = *(const u32x2*)((const unsigned char*)S + off + bj * HALF);
#else
                    sv[m][bj] = EPI_LD16(S + off + bj * HALF);
#endif
                    if (!FIRST) gv[m][bj] = EPI_LD16(Mg + off + bj * HALF); } }
            asm volatile("" ::: "memory");
#pragma unroll
            for (int m = 0; m < 4; ++m) { const size_t off = (size_t)(row0 + ai * HALF + m * 16) * D + col0;
#pragma unroll
                for (int bj = 0; bj < 2; ++bj) { f32x4 s0, s1, g0, g1;
#if S_U8 == 2
                    sv[m][bj] = bj == 0 ? (u32x2){sp[m].x, sp[m].y} : (u32x2){sp[m].z, sp[m].w};
#endif
#if S_U8
                    { const unsigned wa = sv[m][bj].x, wb = sv[m][bj].y;
                      s0 = (f32x4){(float)((wa >> 0) & 0xffu), (float)((wa >> 8) & 0xffu), (float)((wa >> 16) & 0xffu), (float)((wa >> 24) & 0xffu)};
                      s1 = (f32x4){(float)((wb >> 0) & 0xffu), (float)((wb >> 8) & 0xffu), (float)((wb >> 16) & 0xffu), (float)((wb >> 24) & 0xffu)}; }
#else
                    unpack8(sv[m][bj], s0, s1);
#endif
                    if (FIRST) { g0 = (f32x4){0.f, 0.f, 0.f, 0.f}; g1 = g0; } else unpack8(gv[m][bj], g0, g1);
                    g0 += s0 * acc[ai][bj][m][0] * sc; g1 += s1 * acc[ai][bj][m][1] * sc;
                    *(u32x4*)(Mg + off + bj * HALF) = pack8(g0, g1); } }
            asm volatile("" ::: "memory");
        }
    }
};
#if XB16
struct EpiOut {
    static constexpr bool PERM = true, AFTER_DRAIN = false;
    const bf16_t* xa; bf16_t* xb; float* ss; unsigned char* h8;
    __device__ __forceinline__ void operator()(const acc_t& acc, const Unit& u, int wr, int wc, int fr, int fq) const {
        const int row0 = u.pm * BM + wr * 64 + fr, col0 = u.pn * BM + wc * 32 + 8 * fq;
#pragma unroll
        for (int ai = 0; ai < 2; ++ai) {
            u32x4 xv[4][2];
#pragma unroll
            for (int m = 0; m < 4; ++m) { const size_t off = (size_t)(row0 + ai * HALF + m * 16) * D + col0;
#pragma unroll
                for (int bj = 0; bj < 2; ++bj) xv[m][bj] = EPI_LD16(xa + off + bj * HALF); }
            asm volatile("" ::: "memory");
#pragma unroll
            for (int m = 0; m < 4; ++m) { const int row = row0 + ai * HALF + m * 16; const size_t off = (size_t)row * D + col0; float sq = 0.f;
#pragma unroll
                for (int bj = 0; bj < 2; ++bj) { f32x4 a0, a1; unpack8(xv[m][bj], a0, a1); a0 += acc[ai][bj][m][0]; a1 += acc[ai][bj][m][1];
                    *(u32x4*)(xb + off + bj * HALF) = pack8(a0, a1);
                    sq += ((a0[0] * a0[0] + a0[1] * a0[1]) + (a0[2] * a0[2] + a0[3] * a0[3])) + ((a1[0] * a1[0] + a1[1] * a1[1]) + (a1[2] * a1[2] + a1[3] * a1[3]));
                    if (Q_F8) { u32x2 w8; w8.x = pk4_fp8(a0[0], a0[1], a0[2], a0[3]); w8.y = pk4_fp8(a1[0], a1[1], a1[2], a1[3]); *(u32x2*)(h8 + off + bj * HALF) = w8; } }
                sq += shx<16>(sq); sq += shx<32>(sq);
                if (fq == 0) st_wt(ss + (size_t)row * 16 + u.pn * 4 + wc, sq); }
            asm volatile("" ::: "memory");
        }
    }
};
#else
struct EpiOut {
    static constexpr bool PERM = true, AFTER_DRAIN = false;
    const float* xin; float* xout; bf16_t* xg; const float* g; float* ss; unsigned char* h8;
    __device__ __forceinline__ void operator()(const acc_t& acc, const Unit& u, int wr, int wc, int fr, int fq) const {
        const int row0 = u.pm * BM + wr * 64 + fr, col0 = u.pn * BM + wc * 32 + 8 * fq;
        f32x4 gv[2][2];
#pragma unroll
        for (int bj = 0; bj < 2; ++bj)
#pragma unroll
            for (int n = 0; n < 2; ++n) gv[bj][n] = *(const f32x4*)(g + col0 + bj * HALF + 4 * n);
#pragma unroll
        for (int ai = 0; ai < 2; ++ai)
#pragma unroll
            for (int mh = 0; mh < 2; ++mh) {
                f32x4 xr[2][2][2];
#pragma unroll
                for (int mm = 0; mm < 2; ++mm) { const size_t off = (size_t)(row0 + ai * HALF + (2 * mh + mm) * 16) * D + col0;
#pragma unroll
                    for (int bj = 0; bj < 2; ++bj)
#pragma unroll
                        for (int n = 0; n < 2; ++n) xr[mm][bj][n] = *(const f32x4*)(xin + off + bj * HALF + 4 * n); }
                asm volatile("" ::: "memory");
#pragma unroll
                for (int mm = 0; mm < 2; ++mm) { const int m = 2 * mh + mm; const int row = row0 + ai * HALF + m * 16; const size_t off = (size_t)row * D + col0; float sq = 0.f;
#pragma unroll
                    for (int bj = 0; bj < 2; ++bj) { f32x4 x1[2], xs[2];
#pragma unroll
                        for (int n = 0; n < 2; ++n) { x1[n] = xr[mm][bj][n] + acc[ai][bj][m][n];
                            *(f32x4*)(xout + off + bj * HALF + 4 * n) = x1[n]; sq += (x1[n][0] * x1[n][0] + x1[n][1] * x1[n][1]) + (x1[n][2] * x1[n][2] + x1[n][3] * x1[n][3]); xs[n] = x1[n] * gv[bj][n]; }
                        *(u32x4*)(xg + off + bj * HALF) = pack8(xs[0], xs[1]);
                        if (Q_F8) { u32x2 w8; w8.x = pk4_fp8(xs[0][0], xs[0][1], xs[0][2], xs[0][3]); w8.y = pk4_fp8(xs[1][0], xs[1][1], xs[1][2], xs[1][3]); *(u32x2*)(h8 + off + bj * HALF) = w8; } }
                    sq += shx<16>(sq); sq += shx<32>(sq);
                    if (fq == 0) st_wt(ss + (size_t)row * 16 + u.pn * 4 + wc, sq); }
                asm volatile("" ::: "memory");
            }
    }
};
#endif
template <class Epi, class Sched, bool ALIGN_EPI = false, bool SP2 = false, bool F8 = false>
__device__ __forceinline__ void gemm_phase(PG8_LAS unsigned char* lds, const Gemm g, const Sched& S, const Epi& E, int tid0) {
    int tid_ = tid0; asm volatile("" : "+v"(tid_));
    const int tid = tid_, wid = __builtin_amdgcn_readfirstlane(tid >> 6), lane = tid & 63, wr = wid >> 2, wc = wid & 3, fr = lane & 15, fq = lane >> 4;
    const int K = g.K, nt = K / BK, lda = g.lda, ldb = g.ldb;
    unsigned voffA[2], voffB[2];
#pragma unroll
    for (int i = 0; i < 2; ++i) { int R, C; stage_rc(tid * 16 + i * 8192, R, C); const int Rb = Epi::PERM ? ((R & ~31) + perm32(R & 31)) : R;
        voffA[i] = (unsigned)(R * lda + C) * 2u; voffB[i] = (unsigned)(Rb * ldb + C) * 2u; }
    const size_t kstep = (size_t)(BK * 2);
    const size_t hstepA = (size_t)HALF * lda * 2, hstepB = (size_t)HALF * ldb * 2;
    const size_t tstepA = 2 * hstepA, tstepB = 2 * hstepB;
    const unsigned ldsw = (unsigned)wid * 1024u;
    const int aoff = lds_byte(wr * 64 + fr, fq * 8), boff = lds_byte(wc * 32 + fr, fq * 8);
#define PG8_SA(b, h) (((b) * 2 + (h)) * HTB)
#define PG8_SB(b, h) ((4 + (b) * 2 + (h)) * HTB)
#define PG8_STAGE(bufoff, gbase, voff) do { const char* gb_ = (const char*)(gbase); asm volatile("" : "+s"(gb_));     \
        _Pragma("unroll") for (int _i = 0; _i < 2; ++_i) { unsigned vo_ = (voff)[_i]; asm volatile("" : "+v"(vo_));       \
        __builtin_amdgcn_global_load_lds((const unsigned*)(gb_ + vo_), (PG8_LAS unsigned*)(lds + (bufoff) + ldsw + _i * 8192), 16, 0, 0); } } while (0)
#define PG8_LDA(dst, b, h) do { if constexpr (F8) { _Pragma("unroll") for (int m = 0; m < 4; ++m) { const i32x4_t lo_ = *(const PG8_LAS i32x4_t*)(lds + PG8_SA(b, h) + aoff + m * 2048), hi_ = *(const PG8_LAS i32x4_t*)(lds + PG8_SA(b, h) + aoff + m * 2048 + 1024); \
            dst##8[m] = __builtin_shufflevector(lo_, hi_, 0, 1, 2, 3, 4, 5, 6, 7); } } \
        else { _Pragma("unroll") for (int m = 0; m < 4; ++m) _Pragma("unroll") for (int k = 0; k < 2; ++k) dst[m][k] = *(const PG8_LAS bf16x8*)(lds + PG8_SA(b, h) + aoff + m * 2048 + k * 1024); } } while (0)
#define PG8_LDB(dst, b, h) do { if constexpr (F8) { _Pragma("unroll") for (int n = 0; n < 2; ++n) { const i32x4_t lo_ = *(const PG8_LAS i32x4_t*)(lds + PG8_SB(b, h) + boff + n * 2048), hi_ = *(const PG8_LAS i32x4_t*)(lds + PG8_SB(b, h) + boff + n * 2048 + 1024); \
            dst##8[n] = __builtin_shufflevector(lo_, hi_, 0, 1, 2, 3, 4, 5, 6, 7); } } \
        else { _Pragma("unroll") for (int n = 0; n < 2; ++n) _Pragma("unroll") for (int k = 0; k < 2; ++k) dst[n][k] = *(const PG8_LAS bf16x8*)(lds + PG8_SB(b, h) + boff + n * 2048 + k * 1024); } } while (0)
#define PG8_MMA(ai, bj, At, Bt) do { __builtin_amdgcn_s_setprio(1); _Pragma("unroll") for (int m = 0; m < 4; ++m) _Pragma("unroll") for (int n = 0; n < 2; ++n) { \
        if constexpr (F8) acc[ai][bj][m][n] = __builtin_amdgcn_mfma_scale_f32_16x16x128_f8f6f4(Bt##8[n], At##8[m], acc[ai][bj][m][n], 0, 0, 0, 0, 0, 0); \
        else { _Pragma("unroll") for (int k = 0; k < 2; ++k) acc[ai][bj][m][n] = __builtin_amdgcn_mfma_f32_16x16x32_bf16(Bt[n][k], At[m][k], acc[ai][bj][m][n], 0, 0, 0); } } __builtin_amdgcn_s_setprio(0); } while (0)
#define PG8_WAIT_V(n) asm volatile("s_waitcnt vmcnt(" #n ")" ::: "memory")
#define PG8_WAIT_L(n) asm volatile("s_waitcnt lgkmcnt(" #n ")" ::: "memory")
#define PG8_BAR __builtin_amdgcn_s_barrier()
#define PG8_SCHED __builtin_amdgcn_sched_barrier(0)
    Unit cur, nxt; int ui = 0;
    if (!S.next(0, cur)) return;
    f32x4 acc[2][2][4][2];
#pragma unroll
    for (int a = 0; a < 2; ++a)
#pragma unroll
        for (int b = 0; b < 2; ++b)
#pragma unroll
            for (int m = 0; m < 4; ++m)
#pragma unroll
                for (int n = 0; n < 2; ++n) acc[a][b][m][n] = (f32x4){0.f, 0.f, 0.f, 0.f};
    bf16x8 At[4][2], B0[2][2], B1[2][2];
    i32x8_t At8[4], B08[2], B18[2];
    const char* cA = (const char*)g.A + (size_t)cur.pm * tstepA; const char* cB = (const char*)g.Bt + (size_t)cur.pn * tstepB;
    S.a_ready(cur);
    if constexpr (SP2) {
        PG8_STAGE(PG8_SB(0, 0), cB, voffB); PG8_STAGE(PG8_SB(0, 1), cB + hstepB, voffB); PG8_STAGE(PG8_SA(0, 0), cA, voffA); PG8_STAGE(PG8_SA(0, 1), cA + hstepA, voffA);
        if (wr == 1) PG8_BAR;
        PG8_WAIT_V(2); PG8_BAR;
        PG8_STAGE(PG8_SB(1, 0), cB + kstep, voffB); PG8_STAGE(PG8_SA(1, 0), cA + kstep, voffA); PG8_STAGE(PG8_SB(1, 1), cB + hstepB + kstep, voffB);
        PG8_WAIT_V(6); PG8_BAR;
    } else {
        PG8_STAGE(PG8_SB(0, 0), cB, voffB); PG8_STAGE(PG8_SA(0, 0), cA, voffA); PG8_STAGE(PG8_SB(0, 1), cB + hstepB, voffB); PG8_STAGE(PG8_SA(0, 1), cA + hstepA, voffA);
        if (wr == 1) PG8_BAR;
        PG8_WAIT_V(4); PG8_BAR;
        PG8_STAGE(PG8_SB(1, 0), cB + kstep, voffB); PG8_STAGE(PG8_SA(1, 0), cA + kstep, voffA); PG8_STAGE(PG8_SB(1, 1), cB + hstepB + kstep, voffB);
        PG8_WAIT_V(6); PG8_BAR;
    }
    for (;;) {
        const bool has_next = S.next(ui + 1, nxt);
        const char* nA = has_next ? (const char*)g.A + (size_t)nxt.pm * tstepA : cA; const char* nB = has_next ? (const char*)g.Bt + (size_t)nxt.pn * tstepB : cB;
#pragma nounroll
        for (int t = 0; t < nt; t += 2) {
            const bool last = (t == nt - 2);
            const char* a1 = cA + (size_t)(t + 1) * kstep;
            const char* a2 = last ? nA : cA + (size_t)(t + 2) * kstep; const char* b2 = last ? nB : cB + (size_t)(t + 2) * kstep;
            const char* a3 = a2 + kstep; const char* b3 = b2 + kstep;
            if (last && has_next) S.a_ready(nxt);
            if constexpr (SP2) {
            PG8_LDB(B0, 0, 0); PG8_LDB(B1, 0, 1); PG8_SCHED; PG8_LDA(At, 0, 0); PG8_STAGE(PG8_SA(1, 1), a1 + hstepA, voffA);
            PG8_WAIT_V(8); PG8_WAIT_L(0); PG8_BAR; PG8_MMA(0, 0, At, B0); PG8_MMA(0, 1, At, B1); PG8_BAR; PG8_SCHED;
            PG8_LDA(At, 0, 1); PG8_STAGE(PG8_SB(0, 0), b2, voffB); PG8_STAGE(PG8_SB(0, 1), b2 + hstepB, voffB); PG8_STAGE(PG8_SA(0, 0), a2, voffA);
            PG8_WAIT_V(8); PG8_WAIT_L(0); PG8_BAR; PG8_MMA(1, 0, At, B0); PG8_MMA(1, 1, At, B1); PG8_BAR; PG8_SCHED;
            PG8_LDB(B0, 1, 0); PG8_LDB(B1, 1, 1); PG8_SCHED; PG8_LDA(At, 1, 0); PG8_STAGE(PG8_SA(0, 1), a2 + hstepA, voffA);
            PG8_WAIT_V(8); PG8_WAIT_L(0); PG8_BAR; PG8_MMA(0, 0, At, B0); PG8_MMA(0, 1, At, B1); PG8_BAR; PG8_SCHED;
            PG8_LDA(At, 1, 1); PG8_STAGE(PG8_SB(1, 0), b3, voffB); PG8_STAGE(PG8_SB(1, 1), b3 + hstepB, voffB); PG8_STAGE(PG8_SA(1, 0), a3, voffA);
            PG8_WAIT_V(8); PG8_WAIT_L(0); PG8_BAR; PG8_MMA(1, 0, At, B0); PG8_MMA(1, 1, At, B1); PG8_BAR; PG8_SCHED;
            } else {
            PG8_LDB(B0, 0, 0); PG8_SCHED; PG8_LDA(At, 0, 0); PG8_STAGE(PG8_SA(1, 1), a1 + hstepA, voffA);
            PG8_WAIT_L(8); PG8_BAR; PG8_WAIT_L(0); PG8_MMA(0, 0, At, B0); PG8_BAR; PG8_SCHED;
            PG8_LDB(B1, 0, 1); PG8_STAGE(PG8_SB(0, 0), b2, voffB);
            PG8_BAR; PG8_WAIT_L(0); PG8_MMA(0, 1, At, B1); PG8_BAR;
            PG8_LDA(At, 0, 1); PG8_STAGE(PG8_SA(0, 0), a2, voffA);
            PG8_BAR; PG8_WAIT_L(0); PG8_MMA(1, 0, At, B0); PG8_BAR; PG8_SCHED;
            PG8_STAGE(PG8_SB(0, 1), b2 + hstepB, voffB);
            PG8_WAIT_V(6); PG8_BAR; PG8_MMA(1, 1, At, B1); PG8_BAR;
            PG8_LDB(B0, 1, 0); PG8_SCHED; PG8_LDA(At, 1, 0); PG8_STAGE(PG8_SA(0, 1), a2 + hstepA, voffA);
            PG8_WAIT_L(8); PG8_BAR; PG8_WAIT_L(0); PG8_MMA(0, 0, At, B0); PG8_BAR; PG8_SCHED;
            PG8_LDB(B1, 1, 1); PG8_STAGE(PG8_SB(1, 0), b3, voffB);
            PG8_BAR; PG8_WAIT_L(0); PG8_MMA(0, 1, At, B1); PG8_BAR;
            PG8_LDA(At, 1, 1); PG8_STAGE(PG8_SA(1, 0), a3, voffA);
            PG8_BAR; PG8_WAIT_L(0); PG8_MMA(1, 0, At, B0); PG8_BAR; PG8_SCHED;
            PG8_STAGE(PG8_SB(1, 1), b3 + hstepB, voffB);
            PG8_WAIT_V(6); PG8_BAR; PG8_MMA(1, 1, At, B1); PG8_BAR;
            }
        }
        if constexpr (ALIGN_EPI) { if (wr == 0) PG8_BAR; }
        if constexpr (!Epi::AFTER_DRAIN) { int te = tid; if constexpr (F8) asm volatile("" : "+v"(te));
            E(acc, cur, wr, wc, te & 15, (te & 63) >> 4); S.done(cur); }
        if (!has_next) break;
#pragma unroll
        for (int a = 0; a < 2; ++a)
#pragma unroll
            for (int b = 0; b < 2; ++b)
#pragma unroll
                for (int m = 0; m < 4; ++m)
#pragma unroll
                    for (int n = 0; n < 2; ++n) acc[a][b][m][n] = (f32x4){0.f, 0.f, 0.f, 0.f};
        cur = nxt; cA = nA; cB = nB; ++ui;
        if constexpr (ALIGN_EPI) { if (wr == 1) PG8_BAR; }
    }
    PG8_WAIT_V(0);
    if constexpr (!ALIGN_EPI) { if (wr == 0) PG8_BAR; }
    PG8_BAR;
    if constexpr (Epi::AFTER_DRAIN) { E.fused(acc, cur, wr, wc, fr, fq, lds, wid, lane); S.done(cur); }
#undef PG8_SA
#undef PG8_SB
#undef PG8_STAGE
#undef PG8_LDA
#undef PG8_LDB
#undef PG8_MMA
#undef PG8_WAIT_V
#undef PG8_WAIT_L
#undef PG8_BAR
#undef PG8_SCHED
}
}
struct Args { const void* in[26]; float* out; unsigned char* ws; };
enum { I_X = 0, I_POS, I_N1G, I_WIN, I_POOLW, I_POOLS, I_PPROJ, I_ARE, I_AIM, I_LDT, I_BRE, I_BIM, I_CRE, I_CIM, I_SD, I_GLU, I_SPROJ, I_APROJ, I_WOUT, I_N2G, I_WQ, I_K1, I_K2, I_PU, I_PV, I_FG };

struct Ctx {
    int tid, lane, wave, G, bid;
    int gw, ngw;
    int gt, ngt;
    LAS unsigned char* lds;
};

__device__ __forceinline__ void cis_f(float ang, float& c, float& s) {
    const double r = (double)ang * 0.15915494309189535;
    const double fr = r - __builtin_rint(r);
    const float f = (float)fr;
    c = __builtin_amdgcn_cosf(f); s = __builtin_amdgcn_sinf(f);
}

template <class RowMap>
__device__ __forceinline__ void p0_transpose_item(const float* W, int K, int N, bf16_t* WT, RowMap rm, LAS float* scr, int item, int lane, const float* gk = nullptr) {
    const int nblk = N / 32, kb = item / nblk, nb = item % nblk, k0 = 64 * kb, n0 = 32 * nb;
#pragma unroll 8
    for (int i = 0; i < 32; ++i) { const int kk = 2 * i + (lane >> 5); scr[kk * 33 + (lane & 31)] = W[(size_t)(k0 + kk) * N + n0 + (lane & 31)] * (gk ? gk[k0 + kk] : 1.0f); }
    LDS_WAIT(); asm volatile("" ::: "memory");
    const int c = lane & 7;
#pragma unroll
    for (int j = 0; j < 4; ++j) { const int n = (lane >> 3) + 8 * j; const LAS float* s = scr + (8 * c) * 33 + n;
        u32x4 o; o.x = pk2(s[0 * 33], s[1 * 33]); o.y = pk2(s[2 * 33], s[3 * 33]); o.z = pk2(s[4 * 33], s[5 * 33]); o.w = pk2(s[6 * 33], s[7 * 33]);
        *(u32x4*)(WT + (size_t)rm(n0 + n) * K + k0 + 8 * c) = o; }
    LDS_WAIT(); asm volatile("" ::: "memory");
}
__device__ __forceinline__ void p0_transpose_item_f8(const float* W, int K, int N, unsigned char* WT8, int nbase, float sc, LAS float* scr, int item, int lane, const float* gk = nullptr) {
    const int nblk = N / 32, kb = item / nblk, nb = item % nblk, k0 = 64 * kb, n0 = 32 * nb;
#pragma unroll 8
    for (int i = 0; i < 32; ++i) { const int kk = 2 * i + (lane >> 5); scr[kk * 33 + (lane & 31)] = W[(size_t)(k0 + kk) * N + n0 + (lane & 31)] * (gk ? gk[k0 + kk] : 1.0f); }
    LDS_WAIT(); asm volatile("" ::: "memory");
    const int c = lane & 7;
#pragma unroll
    for (int j = 0; j < 4; ++j) { const int n = (lane >> 3) + 8 * j; const LAS float* s = scr + (8 * c) * 33 + n;
        u32x2 o; o.x = pk4_fp8(s[0 * 33] * sc, s[1 * 33] * sc, s[2 * 33] * sc, s[3 * 33] * sc); o.y = pk4_fp8(s[4 * 33] * sc, s[5 * 33] * sc, s[6 * 33] * sc, s[7 * 33] * sc);
        *(u32x2*)(WT8 + (size_t)(n0 + n - nbase) * K + k0 + 8 * c) = o; }
    LDS_WAIT(); asm volatile("" ::: "memory");
}
struct RmId { __device__ __forceinline__ int operator()(int n) const { return n; } };
struct RmGlu { __device__ __forceinline__ int operator()(int n) const { return 256 * ((n & 511) >> 7) + 128 * (n >> 9) + (n & 127); } };

__device__ __forceinline__ void convert_f16(const Ctx& C, const float* src, unsigned short* dst, size_t n8) {
    for (size_t i = C.gt; i < n8; i += C.ngt) { const f32x4 a = *(const f32x4*)(src + i * 8), b = *(const f32x4*)(src + i * 8 + 4);
        u32x4 o; o.x = pkh2(a[0], a[1]); o.y = pkh2(a[2], a[3]); o.z = pkh2(b[0], b[1]); o.w = pkh2(b[2], b[3]); *(u32x4*)(dst + i * 8) = o; }
}
__device__ __forceinline__ void norm_row(const float* xrow, const float* g, bf16_t* orow, unsigned char* h8row, float* rstd_out, int lane, float* frow = nullptr) {
    f32x4 v[4]; float s = 0.f;
#pragma unroll
    for (int j = 0; j < 4; ++j) { v[j] = *((const f32x4*)xrow + lane + 64 * j); s += (v[j][0] * v[j][0] + v[j][1] * v[j][1]) + (v[j][2] * v[j][2] + v[j][3] * v[j][3]); }
    s = wave_sum(s);
#pragma unroll
    for (int j = 0; j < 4; ++j) { const f32x4 gg = *((const f32x4*)g + lane + 64 * j); const f32x4 o = XB16 ? v[j] : v[j] * gg; u32x2 w; w.x = pk2(o[0], o[1]); w.y = pk2(o[2], o[3]); *((u32x2*)orow + lane + 64 * j) = w;
        if (GATE_F8) *((unsigned*)h8row + lane + 64 * j) = pk4_fp8(o[0], o[1], o[2], o[3]);
 }
    if (lane == 0) st_wt(rstd_out, __builtin_amdgcn_rsqf(s * (1.0f / D) + EPS));
}

__device__ __forceinline__ void quant_load(const float* usrc, const float* vsrc, int lane, f32x4 (&u)[4], f32x4 (&v)[4]) {
#pragma unroll
    for (int j = 0; j < 4; ++j) { u[j] = *((const f32x4*)usrc + 4 * lane + j); v[j] = *((const f32x4*)vsrc + 4 * lane + j); }
}
__device__ __forceinline__ void quant_finish(const f32x4 (&u)[4], const f32x4 (&v)[4], unsigned char* dst, int e, float* su_out, float* sv_out, int lane) {
    float mu = 0.f, mv = 0.f;
#pragma unroll
    for (int j = 0; j < 4; ++j) {
        mu = fmaxf(mu, fmaxf(fmaxf(fabsf(u[j][0]), fabsf(u[j][1])), fmaxf(fabsf(u[j][2]), fabsf(u[j][3])))); mv = fmaxf(mv, fmaxf(fmaxf(fabsf(v[j][0]), fabsf(v[j][1])), fmaxf(fabsf(v[j][2]), fabsf(v[j][3])))); }
    mu = wave_max(mu); mv = wave_max(mv);
    const float su = fmaxf(mu, 1e-30f) * (PEER_MFMA ? (1.0f / 6.0f) : (1.0f / 7.0f)), iu = 1.0f / su, sv = fmaxf(mv, 1e-30f) * (1.0f / 6.0f), iv = 1.0f / sv;
    unsigned w[4];
#if PEER_MFMA
#pragma unroll
    for (int dd = 0; dd < 2; ++dd) { unsigned t = 0u;
#pragma unroll
        for (int j = 0; j < 8; ++j) { const float x = u[2 * dd + (j >> 2)][j & 3] * iu, ax = fabsf(x);
            const unsigned c = (unsigned)(ax > 0.25f) + (unsigned)(ax > 0.75f) + (unsigned)(ax > 1.25f) + (unsigned)(ax > 1.75f) + (unsigned)(ax > 2.5f) + (unsigned)(ax > 3.5f) + (unsigned)(ax > 5.0f);
            t |= (c | (x < 0.f ? 8u : 0u)) << (4 * j); }
        w[dd] = t; }
#else
#pragma unroll
    for (int dd = 0; dd < 2; ++dd) { unsigned t = 0u;
#pragma unroll
        for (int j = 0; j < 8; ++j) { const float x = u[2 * dd + (j >> 2)][j & 3] * iu; int q = (int)rintf(x); q = q > 7 ? 7 : (q < -7 ? -7 : q); t |= ((unsigned)q & 15u) << (4 * j); }
        w[dd] = t; }
#endif
#pragma unroll
    for (int dd = 0; dd < 2; ++dd) { unsigned t = 0u;
        t = __builtin_amdgcn_cvt_scalef32_pk_fp4_f32(t, v[2 * dd][0] * iv, v[2 * dd][1] * iv, 1.0f, 0); t = __builtin_amdgcn_cvt_scalef32_pk_fp4_f32(t, v[2 * dd][2] * iv, v[2 * dd][3] * iv, 1.0f, 1);
        t = __builtin_amdgcn_cvt_scalef32_pk_fp4_f32(t, v[2 * dd + 1][0] * iv, v[2 * dd + 1][1] * iv, 1.0f, 2); t = __builtin_amdgcn_cvt_scalef32_pk_fp4_f32(t, v[2 * dd + 1][2] * iv, v[2 * dd + 1][3] * iv, 1.0f, 3); w[2 + dd] = t; }
#if PEER_SLICED
    *(u32x2*)(dst + (size_t)(lane >> 3) * MiB + (size_t)e * 64 + (lane & 7) * 8) = (u32x2){w[0], w[1]};
    *((u32x2*)(dst + 16 * MiB + (size_t)e * 512) + lane) = (u32x2){w[2], w[3]};
#elif PEER_MFMA
    *((u32x2*)(dst + (size_t)e * 1024) + lane) = (u32x2){w[0], w[1]};
    *((u32x2*)(dst + (size_t)e * 1024 + 512) + lane) = (u32x2){w[2], w[3]};
#else
    *((u32x4*)(dst + (size_t)e * 1024) + lane) = (u32x4){w[0], w[1], w[2], w[3]};
#endif
    if (lane == 0) { st_wt(su_out, su); st_wt(sv_out, sv); }
}
__device__ __forceinline__ void quant_expert(const float* usrc, const float* vsrc, unsigned char* dst, int e, float* su_out, float* sv_out, int lane) {
    f32x4 u[4], v[4]; quant_load(usrc, vsrc, lane, u, v); quant_finish(u, v, dst, e, su_out, sv_out, lane);
}
__device__ __forceinline__ void quant_rows(const float* pu, const float* pv, unsigned char* dst, float* su, float* sv, int e0, int eend, int estep, int lane) {
    if (e0 >= eend) return;
    f32x4 u[4], v[4]; quant_load(pu + (size_t)e0 * D, pv + (size_t)e0 * D, lane, u, v);
    for (int e = e0;;) {
        const int en = e + estep; f32x4 un[4], vn[4];
        if (en < eend) quant_load(pu + (size_t)en * D, pv + (size_t)en * D, lane, un, vn);
        quant_finish(u, v, dst, e, su + e, sv + e, lane);
        if (en >= eend) break;
#pragma unroll
        for (int j = 0; j < 4; ++j) { u[j] = un[j]; v[j] = vn[j]; }
        e = en;
    }
}

__device__ __forceinline__ void phase_prologue(const Ctx& C, const Args& a) {
    unsigned char* ws = a.ws;
    LAS float* scr = (LAS float*)(C.lds) + C.wave * (64 * 33);
    constexpr int I_WINI = 16 * 200, I_PP = 8 * 32, I_GL = 8 * 32, I_SP = 8 * 32, I_AP = 4 * 32, I_WO = 16 * 32, I_WQI = 16 * 64, I_LAYER = I_WINI + I_PP + I_GL + I_SP + I_AP + I_WO + I_WQI;
    for (int it = C.gw; it < DEPTH * I_LAYER; it += C.ngw) {
        const int l = it / I_LAYER; int r = it % I_LAYER; unsigned char* wl = ws + WS_W + (size_t)l * W_LAYER;
        if (GATE_F8 && r < I_WINI && (r % 200) >= NZ / 32) { p0_transpose_item_f8((const float*)a.in[I_WIN] + (size_t)l * D * IN_COLS, D, IN_COLS, wl + WO_WIN + (size_t)NZ * D * 2, NZ, GATE_WSC, scr, r, C.lane, XB16 ? (const float*)a.in[I_N1G] + (size_t)l * D : nullptr); continue; }
        if (r < I_WINI) { p0_transpose_item((const float*)a.in[I_WIN] + (size_t)l * D * IN_COLS, D, IN_COLS, (bf16_t*)(wl + WO_WIN), RmId(), scr, r, C.lane, XB16 ? (const float*)a.in[I_N1G] + (size_t)l * D : nullptr); continue; } r -= I_WINI;
        if (r < I_PP) { p0_transpose_item((const float*)a.in[I_PPROJ] + (size_t)l * POOLW * D, POOLW, D, (bf16_t*)(wl + WO_PPROJ), RmId(), scr, r, C.lane); continue; } r -= I_PP;
        if (r < I_GL) { p0_transpose_item((const float*)a.in[I_GLU] + (size_t)l * SSMW * 2 * SSMW, SSMW, 2 * SSMW, (bf16_t*)(wl + WO_GLU), RmGlu(), scr, r, C.lane); continue; } r -= I_GL;
        if (r < I_SP) { p0_transpose_item((const float*)a.in[I_SPROJ] + (size_t)l * SSMW * D, SSMW, D, (bf16_t*)(wl + WO_SPROJ), RmId(), scr, r, C.lane); continue; } r -= I_SP;
        if (r < I_AP) { p0_transpose_item((const float*)a.in[I_APROJ] + (size_t)l * AOUT * D, AOUT, D, (bf16_t*)(wl + WO_APROJ), RmId(), scr, r, C.lane); continue; } r -= I_AP;
        if (r < I_WO) { p0_transpose_item((const float*)a.in[I_WOUT] + (size_t)l * D * D, D, D, (bf16_t*)(wl + WO_WOUT), RmId(), scr, r, C.lane); continue; } r -= I_WO;
        if (Q_F8) p0_transpose_item_f8((const float*)a.in[I_WQ] + (size_t)l * D * PQ, D, PQ, wl + WO_WQ, 0, GATE_WSC, scr, r, C.lane, XB16 ? (const float*)a.in[I_N2G] + (size_t)l * D : nullptr);
        else p0_transpose_item((const float*)a.in[I_WQ] + (size_t)l * D * PQ, D, PQ, (bf16_t*)(wl + WO_WQ), RmId(), scr, r, C.lane, XB16 ? (const float*)a.in[I_N2G] + (size_t)l * D : nullptr);
    }
    for (int i = C.gt; i < DEPTH * 512 * 512; i += C.ngt) {
        const int l = i / (512 * 512), r = i % (512 * 512), n = r / 512, k = r % 512, gn = n >> 7, gk = k >> 7;
        float v = 0.f;
        if (gn == gk) v = ((const float*)a.in[I_POOLW])[((size_t)(l * 4 + gn) * 128 + (k & 127)) * 128 + (n & 127)] * ((const float*)a.in[I_POOLS])[l * POOLW + n];
        ((bf16_t*)(ws + WS_W + (size_t)l * W_LAYER + WO_POOL))[r] = (bf16_t)f2bf(v);
    }
    for (int i = C.gt; i < DEPTH * 2 * 128 * 128; i += C.ngt) {
        const int l = i / (2 * 16384), r = i % (2 * 16384), t = r / 16384, e = r % 16384;
        const float v = ((const float*)a.in[t ? I_K2 : I_K1])[(size_t)l * 16384 + e];
        ((bf16_t*)(ws + WS_W + (size_t)l * W_LAYER + (t ? WO_K2 : WO_K1)))[e] = (bf16_t)f2bf(v);
    }
    {
        const bool defer = TABQ_DEFER && C.G == 256;
        for (int l = 0; l < (defer ? 1 : DEPTH); ++l)
            quant_rows((const float*)a.in[I_PU] + (size_t)l * NEXP * D, (const float*)a.in[I_PV] + (size_t)l * NEXP * D, ws + WS_TAB + (size_t)l * TAB_LAYER,
                       (float*)(ws + WS_TSC + (size_t)l * 131072), (float*)(ws + WS_TSC + (size_t)l * 131072 + 65536), C.gw, NEXP, C.ngw, C.lane);
    }
    if (!ROPE_FLY)
    for (int i = C.gt; i < M * 32; i += C.ngt) {
        const int m = i >> 5, f = i & 31;
        const float invf = exp2f(-(float)f * (13.287712379549449f / 32.0f));
        const float ang = (float)((const int*)a.in[I_POS])[m] * invf;
        float c, s; cis_f(ang, c, s);
        ((f32x2*)(ws + WS_ROPE))[i] = (f32x2){c, s};
    }
    for (int i = C.gt; i < DEPTH * SSM_G * SSM_N; i += C.ngt) {
        const int l = i / (SSM_G * SSM_N), gn = i % (SSM_G * SSM_N), g = gn / SSM_N;
        unsigned char* sc = ws + WS_SSMC + (size_t)l * SSMC_LAYER;
        const float dt = expf(((const float*)a.in[I_LDT])[l * SSM_G + g]);
        const float ar = ((const float*)a.in[I_ARE])[i], ai = ((const float*)a.in[I_AIM])[i];
        const float decay = expf(ar * dt); float cc, ss; cis_f(ai * dt, cc, ss);
        const float abr = decay * cc, abi = decay * ss;
        const float den = ar * ar + ai * ai, nr = abr - 1.0f;
        const float kr = (nr * ar + abi * ai) / den, ki = (abi * ar - nr * ai) / den;
        ((f32x2*)sc)[gn] = (f32x2){abr, abi};
        double pr = (double)abr, pi = (double)abi;
#pragma unroll
        for (int q = 0; q < 8; ++q) { const double nr2 = pr * pr - pi * pi, ni2 = 2.0 * pr * pi; pr = nr2; pi = ni2; }
        ((f32x2*)(sc + 16384))[gn] = (f32x2){(float)pr, (float)pi};
        const float* br = (const float*)a.in[I_BRE] + (size_t)i * SSM_P; const float* bi = (const float*)a.in[I_BIM] + (size_t)i * SSM_P;
        f32x2* bb = (f32x2*)(sc + 32768) + (size_t)gn * SSM_P;
#pragma unroll
        for (int q = 0; q < SSM_P; ++q) bb[q] = (f32x2){kr * br[q] - ki * bi[q], kr * bi[q] + ki * br[q]};
    }
    for (int m = C.gw; m < M; m += C.ngw) norm_row((const float*)a.in[I_X] + (size_t)m * D, (const float*)a.in[I_N1G], (bf16_t*)(ws + WS_E) + (size_t)m * D, ws + WS_H8 + (size_t)m * D, (float*)(ws + WS_RSTD1) + m, C.lane);
}
constexpr int AT_K_OFF = 0, AT_V_OFF = 49152, AT_VROW = 160, AT_LDS = AT_V_OFF + 384 * AT_VROW;
constexpr float AT_QSCALE = 0.125f * 1.4426950408889634f;

#if ROPE_FLY
struct AttnRegs { u32x4 kx[2][2]; int kpos[2]; u32x4 vv[4]; u32x4 qx[2]; int qpos; };
__device__ __forceinline__ void rope8(int pos, int f0, f32x2 (&cs)[8]) {
#pragma unroll
    for (int q = 0; q < 8; ++q) { const float invf = fast_exp2(-(float)(f0 + q) * (13.287712379549449f / 32.0f)); const float rev = __builtin_amdgcn_fractf(((float)pos * invf) * 0.15915494309189535f);
        cs[q] = (f32x2){__builtin_amdgcn_cosf(rev), __builtin_amdgcn_sinf(rev)}; }
}
#else
struct AttnRegs { u32x4 kx[2][2]; f32x2 kr[2][8]; u32x4 vv[4]; u32x4 qx[2]; f32x2 qr[8]; };
#endif
struct AttnIdx { int b, head, grp, hs, dil, cls, nb, slot0; size_t rowb; };
__device__ __forceinline__ AttnIdx attn_idx(int it) {
    AttnIdx I; I.b = it / 768; const int rem = it % 768; I.head = rem >> 6; const int blk = rem & 63;
    I.grp = I.head >> 2; I.hs = I.head & 3; const int dsh = 2 * I.grp; I.dil = 1 << dsh; const int nbpc = 64 >> dsh; I.cls = blk / nbpc; I.nb = blk % nbpc;
    I.rowb = (size_t)I.b * SEQ; I.slot0 = 128 * (I.nb - 1); return I;
}
#if !ROPE_FLY
#error "the block-reuse attention path is written for ROPE_FLY"
#endif
__device__ __forceinline__ void attn_load_blk(const Ctx& C, const AttnIdx& I, int kb  , int s  , const bf16_t* zqkv, const int* pos, AttnRegs& R) {
    { const int e = C.tid, j = e >> 2, c = e & 3; const size_t m = I.rowb + (size_t)(128 * kb + j) * I.dil + I.cls;
      const bf16_t* kp = zqkv + m * QKVW + AW + I.head * 64 + 8 * c;
      R.kx[s][0] = *(const u32x4*)kp; R.kx[s][1] = *(const u32x4*)(kp + 32); R.kpos[s] = pos[m]; }
#pragma unroll
    for (int p = 0; p < 2; ++p) { const int e = C.tid + p * NTHREADS, j = e >> 3, c = e & 7;
        R.vv[2 * s + p] = *(const u32x4*)(zqkv + (I.rowb + (size_t)(128 * kb + j) * I.dil + I.cls) * QKVW + 2 * AW + I.head * 64 + 8 * c); }
}
__device__ __forceinline__ void attn_load(const Ctx& C, int it, bool both, const bf16_t* zqkv, const f32x2* rope, AttnRegs& R) {
    const AttnIdx I = attn_idx(it); const int* pos = (const int*)rope;
    attn_load_blk(C, I, I.nb, 1, zqkv, pos, R);
    if (both && I.nb > 0) attn_load_blk(C, I, I.nb - 1, 0, zqkv, pos, R);
    const int w = C.wave, ql = C.lane & 15, quad = C.lane >> 4;
    const size_t mq = I.rowb + (size_t)(128 * I.nb + 16 * w + ql) * I.dil + I.cls;
    const bf16_t* qp = zqkv + mq * QKVW + I.head * 64 + 8 * quad;
    R.qx[0] = *(const u32x4*)qp; R.qx[1] = *(const u32x4*)(qp + 32); R.qpos = pos[mq];
}
__device__ __forceinline__ void attn_store_blk(const Ctx& C, int hf  , int s, bool zero, const AttnRegs& R) {
    LAS unsigned char* Ks = C.lds + AT_K_OFF; LAS unsigned char* Vs = C.lds + AT_V_OFF;
    { const int e = C.tid, j = 128 * hf + (e >> 2), c = e & 3;
      u32x4 o1 = {0u, 0u, 0u, 0u}, o2 = o1;
      if (!zero) {
          const u32x4 x1 = R.kx[s][0], x2 = R.kx[s][1];
          unsigned w1[4] = {x1.x, x1.y, x1.z, x1.w}, w2[4] = {x2.x, x2.y, x2.z, x2.w}, r1[4], r2[4];
          f32x2 kcs[8]; rope8(R.kpos[s], 8 * c, kcs);
#pragma unroll
          for (int q = 0; q < 4; ++q) {
              const f32x2 cs0 = kcs[2 * q], cs1 = kcs[2 * q + 1];
              const float a0 = bflo(w1[q]), a1 = bfhi(w1[q]), b0 = bflo(w2[q]), b1 = bfhi(w2[q]);
              r1[q] = pk2(a0 * cs0[0] - b0 * cs0[1], a1 * cs1[0] - b1 * cs1[1]);
              r2[q] = pk2(b0 * cs0[0] + a0 * cs0[1], b1 * cs1[0] + a1 * cs1[1]);
          }
          o1 = (u32x4){r1[0], r1[1], r1[2], r1[3]}; o2 = (u32x4){r2[0], r2[1], r2[2], r2[3]};
      }
      *(LAS u32x4*)(Ks + j * 128 + ((c ^ (j & 7)) << 4)) = o1;
      *(LAS u32x4*)(Ks + j * 128 + (((c + 4) ^ (j & 7)) << 4)) = o2; }
#pragma unroll
    for (int p = 0; p < 2; ++p) { const int e = C.tid + p * NTHREADS, j = 128 * hf + (e >> 3), c = e & 7;
        u32x4 v = {0u, 0u, 0u, 0u};
        if (!zero) v = R.vv[2 * s + p];
        *(LAS u32x4*)(Vs + j * AT_VROW + c * 16) = v; }
}
__device__ __forceinline__ void attn_store(const Ctx& C, int it, bool both, const AttnRegs& R, bf16x8 (&qf)[2]) {
    const AttnIdx I = attn_idx(it);
    attn_store_blk(C, I.nb % 3, 1, false, R);
    if (both) attn_store_blk(C, (I.nb + 2) % 3, 0, I.nb == 0, R);
    {
        const u32x4 x1 = R.qx[0], x2 = R.qx[1];
        unsigned w1[4] = {x1.x, x1.y, x1.z, x1.w}, w2[4] = {x2.x, x2.y, x2.z, x2.w}, r1[4], r2[4];
        f32x2 qcs[8]; rope8(R.qpos, 8 * (C.lane >> 4), qcs);
#pragma unroll
        for (int q = 0; q < 4; ++q) {
            const f32x2 cs0 = qcs[2 * q] * AT_QSCALE, cs1 = qcs[2 * q + 1] * AT_QSCALE;
            const float a0 = bflo(w1[q]), a1 = bfhi(w1[q]), b0 = bflo(w2[q]), b1 = bfhi(w2[q]);
            r1[q] = pk2(a0 * cs0[0] - b0 * cs0[1], a1 * cs1[0] - b1 * cs1[1]);
            r2[q] = pk2(b0 * cs0[0] + a0 * cs0[1], b1 * cs1[0] + a1 * cs1[1]);
        }
        qf[0] = __builtin_bit_cast(bf16x8, (u32x4){r1[0], r1[1], r1[2], r1[3]}); qf[1] = __builtin_bit_cast(bf16x8, (u32x4){r2[0], r2[1], r2[2], r2[3]});
    }
}
__device__ __forceinline__ void attn_compute(const Ctx& C, int it, const bf16x8 (&qf)[2], bf16_t* og, float* lse_out) {
    const AttnIdx I = attn_idx(it);
    const int grp = I.grp, hs = I.hs, nb = I.nb;
    LAS unsigned char* Ks = C.lds + AT_K_OFF; LAS unsigned char* Vs = C.lds + AT_V_OFF;
    const int w = C.wave, ql = C.lane & 15, quad = C.lane >> 4;
    const size_t mq = I.rowb + (size_t)(128 * nb + 16 * w + ql) * I.dil + I.cls;
    const int slo = 128 * ((nb + 2) % 3), sup = 128 * (nb % 3);
    f32x4 st[9];
#pragma unroll
    for (int r = 0; r < 9; ++r) {
        const int lrow = 16 * (w + r) + ql, row = ((lrow & 128) ? sup : slo) + (lrow & 127);
        f32x4 acc = {0.f, 0.f, 0.f, 0.f};
#pragma unroll
        for (int kk = 0; kk < 2; ++kk) {
            const bf16x8 kf = *(const LAS bf16x8*)(Ks + row * 128 + (((4 * kk + quad) ^ (row & 7)) << 4));
            acc = __builtin_amdgcn_mfma_f32_16x16x32_bf16(kf, qf[kk], acc, 0, 0, 0);
        }
        st[r] = acc;
    }
    const float NEG = -INFINITY;
    float mx = NEG;
#pragma unroll
    for (int r = 0; r < 9; ++r)
#pragma unroll
        for (int i = 0; i < 4; ++i) {
            bool ok = true;
            if (r == 0) ok = (4 * quad + i >= ql);
            if (r == 8) ok = (4 * quad + i <= ql);
            if (nb == 0 && (w + r) < 8) ok = false;
            st[r][i] = ok ? st[r][i] : NEG;
            mx = fmaxf(mx, st[r][i]);
        }
    mx = fmaxf(mx, shx<16>(mx)); mx = fmaxf(mx, shx<32>(mx));
    float den = 0.f;
#pragma unroll
    for (int r = 0; r < 9; ++r)
#pragma unroll
        for (int i = 0; i < 4; ++i) { const float p = fast_exp2(st[r][i] - mx); st[r][i] = p; den += p; }
    den += shx<16>(den); den += shx<32>(den);
    f32x4 o[4];
#pragma unroll
    for (int mb = 0; mb < 4; ++mb) o[mb] = (f32x4){0.f, 0.f, 0.f, 0.f};
    const int li = C.lane & 15, trr = li >> 2, trc = li & 3;
#pragma unroll
    for (int jj = 0; jj < 5; ++jj) {
        u32x4 pw; pw.x = pk2(st[2 * jj][0], st[2 * jj][1]); pw.y = pk2(st[2 * jj][2], st[2 * jj][3]);
        if (jj < 4) { pw.z = pk2(st[2 * jj + 1][0], st[2 * jj + 1][1]); pw.w = pk2(st[2 * jj + 1][2], st[2 * jj + 1][3]); } else { pw.z = 0u; pw.w = 0u; }
        const bf16x8 pf = __builtin_bit_cast(bf16x8, pw);
        const int jb1 = w + 2 * jj; int jb2 = jb1 + 1; jb2 = jb2 > 15 ? 15 : jb2;
        const int l1 = 16 * jb1 + 4 * quad + trr, l2 = 16 * jb2 + 4 * quad + trr, row1 = ((l1 & 128) ? sup : slo) + (l1 & 127), row2 = ((l2 & 128) ? sup : slo) + (l2 & 127);
#pragma unroll
        for (int mb = 0; mb < 4; ++mb) {
            const v4i16_t lo = __builtin_amdgcn_ds_read_tr16_b64_v4i16((LAS v4i16_t*)(Vs + row1 * AT_VROW + (16 * mb + 4 * trc) * 2));
            const v4i16_t hi = __builtin_amdgcn_ds_read_tr16_b64_v4i16((LAS v4i16_t*)(Vs + row2 * AT_VROW + (16 * mb + 4 * trc) * 2));
            const bf16x8 vf = {lo[0], lo[1], lo[2], lo[3], hi[0], hi[1], hi[2], hi[3]};
            o[mb] = __builtin_amdgcn_mfma_f32_16x16x32_bf16(vf, pf, o[mb], 0, 0, 0);
        }
    }
    const float rden = 1.0f / den;
    bf16_t* op = og + ((size_t)grp * M + mq) * AOUT + hs * 64 + 4 * quad;
#pragma unroll
    for (int mb = 0; mb < 4; ++mb) { u32x2 wv; wv.x = pk2(o[mb][0] * rden, o[mb][1] * rden); wv.y = pk2(o[mb][2] * rden, o[mb][3] * rden); *(u32x2*)(op + 16 * mb) = wv; }
    if (quad == 0) st_wt(lse_out + ((size_t)grp * M + mq) * 4 + hs, (mx + __builtin_amdgcn_logf(den)) * 0.6931471805599453f);
}

__device__ __forceinline__ void attn_items(const Ctx& C, const bf16_t* zqkv, const f32x2* rope, bf16_t* og, float* lse_out) {
    constexpr int NI = BATCH * 768; const int per = (NI + C.G - 1) / C.G, lo = C.bid * per, hi = (lo + per) < NI ? (lo + per) : NI;
    int it = lo; if (it >= hi) return;
    AttnRegs R; attn_load(C, it, true, zqkv, rope, R);
    bf16x8 qf[2];
    attn_store(C, it, true, R, qf);
    __syncthreads();
    for (;;) {
        const int nxt = it + 1; const bool nboth = (nxt & ((64 >> (2 * (((nxt % 768) >> 6) >> 2))) - 1)) == 0;
        if (nxt < hi) attn_load(C, nxt, nboth, zqkv, rope, R);
        attn_compute(C, it, qf, og, lse_out);
        if (nxt >= hi) break;
        if (nboth) __syncthreads();
        attn_store(C, nxt, nboth, R, qf);
        __syncthreads();
        it = nxt;
    }
    __syncthreads();
}
typedef float f32x16 __attribute__((ext_vector_type(16)));
constexpr int SS_TILE = 32 * 256;
__device__ __forceinline__ void cstep(float& sr, float& si, float ar, float ai, float xr, float xi) { const float nr = fmaf(ar, sr, fmaf(-ai, si, xr)), ni = fmaf(ar, si, fmaf(ai, sr, xi)); sr = nr; si = ni; }
template <bool OUT>
__device__ __forceinline__ void ssm_item(const Ctx& C, int it, const bf16_t* zps, const unsigned char* sc, f32x2* send, const float* cre, const float* cim, const float* dsk, bf16_t* ssmy) {
    const int b = it / (NCH * SSM_G), rem = it % (NCH * SSM_G), c = rem / SSM_G, g = rem % SSM_G;
    const int lane = C.lane, n = lane & 31, hi = lane >> 5, tl = lane & 15, quad = lane >> 4;
    const f32x2 ab0 = ((const f32x2*)sc)[g * SSM_N + n], ab1 = ((const f32x2*)sc)[g * SSM_N + 32 + n];
    bf16x8 bfr[4];
    { const f32x4* p0 = (const f32x4*)(sc + 32768) + (size_t)(g * SSM_N + n) * 8 + 4 * hi; const f32x4* p1 = (const f32x4*)(sc + 32768) + (size_t)(g * SSM_N + 32 + n) * 8 + 4 * hi;
      const f32x4 a0 = p0[0], a1 = p0[1], a2 = p0[2], a3 = p0[3], c0 = p1[0], c1 = p1[1], c2 = p1[2], c3 = p1[3];
      bfr[0] = __builtin_bit_cast(bf16x8, (u32x4){pk2(a0[0], a0[2]), pk2(a1[0], a1[2]), pk2(a2[0], a2[2]), pk2(a3[0], a3[2])});
      bfr[2] = __builtin_bit_cast(bf16x8, (u32x4){pk2(a0[1], a0[3]), pk2(a1[1], a1[3]), pk2(a2[1], a2[3]), pk2(a3[1], a3[3])});
      bfr[1] = __builtin_bit_cast(bf16x8, (u32x4){pk2(c0[0], c0[2]), pk2(c1[0], c1[2]), pk2(c2[0], c2[2]), pk2(c3[0], c3[2])});
      bfr[3] = __builtin_bit_cast(bf16x8, (u32x4){pk2(c0[1], c0[3]), pk2(c1[1], c1[3]), pk2(c2[1], c2[3]), pk2(c3[1], c3[3])}); }
    float s0r = 0.f, s0i = 0.f, s1r = 0.f, s1i = 0.f;
    float p0r = ab0[0], p0i = ab0[1], p1r = ab1[0], p1i = ab1[1];
    if (!OUT) {
#pragma unroll
        for (int q = 0; q < 4; ++q) { const float t0 = p0r * p0r - p0i * p0i, t1 = 2.f * p0r * p0i, t2 = p1r * p1r - p1i * p1i, t3 = 2.f * p1r * p1i; p0r = t0; p0i = t1; p1r = t2; p1i = t3; }
    }
    bf16x8 cf[4]; float dq[4];
    LAS unsigned char* tile = C.lds + C.wave * SS_TILE;
    if (OUT) {
        const f32x2 aC0 = ((const f32x2*)(sc + 16384))[g * SSM_N + n], aC1 = ((const f32x2*)(sc + 16384))[g * SSM_N + 32 + n];
        const f32x2* sp = send + ((size_t)(b * NCH) * SSM_G + g) * SSM_N + n;
        f32x2 sv0[NCH], sv1[NCH];
#pragma unroll
        for (int k = 0; k < NCH; ++k) { const int kc = k < c ? k : 0; sv0[k] = sp[(size_t)kc * SSM_G * SSM_N]; sv1[k] = sp[(size_t)kc * SSM_G * SSM_N + 32]; }
#pragma unroll
        for (int k = 0; k < NCH; ++k) if (k < c) { cstep(s0r, s0i, aC0[0], aC0[1], sv0[k][0], sv0[k][1]); cstep(s1r, s1i, aC1[0], aC1[1], sv1[k][0], sv1[k][1]); }
        const float* crp = cre + ((size_t)g * SSM_P + tl) * SSM_N; const float* cip = cim + ((size_t)g * SSM_P + tl) * SSM_N;
#pragma unroll
        for (int kk = 0; kk < 4; ++kk) { const float* src = (kk < 2 ? crp : cip) + (kk & 1) * 32 + 8 * quad; const float sg = kk < 2 ? 1.f : -1.f;
            const f32x4 a = *(const f32x4*)src * sg, bq = *(const f32x4*)(src + 4) * sg;
            cf[kk] = __builtin_bit_cast(bf16x8, (u32x4){pk2(a[0], a[1]), pk2(a[2], a[3]), pk2(bq[0], bq[1]), pk2(bq[2], bq[3])}); }
#pragma unroll
        for (int i = 0; i < 4; ++i) dq[i] = dsk[g * SSM_P + 4 * quad + i];
    }
    const size_t m0 = (size_t)b * SEQ + (size_t)c * CH;
    const int tau = 16 * ((n >> 2) & 1) + (n & 3) + 4 * (n >> 3);
    const bf16_t* up = zps + (m0 + tau) * 1024 + POOLW + g * SSM_P + 8 * hi;
    const bf16_t* ue = zps + (m0 + tl) * 1024 + POOLW + g * SSM_P + 4 * quad;
    bf16x8 ua = *(const bf16x8*)up;
    u32x2 ue0 = {0u, 0u}, ue1 = {0u, 0u};
    if (OUT) { ue0 = *(const u32x2*)ue; ue1 = *(const u32x2*)(ue + 16 * 1024); }
    for (int blk = 0; blk < CH / 32; ++blk) {
        const bf16x8 ucur = ua; const u32x2 uc0 = ue0, uc1 = ue1;
        if (blk + 1 < CH / 32) { ua = *(const bf16x8*)(up + (size_t)(blk + 1) * 32 * 1024); if (OUT) { ue0 = *(const u32x2*)(ue + (size_t)(blk + 1) * 32 * 1024); ue1 = *(const u32x2*)(ue + (size_t)((blk + 1) * 32 + 16) * 1024); } }
        f32x16 xr0 = {}, xr1 = {}, xi0 = {}, xi1 = {};
        xr0 = __builtin_amdgcn_mfma_f32_32x32x16_bf16(ucur, bfr[0], xr0, 0, 0, 0);
        xr1 = __builtin_amdgcn_mfma_f32_32x32x16_bf16(ucur, bfr[1], xr1, 0, 0, 0);
        xi0 = __builtin_amdgcn_mfma_f32_32x32x16_bf16(ucur, bfr[2], xi0, 0, 0, 0);
        xi1 = __builtin_amdgcn_mfma_f32_32x32x16_bf16(ucur, bfr[3], xi1, 0, 0, 0);
        float e0r = hi ? 0.f : s0r, e0i = hi ? 0.f : s0i, e1r = hi ? 0.f : s1r, e1i = hi ? 0.f : s1i;
#pragma unroll
        for (int r = 0; r < 16; ++r) { cstep(e0r, e0i, ab0[0], ab0[1], xr0[r], xi0[r]); cstep(e1r, e1i, ab1[0], ab1[1], xr1[r], xi1[r]); }
        const float q0r = shx<32>(e0r), q0i = shx<32>(e0i), q1r = shx<32>(e1r), q1i = shx<32>(e1i);
        if (!OUT) {
            float f0r = e0r, f0i = e0i, f1r = e1r, f1i = e1i;
            { const float nr = fmaf(p0r, q0r, fmaf(-p0i, q0i, f0r)), ni = fmaf(p0r, q0i, fmaf(p0i, q0r, f0i)); f0r = nr; f0i = ni; }
            { const float nr = fmaf(p1r, q1r, fmaf(-p1i, q1i, f1r)), ni = fmaf(p1r, q1i, fmaf(p1i, q1r, f1i)); f1r = nr; f1i = ni; }
            const float g0r = shx<32>(f0r), g0i = shx<32>(f0i), g1r = shx<32>(f1r), g1i = shx<32>(f1i);
            s0r = hi ? f0r : g0r; s0i = hi ? f0i : g0i; s1r = hi ? f1r : g1r; s1i = hi ? f1i : g1i;
        } else {
            float t0r = hi ? q0r : s0r, t0i = hi ? q0i : s0i, t1r = hi ? q1r : s1r, t1i = hi ? q1i : s1i;
#pragma unroll
            for (int r = 0; r < 16; ++r) { cstep(t0r, t0i, ab0[0], ab0[1], xr0[r], xi0[r]); xr0[r] = t0r; xi0[r] = t0i; cstep(t1r, t1i, ab1[0], ab1[1], xr1[r], xi1[r]); xr1[r] = t1r; xi1[r] = t1i; }
            const float g0r = shx<32>(t0r), g0i = shx<32>(t0i), g1r = shx<32>(t1r), g1i = shx<32>(t1i);
            s0r = hi ? t0r : g0r; s0i = hi ? t0i : g0i; s1r = hi ? t1r : g1r; s1i = hi ? t1i : g1i;
#pragma unroll
            for (int r = 0; r < 16; ++r) { LAS unsigned char* rowp = tile + (16 * hi + r) * 256 + (n & 7) * 2; const int cb = n >> 3;
                const unsigned wre = pk2(xr0[r], xr1[r]), wim = pk2(xi0[r], xi1[r]);
                *(LAS bf16_t*)(rowp + (((cb) ^ r) << 4)) = (bf16_t)(wre & 0xffffu); *(LAS bf16_t*)(rowp + (((cb + 4) ^ r) << 4)) = (bf16_t)(wre >> 16);
                *(LAS bf16_t*)(rowp + (((cb + 8) ^ r) << 4)) = (bf16_t)(wim & 0xffffu); *(LAS bf16_t*)(rowp + (((cb + 12) ^ r) << 4)) = (bf16_t)(wim >> 16); }
            LDS_WAIT(); asm volatile("" ::: "memory");
#pragma unroll
            for (int h2 = 0; h2 < 2; ++h2) {
                f32x4 y = {0.f, 0.f, 0.f, 0.f};
#pragma unroll
                for (int kk = 0; kk < 4; ++kk) { const bf16x8 sf = *(const LAS bf16x8*)(tile + (16 * h2 + tl) * 256 + (((4 * kk + quad) ^ tl) << 4)); y = __builtin_amdgcn_mfma_f32_16x16x32_bf16(cf[kk], sf, y, 0, 0, 0); }
                const size_t m = m0 + 32 * blk + 16 * h2 + tl;
                const u32x2 uu = h2 ? uc1 : uc0;
                const float uf[4] = {bflo(uu.x), bfhi(uu.x), bflo(uu.y), bfhi(uu.y)};
                float o[4];
#pragma unroll
                for (int i = 0; i < 4; ++i) o[i] = gelu_tanh(y[i] + dq[i] * uf[i]);
                u32x2 wv; wv.x = pk2(o[0], o[1]); wv.y = pk2(o[2], o[3]);
                *(u32x2*)(ssmy + m * SSMW + g * SSM_P + 4 * quad) = wv;
            }
            LDS_WAIT(); asm volatile("" ::: "memory");
        }
    }
    if (!OUT && hi == 0) { f32x2* dst = send + (((size_t)b * NCH + c) * SSM_G + g) * SSM_N + n; dst[0] = (f32x2){s0r, s0i}; dst[32] = (f32x2){s1r, s1i}; }
}

template <int WIN>
__device__ __forceinline__ void pool_run(const bf16_t* zps, bf16_t* pooled, int m0, int c) {
    const int t0 = m0 & (SEQ - 1);
    u32x4 v[15 + WIN];
#pragma unroll
    for (int j = 0; j < 15 + WIN; ++j) { const int dt = j - (WIN - 1); v[j] = (u32x4){0u, 0u, 0u, 0u}; if (t0 + dt >= 0) v[j] = *(const u32x4*)(zps + (size_t)(m0 + dt) * 1024 + 8 * c); }
    float s[8];
#pragma unroll
    for (int e = 0; e < 8; ++e) s[e] = 0.f;
#pragma unroll
    for (int j = 0; j < WIN - 1; ++j) { s[0] += bflo(v[j].x); s[1] += bfhi(v[j].x); s[2] += bflo(v[j].y); s[3] += bfhi(v[j].y); s[4] += bflo(v[j].z); s[5] += bfhi(v[j].z); s[6] += bflo(v[j].w); s[7] += bfhi(v[j].w); }
#pragma unroll
    for (int k = 0; k < 16; ++k) {
        const u32x4 cur = v[WIN - 1 + k];
        s[0] += bflo(cur.x); s[1] += bfhi(cur.x); s[2] += bflo(cur.y); s[3] += bfhi(cur.y); s[4] += bflo(cur.z); s[5] += bfhi(cur.z); s[6] += bflo(cur.w); s[7] += bfhi(cur.w);
        const int cnt = (t0 + k + 1) < WIN ? (t0 + k + 1) : WIN; const float inv = 1.0f / (float)cnt;
        u32x4 o; o.x = pk2(s[0] * inv - bflo(cur.x), s[1] * inv - bfhi(cur.x)); o.y = pk2(s[2] * inv - bflo(cur.y), s[3] * inv - bfhi(cur.y));
        o.z = pk2(s[4] * inv - bflo(cur.z), s[5] * inv - bfhi(cur.z)); o.w = pk2(s[6] * inv - bflo(cur.w), s[7] * inv - bfhi(cur.w));
        *(u32x4*)(pooled + (size_t)(m0 + k) * POOLW + 8 * c) = o;
        const u32x4 old = v[k];
        s[0] -= bflo(old.x); s[1] -= bfhi(old.x); s[2] -= bflo(old.y); s[3] -= bfhi(old.y); s[4] -= bflo(old.z); s[5] -= bfhi(old.z); s[6] -= bflo(old.w); s[7] -= bfhi(old.w);
    }
}
__device__ __forceinline__ void pool_items(const Ctx& C, const bf16_t* zps, bf16_t* pooled) {
    for (int w = C.gw; w < (M / 64) * 4; w += C.ngw) {
        const int gi = w & 3, m0 = 64 * (w >> 2) + 16 * (C.lane >> 4), c = 16 * gi + (C.lane & 15);
        if (gi == 0) pool_run<2>(zps, pooled, m0, c); else if (gi == 1) pool_run<4>(zps, pooled, m0, c); else if (gi == 2) pool_run<8>(zps, pooled, m0, c); else pool_run<16>(zps, pooled, m0, c);
    }
}
__device__ __forceinline__ void attn_merge_items(const Ctx& C, const bf16_t* og, const float* lse, bf16_t* attn) {
    for (int i = C.gt; i < M * 32; i += C.ngt) {
        const int m = i >> 5, c = i & 31, hs = c >> 3;
        const float l0 = lse[((size_t)0 * M + m) * 4 + hs], l1 = lse[((size_t)1 * M + m) * 4 + hs], l2 = lse[((size_t)2 * M + m) * 4 + hs];
        const float mx = fmaxf(l0, fmaxf(l1, l2));
        float w0 = __expf(l0 - mx), w1 = __expf(l1 - mx), w2 = __expf(l2 - mx); const float inv = 1.0f / (w0 + w1 + w2); w0 *= inv; w1 *= inv; w2 *= inv;
        const u32x4 a = *(const u32x4*)(og + ((size_t)0 * M + m) * AOUT + 8 * c), bq = *(const u32x4*)(og + ((size_t)1 * M + m) * AOUT + 8 * c), cq = *(const u32x4*)(og + ((size_t)2 * M + m) * AOUT + 8 * c);
        u32x4 o;
        o.x = pk2(w0 * bflo(a.x) + w1 * bflo(bq.x) + w2 * bflo(cq.x), w0 * bfhi(a.x) + w1 * bfhi(bq.x) + w2 * bfhi(cq.x));
        o.y = pk2(w0 * bflo(a.y) + w1 * bflo(bq.y) + w2 * bflo(cq.y), w0 * bfhi(a.y) + w1 * bfhi(bq.y) + w2 * bfhi(cq.y));
        o.z = pk2(w0 * bflo(a.z) + w1 * bflo(bq.z) + w2 * bflo(cq.z), w0 * bfhi(a.z) + w1 * bfhi(bq.z) + w2 * bfhi(cq.z));
        o.w = pk2(w0 * bflo(a.w) + w1 * bflo(bq.w) + w2 * bflo(cq.w), w0 * bfhi(a.w) + w1 * bfhi(bq.w) + w2 * bfhi(cq.w));
        *(u32x4*)(attn + (size_t)m * AOUT + 8 * c) = o;
    }
}
constexpr int TK_KEYS = 65536, TK_CIJ = TK_KEYS, TK_WSCR = TK_KEYS + 256, TK_LDS = TK_WSCR + 8 * 1024;
__device__ __forceinline__ void topk_stage_keys(const Ctx& C, const bf16_t* k1, const bf16_t* k2) {
#pragma unroll
    for (int p = 0; p < 8; ++p) { const int e = C.tid + p * NTHREADS, tab = e >> 11, row = (e >> 4) & 127, ch = e & 15;
        const u32x4 v = *(const u32x4*)((tab ? k2 : k1) + row * 128 + ch * 8);
        *(LAS u32x4*)(C.lds + tab * 32768 + row * 256 + ((ch ^ (row & 15)) << 4)) = v; }
    if (C.tid < 64) { int c = C.tid, i = 0, j = 0, found = 0, cnt = 0;
        for (int ii = 0; ii < 16; ++ii) for (int jj = 0; jj < 16; ++jj) if ((ii + 1) * (jj + 1) <= 16) { if (cnt == c) { i = ii; j = jj; found = 1; } ++cnt; }
        *(LAS unsigned char*)(C.lds + TK_CIJ + c) = (unsigned char)(found ? ((i << 4) | j) : 0); }
}
template <int N> __device__ __forceinline__ void bitonic_sort_desc(float (&a)[N]) {
#pragma unroll
    for (int k = 2; k <= N; k <<= 1)
#pragma unroll
        for (int j = k >> 1; j > 0; j >>= 1)
#pragma unroll
            for (int i = 0; i < N; ++i) { const int l = i ^ j; if (l > i) { const bool desc = (i & k) == 0; const float hi = fmaxf(a[i], a[l]), lo = fminf(a[i], a[l]); a[i] = desc ? hi : lo; a[l] = desc ? lo : hi; } }
}
template <int N> __device__ __forceinline__ void bitonic_merge_desc(float (&a)[N]) {
#pragma unroll
    for (int j = N >> 1; j > 0; j >>= 1)
#pragma unroll
        for (int i = 0; i < N; ++i) { const int l = i ^ j; if (l > i) { const float hi = fmaxf(a[i], a[l]), lo = fminf(a[i], a[l]); a[i] = hi; a[l] = lo; } }
}
template <int MASK>
__device__ __forceinline__ void merge_lanes16(float (&top)[16]) {
    float c[16];
#pragma unroll
    for (int i = 0; i < 16; ++i) c[i] = fmaxf(top[i], shx<MASK>(top[15 - i]));
    bitonic_merge_desc<16>(c);
#pragma unroll
    for (int i = 0; i < 16; ++i) top[i] = c[i];
}
struct TkQ { bf16x8 q[2][4]; };
__device__ __forceinline__ void topk_load(const Ctx& C, int it, const bf16_t* qbuf, TkQ& Q) {
    const int tg = it >> 3, h = it & 7, tl = C.lane & 15, quad = C.lane >> 4;
    const bf16_t* qrow = qbuf + ((size_t)16 * tg + tl) * PQ + h * 256 + 8 * quad;
#pragma unroll
    for (int t = 0; t < 2; ++t)
#pragma unroll
        for (int kk = 0; kk < 4; ++kk) Q.q[t][kk] = *(const bf16x8*)(qrow + 128 * t + 32 * kk);
}
__device__ __forceinline__ void topk_table(const Ctx& C, int tab, const bf16x8 (&qf)[4], float (&top)[16]) {
    const int tl = C.lane & 15, quad = C.lane >> 4;
    float v[32];
#pragma unroll
    for (int mb = 0; mb < 8; ++mb) {
        f32x4 acc = {0.f, 0.f, 0.f, 0.f}; const int row = 16 * mb + tl;
#pragma unroll
        for (int kk = 0; kk < 4; ++kk) { const bf16x8 kf = *(const LAS bf16x8*)(C.lds + tab * 32768 + row * 256 + (((4 * kk + quad) ^ (row & 15)) << 4));
            acc = __builtin_amdgcn_mfma_f32_16x16x32_bf16(kf, qf[kk], acc, 0, 0, 0); }
#pragma unroll
        for (int i = 0; i < 4; ++i) { const float sc_ = acc[i]; v[4 * mb + i] = bitsf((fbits(sc_) & ~127u) | (unsigned)(16 * mb + 4 * quad + i)); }
    }
#pragma unroll
    for (int k = 2; k <= 16; k <<= 1)
#pragma unroll
        for (int j = k >> 1; j > 0; j >>= 1)
#pragma unroll
            for (int i = 0; i < 32; ++i) { const int l = i ^ j; if (l > i) { const bool desc = (i & k) == 0; const float hi = fmaxf(v[i], v[l]), lo = fminf(v[i], v[l]); v[i] = desc ? hi : lo; v[l] = desc ? lo : hi; } }
#pragma unroll
    for (int i = 0; i < 16; ++i) top[i] = fmaxf(v[i], v[16 + i]);
    bitonic_merge_desc<16>(top);
    merge_lanes16<16>(top); merge_lanes16<32>(top);
}

__device__ __forceinline__ void topk_item(const Ctx& C, int it, const TkQ& Q, int* idx, float* gate) {
    const int tg = it >> 3, h = it & 7, tl = C.lane & 15, quad = C.lane >> 4;
    const size_t m = (size_t)16 * tg + tl;
    float t1[16], t2[16];
    topk_table(C, 0, Q.q[0], t1);
    __builtin_amdgcn_sched_barrier(0);
    topk_table(C, 1, Q.q[1], t2);
    __builtin_amdgcn_sched_barrier(0);
    constexpr int CI[50] = {0,0,0,0,0,0,0,0,0,0,0,0,0,0,0,0,1,1,1,1,1,1,1,1,2,2,2,2,2,3,3,3,3,4,4,4,5,5,6,6,7,7,8,9,10,11,12,13,14,15};
    constexpr int CJ[50] = {0,1,2,3,4,5,6,7,8,9,10,11,12,13,14,15,0,1,2,3,4,5,6,7,0,1,2,3,4,0,1,2,3,0,1,2,0,1,0,1,0,1,0,0,0,0,0,0,0,0};
    float c1[16], c2[16];
#pragma unroll
    for (int i = 0; i < 16; ++i) { c1[i] = bitsf(fbits(t1[i]) & ~127u); c2[i] = bitsf(fbits(t2[i]) & ~127u); }
    LAS unsigned char* wscr = C.lds + TK_WSCR + C.wave * 1024 + tl * 32;
    {
        unsigned p1 = 0u, p2 = 0u;
#pragma unroll
        for (int i = 0; i < 4; ++i) { const unsigned a = quad == 0 ? fbits(t1[i]) : quad == 1 ? fbits(t1[4 + i]) : quad == 2 ? fbits(t1[8 + i]) : fbits(t1[12 + i]);
            const unsigned b = quad == 0 ? fbits(t2[i]) : quad == 1 ? fbits(t2[4 + i]) : quad == 2 ? fbits(t2[8 + i]) : fbits(t2[12 + i]);
            p1 |= (a & 127u) << (8 * i); p2 |= (b & 127u) << (8 * i); }
        *(LAS unsigned*)(wscr + 4 * quad) = p1; *(LAS unsigned*)(wscr + 16 + 4 * quad) = p2;
    }
    float cv[16];
#pragma unroll
    for (int s = 0; s < 16; ++s) {
        float vv = -INFINITY;
        if (s < 13) {
#pragma unroll
            for (int qd = 0; qd < 4; ++qd) { const int c = 4 * s + qd;
                if (c < 50) { const float sum = c1[CI[c < 50 ? c : 0]] + c2[CJ[c < 50 ? c : 0]];
                    const float pv = bitsf((fbits(sum) & ~63u) | (unsigned)c);
                    if (quad == qd) vv = pv; } } }
        cv[s] = vv;
    }
    bitonic_sort_desc<16>(cv);
    merge_lanes16<16>(cv); merge_lanes16<32>(cv);
    float ex[16], sum = 0.f;
#pragma unroll
    for (int r = 0; r < 16; ++r) { ex[r] = __expf(cv[r] - cv[0]); sum += ex[r]; }
    const float inv = 1.0f / sum;
    int oe[4]; float og_[4];
#pragma unroll
    for (int i = 0; i < 4; ++i) {
        const float rvv = quad == 0 ? cv[i] : quad == 1 ? cv[4 + i] : quad == 2 ? cv[8 + i] : cv[12 + i];
        og_[i] = (quad == 0 ? ex[i] : quad == 1 ? ex[4 + i] : quad == 2 ? ex[8 + i] : ex[12 + i]) * inv;
        const unsigned c = fbits(rvv) & 63u;
        const unsigned ij = *(const LAS unsigned char*)(C.lds + TK_CIJ + c);
        const unsigned e1 = *(const LAS unsigned char*)(wscr + (ij >> 4)), e2 = *(const LAS unsigned char*)(wscr + 16 + (ij & 15u));
        oe[i] = (int)((e1 * NKEYS + e2) & (NEXP - 1));
    }
    *(int4*)(idx + m * 128 + h * 16 + 4 * quad) = make_int4(oe[0], oe[1], oe[2], oe[3]);
    *(f32x4*)(gate + m * 128 + h * 16 + 4 * quad) = (f32x4){og_[0], og_[1], og_[2], og_[3]};
}
__device__ __forceinline__ void topk_items(const Ctx& C, const bf16_t* qbuf, int* idx, float* gate) {
    constexpr int NI = (M / 16) * PH;
    int it = C.gw; if (it >= NI) return;
    TkQ Q; topk_load(C, it, qbuf, Q);
    for (;;) {
        const int nxt = it + C.ngw; TkQ Qn;
        if (nxt < NI) topk_load(C, nxt, qbuf, Qn);
        topk_item(C, it, Q, idx, gate);
        if (nxt >= NI) break;
        Q = Qn; it = nxt;
    }
}
__device__ __forceinline__ int topk_own_item(const pg8::StaticOrder& S, int wave, int k) { pg8::Unit u; if (!S.next(k >> 1, u)) return -1; return (16 * u.pm + wave + 8 * (k & 1)) * PH + u.pn; }
__device__ __forceinline__ void topk_own_items(const Ctx& C, const pg8::StaticOrder& S, const bf16_t* qbuf, int* idx, float* gate) {
    int k = 0, it = topk_own_item(S, C.wave, 0); if (it < 0) return;
    TkQ Q; topk_load(C, it, qbuf, Q);
    for (;;) {
        const int nxt = topk_own_item(S, C.wave, k + 1); TkQ Qn;
        if (nxt >= 0) topk_load(C, nxt, qbuf, Qn);
        topk_item(C, it, Q, idx, gate);
        if (nxt < 0) break;
        Q = Qn; it = nxt; ++k;
    }
}
#if TAB_BITS == 8
typedef u32x4 tabv_t;
#else
typedef u32x2 tabv_t;
#endif
constexpr int TABROW = D * TAB_BITS / 8;
__device__ __forceinline__ void peer_load8(const unsigned char* tab, int e0, int e1, int kbase, int lane, tabv_t (&buf)[8]) {
#pragma unroll
    for (int e = 0; e < 8; ++e) { const int k = kbase + e; const int ex = __builtin_amdgcn_readlane(k < 64 ? e0 : e1, k & 63);
        buf[e] = *((const tabv_t*)(tab + (size_t)ex * TABROW) + lane); }
}
__device__ __forceinline__ float dot16(const tabv_t& a, const unsigned (&hh)[8]) {
    float d = 0.f;
#if TAB_BITS == 8
    const unsigned w[4] = {a.x, a.y, a.z, a.w};
#pragma unroll
    for (int q = 0; q < 4; ++q) {
        d = __builtin_amdgcn_fdot2(__builtin_amdgcn_cvt_scalef32_pk_f16_fp8(w[q], 1.0f, false), as_h2(hh[2 * q]), d, false);
        d = __builtin_amdgcn_fdot2(__builtin_amdgcn_cvt_scalef32_pk_f16_fp8(w[q], 1.0f, true), as_h2(hh[2 * q + 1]), d, false);
    }
#else
    const unsigned w[2] = {a.x, a.y};
#pragma unroll
    for (int dd = 0; dd < 2; ++dd) {
        d = __builtin_amdgcn_fdot2(__builtin_amdgcn_cvt_scalef32_pk_f16_fp4(w[dd], 1.0f, 0), as_h2(hh[4 * dd + 0]), d, false);
        d = __builtin_amdgcn_fdot2(__builtin_amdgcn_cvt_scalef32_pk_f16_fp4(w[dd], 1.0f, 1), as_h2(hh[4 * dd + 1]), d, false);
        d = __builtin_amdgcn_fdot2(__builtin_amdgcn_cvt_scalef32_pk_f16_fp4(w[dd], 1.0f, 2), as_h2(hh[4 * dd + 2]), d, false);
        d = __builtin_amdgcn_fdot2(__builtin_amdgcn_cvt_scalef32_pk_f16_fp4(w[dd], 1.0f, 3), as_h2(hh[4 * dd + 3]), d, false);
    }
#endif
    return d;
}
__device__ __forceinline__ float reduce8(const float (&d)[8], int lane) {
    const bool b5 = lane & 32, b4 = lane & 16, b3 = lane & 8;
    float r4[4];
#pragma unroll
    for (int i = 0; i < 4; ++i) { const float keep = b5 ? d[4 + i] : d[i], send = b5 ? d[i] : d[4 + i]; r4[i] = keep + shx<32>(send); }
    float r2[2];
#pragma unroll
    for (int i = 0; i < 2; ++i) { const float keep = b4 ? r4[2 + i] : r4[i], send = b4 ? r4[i] : r4[2 + i]; r2[i] = keep + shx<16>(send); }
    float r1; { const float keep = b3 ? r2[1] : r2[0], send = b3 ? r2[0] : r2[1]; r1 = keep + shx<8>(send); }
    r1 += shx<4>(r1); r1 += shx<2>(r1); r1 += shx<1>(r1);
    return r1;
}
#if TAB_BITS == 4
__device__ __forceinline__ int idot16(const tabv_t& a, const unsigned (&hq)[4]) {
    const int s_hi = __builtin_amdgcn_sdot8((int)a.y, (int)hq[1], __builtin_amdgcn_sdot8((int)a.x, (int)hq[0], 0, false), false);
    const int s_lo = __builtin_amdgcn_sdot8((int)a.y, (int)hq[3], __builtin_amdgcn_sdot8((int)a.x, (int)hq[2], 0, false), false);
    return 16 * s_hi + s_lo;
}
__device__ __forceinline__ int reduce8i(const int (&d)[8], int lane) {
    const bool b5 = lane & 32, b4 = lane & 16, b3 = lane & 8;
    int r4[4];
#pragma unroll
    for (int i = 0; i < 4; ++i) { const int keep = b5 ? d[4 + i] : d[i], send = b5 ? d[i] : d[4 + i]; r4[i] = keep + shx<32>(send); }
    int r2[2];
#pragma unroll
    for (int i = 0; i < 2; ++i) { const int keep = b4 ? r4[2 + i] : r4[i], send = b4 ? r4[i] : r4[2 + i]; r2[i] = keep + shx<16>(send); }
    int r1; { const int keep = b3 ? r2[1] : r2[0], send = b3 ? r2[0] : r2[1]; r1 = keep + shx<8>(send); }
    r1 += shx<4>(r1); r1 += shx<2>(r1); r1 += shx<1>(r1);
    return r1;
}
__device__ __forceinline__ void peer_dots(const tabv_t (&buf)[8], const unsigned (&hq)[4], int grp, int lane, float& a0, float& a1) {
    int d[8];
#pragma unroll
    for (int e = 0; e < 8; ++e) d[e] = idot16(buf[e], hq);
    const int r1 = reduce8i(d, lane);
    const int e = lane & 7, src = ((e >> 2) & 1) * 32 + ((e >> 1) & 1) * 16 + (e & 1) * 8;
    const float val = (float)shfl_idx(r1, src);
    if ((lane >> 3) == (grp & 7)) { if (grp < 8) a0 = val; else a1 = val; }
}
#else
__device__ __forceinline__ void peer_dots(const tabv_t (&buf)[8], const unsigned (&hh)[8], int grp, int lane, float& a0, float& a1) {
    float d[8];
#pragma unroll
    for (int e = 0; e < 8; ++e) d[e] = dot16(buf[e], hh);
    const float r1 = reduce8(d, lane);
    const int e = lane & 7, src = ((e >> 2) & 1) * 32 + ((e >> 1) & 1) * 16 + (e & 1) * 8;
    const float val = shfl_idx(r1, src);
    if ((lane >> 3) == (grp & 7)) { if (grp < 8) a0 = val; else a1 = val; }
}
#endif
__device__ __forceinline__ void peer_fma8(const tabv_t (&buf)[8], float c0, float c1, int kbase, float (&acc)[16]) {
#pragma unroll
    for (int e = 0; e < 8; ++e) { const int k = kbase + e; const float ck = bitsf((unsigned)__builtin_amdgcn_readlane((int)fbits(k < 64 ? c0 : c1), k & 63));
#if TAB_BITS == 4
        const unsigned w4[2] = {buf[e].x, buf[e].y};
#pragma unroll
        for (int dd = 0; dd < 2; ++dd) {
            const h2_t p0 = __builtin_amdgcn_cvt_scalef32_pk_f16_fp4(w4[dd], 1.0f, 0), p1 = __builtin_amdgcn_cvt_scalef32_pk_f16_fp4(w4[dd], 1.0f, 1),
                       p2 = __builtin_amdgcn_cvt_scalef32_pk_f16_fp4(w4[dd], 1.0f, 2), p3 = __builtin_amdgcn_cvt_scalef32_pk_f16_fp4(w4[dd], 1.0f, 3);
            acc[8 * dd + 0] = fmaf((float)p0[0], ck, acc[8 * dd + 0]); acc[8 * dd + 1] = fmaf((float)p0[1], ck, acc[8 * dd + 1]);
            acc[8 * dd + 2] = fmaf((float)p1[0], ck, acc[8 * dd + 2]); acc[8 * dd + 3] = fmaf((float)p1[1], ck, acc[8 * dd + 3]);
            acc[8 * dd + 4] = fmaf((float)p2[0], ck, acc[8 * dd + 4]); acc[8 * dd + 5] = fmaf((float)p2[1], ck, acc[8 * dd + 5]);
            acc[8 * dd + 6] = fmaf((float)p3[0], ck, acc[8 * dd + 6]); acc[8 * dd + 7] = fmaf((float)p3[1], ck, acc[8 * dd + 7]); }
#else
        const unsigned w[4] = {buf[e].x, buf[e].y, buf[e].z, buf[e].w};
#pragma unroll
        for (int q = 0; q < 4; ++q) { const h2_t lo = __builtin_amdgcn_cvt_scalef32_pk_f16_fp8(w[q], 1.0f, false), hi = __builtin_amdgcn_cvt_scalef32_pk_f16_fp8(w[q], 1.0f, true);
            acc[4 * q] = fmaf((float)lo[0], ck, acc[4 * q]); acc[4 * q + 1] = fmaf((float)lo[1], ck, acc[4 * q + 1]);
            acc[4 * q + 2] = fmaf((float)hi[0], ck, acc[4 * q + 2]); acc[4 * q + 3] = fmaf((float)hi[1], ck, acc[4 * q + 3]); }
#endif
    }
}
struct PeerTok { int e0, e1; float g0, g1, su0, su1, sv0, sv1; };
__device__ __forceinline__ void peer_tok_idx(PeerTok& T, int m, const int* idx, const float* gate, int lane) {
    T.e0 = idx[(size_t)m * 128 + lane]; T.e1 = idx[(size_t)m * 128 + 64 + lane]; T.g0 = gate[(size_t)m * 128 + lane]; T.g1 = gate[(size_t)m * 128 + 64 + lane];
}
__device__ __forceinline__ void peer_tok_scales(PeerTok& T, const float* scU, const float* scV) { T.su0 = scU[T.e0]; T.su1 = scU[T.e1]; T.sv0 = scV[T.e0]; T.sv1 = scV[T.e1]; }
__device__ __forceinline__ void peer_issue_f(int grp, const unsigned char* tab, const PeerTok& T, int lane, u32x4 (&buf)[8]) {
#pragma unroll
    for (int e = 0; e < 8; ++e) { const int k = 8 * grp + e; const int ex = __builtin_amdgcn_readlane(k < 64 ? T.e0 : T.e1, k & 63);
        buf[e] = *((const u32x4*)(tab + (size_t)ex * 1024) + lane); }
}
__device__ __forceinline__ void peer_group(const u32x4 (&buf)[8], const unsigned (&hq)[4], int grp, int lane, const PeerTok& T, float sh, h2_t (&acc)[8]) {
    int d[8];
#pragma unroll
    for (int e = 0; e < 8; ++e) { const u32x2 up = {buf[e].x, buf[e].y}; d[e] = idot16(up, hq); }
    const int r1 = reduce8i(d, lane);
    const int el = lane & 7, src = ((el >> 2) & 1) * 32 + ((el >> 1) & 1) * 16 + (el & 1) * 8;
    const float a = (float)shfl_idx(r1, src);
    const bool lo = grp < 8;
    const float c = ABL_PEER ? 0.f : (lo ? T.g0 : T.g1) * gelu_tanh(a * ((lo ? T.su0 : T.su1) * sh)) * (lo ? T.sv0 : T.sv1);
    const unsigned cpk = pkh2(c, c);
#pragma unroll
    for (int e = 0; e < 8; ++e) { const h2_t ck = as_h2((unsigned)__builtin_amdgcn_readlane((int)cpk, 8 * (grp & 7) + e));
        const unsigned w4[2] = {buf[e].z, buf[e].w};
#pragma unroll
        for (int dd = 0; dd < 2; ++dd) {
#pragma unroll
            for (int sl = 0; sl < 4; ++sl) { h2_t pv;
                if (sl == 0) pv = __builtin_amdgcn_cvt_scalef32_pk_f16_fp4(w4[dd], 1.0f, 0); else if (sl == 1) pv = __builtin_amdgcn_cvt_scalef32_pk_f16_fp4(w4[dd], 1.0f, 1);
                else if (sl == 2) pv = __builtin_amdgcn_cvt_scalef32_pk_f16_fp4(w4[dd], 1.0f, 2); else pv = __builtin_amdgcn_cvt_scalef32_pk_f16_fp4(w4[dd], 1.0f, 3);
                acc[4 * dd + sl] = __builtin_elementwise_fma(pv, ck, acc[4 * dd + sl]); } } }
}
template <bool LAST, bool DRY = false>
__device__ __forceinline__ void peer_tokens(const Ctx& C, int m0, int step, const unsigned char* tab, const float* scU, const float* scV, const int* idx, const float* gate, const float* ss2,
                                            float* xs, bf16_t* xg, const float* gnext, float* rstd1, const float* g2 = nullptr, bf16_t* xo = nullptr, unsigned char* h8p = nullptr) {
    const int lane = C.lane;
    if (m0 >= M) return;
    PeerTok T, Tn;
    peer_tok_idx(T, m0, idx, gate, lane); peer_tok_scales(T, scU, scV);
#if PEER_RING == 3
    u32x4 bA[8], bB[8], bC[8];
#else
    u32x4 bA[8], bB[8];
#endif
    int tokpar = 0;
    for (int m = m0; m < M; m += step) {
        const int mn = m + step; const bool has_next = mn < M;
        peer_issue_f(0, tab, T, lane, bA);
#if PEER_RING == 3
        peer_issue_f(1, tab, T, lane, bB);
#endif
        if (has_next) peer_tok_idx(Tn, mn, idx, gate, lane);
#if PEER_RESDMA
        { LAS unsigned char* slot = C.lds + C.wave * 4096;
#if XB16
#pragma unroll
          for (int j = 0; j < 2; ++j) __builtin_amdgcn_global_load_lds((const unsigned*)((const u32x4*)(xg + (size_t)m * D) + 2 * lane + j), (LAS unsigned*)(slot + j * 1024), 16, 0, 0);
#else
#pragma unroll
          for (int j = 0; j < 4; ++j) __builtin_amdgcn_global_load_lds((const unsigned*)((const f32x4*)(xs + (size_t)m * D) + 4 * lane + j), (LAS unsigned*)(slot + j * 1024), 16, 0, 0);
#endif
        }
#endif
        const float rs = pg8::row_rs(ss2, m);
        unsigned hh[4]; float sh;
        {
#if PEER_HDMA
          LAS unsigned char* hslot = C.lds + 32768 + C.wave * 4096 + (tokpar << 11);
          u32x4 x0, x1;
          if (m == m0) { x0 = *((const u32x4*)(xg + (size_t)m * D) + 2 * lane); x1 = *((const u32x4*)(xg + (size_t)m * D) + 2 * lane + 1); }
          else { x0 = *(const LAS u32x4*)(hslot + lane * 16); x1 = *(const LAS u32x4*)(hslot + 1024 + lane * 16); LDS_WAIT(); asm volatile("" ::: "memory"); }
          if (has_next) { LAS unsigned char* nslot = C.lds + 32768 + C.wave * 4096 + ((tokpar ^ 1) << 11);
#pragma unroll
              for (int j = 0; j < 2; ++j) __builtin_amdgcn_global_load_lds((const unsigned*)((const u32x4*)(xg + (size_t)mn * D) + 2 * lane + j), (LAS unsigned*)(nslot + j * 1024), 16, 0, 0); }
          tokpar ^= 1;
#else
          const u32x4 x0 = *((const u32x4*)(xg + (size_t)m * D) + 2 * lane), x1 = *((const u32x4*)(xg + (size_t)m * D) + 2 * lane + 1);
#endif
          const unsigned w[8] = {x0.x, x0.y, x0.z, x0.w, x1.x, x1.y, x1.z, x1.w};
          float hv[16]; float mxh = 0.f;
#pragma unroll
          for (int q = 0; q < 8; ++q) { hv[2 * q] = bflo(w[q]) * rs; hv[2 * q + 1] = bfhi(w[q]) * rs; }
#if XB16
#pragma unroll
          for (int q = 0; q < 4; ++q) { const f32x4 gq = *((const f32x4*)g2 + 4 * lane + q); hv[4 * q] *= gq[0]; hv[4 * q + 1] *= gq[1]; hv[4 * q + 2] *= gq[2]; hv[4 * q + 3] *= gq[3]; }
#endif
#pragma unroll
          for (int q = 0; q < 16; ++q) mxh = fmaxf(mxh, fabsf(hv[q]));
          mxh = wave_max(mxh);
          sh = fmaxf(mxh, 1e-30f) * (1.0f / 119.0f); const float inv = 1.0f / sh;
#pragma unroll
          for (int dd = 0; dd < 2; ++dd) { unsigned th = 0u, tl = 0u;
#pragma unroll
              for (int j = 0; j < 8; ++j) { const int q8 = (int)rintf(hv[8 * dd + j] * inv), hi = (q8 + 8) >> 4, lo = q8 - (hi << 4); th |= ((unsigned)hi & 15u) << (4 * j); tl |= ((unsigned)lo & 15u) << (4 * j); }
              hh[dd] = th; hh[2 + dd] = tl; } }
        h2_t acc[8];
#pragma unroll
        for (int i = 0; i < 8; ++i) acc[i] = (h2_t){(_Float16)0.f, (_Float16)0.f};
#if PEER_RING == 3
#pragma unroll 1
        for (int j = 0; j < 15; j += 3) {
            peer_issue_f(j + 2, tab, T, lane, bC); peer_group(bA, hh, j, lane, T, sh, acc);
            peer_issue_f(j + 3, tab, T, lane, bA); peer_group(bB, hh, j + 1, lane, T, sh, acc);
            if (j + 4 < 16) peer_issue_f(j + 4, tab, T, lane, bB);
            peer_group(bC, hh, j + 2, lane, T, sh, acc);
        }
        peer_group(bA, hh, 15, lane, T, sh, acc);
#else
#pragma unroll 1
        for (int j = 0; j < 16; j += 2) {
            peer_issue_f(j + 1, tab, T, lane, bB); peer_group(bA, hh, j, lane, T, sh, acc);
            if (j + 2 < 16) peer_issue_f(j + 2, tab, T, lane, bA);
            peer_group(bB, hh, j + 1, lane, T, sh, acc);
        }
#endif
#if PEER_RESDMA
        asm volatile("s_waitcnt vmcnt(0)" ::: "memory");
        f32x4 x[4];
        { LAS unsigned char* slot = C.lds + C.wave * 4096;
#if XB16
          const u32x4 x0 = *(const LAS u32x4*)(slot + lane * 16), x1 = *(const LAS u32x4*)(slot + 1024 + lane * 16);
          x[0] = (f32x4){bflo(x0.x), bfhi(x0.x), bflo(x0.y), bfhi(x0.y)}; x[1] = (f32x4){bflo(x0.z), bfhi(x0.z), bflo(x0.w), bfhi(x0.w)};
          x[2] = (f32x4){bflo(x1.x), bfhi(x1.x), bflo(x1.y), bfhi(x1.y)}; x[3] = (f32x4){bflo(x1.z), bfhi(x1.z), bflo(x1.w), bfhi(x1.w)};
#else
#pragma unroll
          for (int j = 0; j < 4; ++j) x[j] = *(const LAS f32x4*)(slot + j * 1024 + lane * 16);
#endif
          LDS_WAIT(); asm volatile("" ::: "memory"); }
        if (has_next) peer_tok_scales(Tn, scU, scV);
        float* xr = xs + (size_t)m * D;
#else
        if (has_next) peer_tok_scales(Tn, scU, scV);
        float* xr = xs + (size_t)m * D;
        f32x4 x[4];
#endif
#if PEER_RESDMA
#elif XB16
        { const u32x4 x0 = *((const u32x4*)(xg + (size_t)m * D) + 2 * lane), x1 = *((const u32x4*)(xg + (size_t)m * D) + 2 * lane + 1);
          x[0] = (f32x4){bflo(x0.x), bfhi(x0.x), bflo(x0.y), bfhi(x0.y)}; x[1] = (f32x4){bflo(x0.z), bfhi(x0.z), bflo(x0.w), bfhi(x0.w)};
          x[2] = (f32x4){bflo(x1.x), bfhi(x1.x), bflo(x1.y), bfhi(x1.y)}; x[3] = (f32x4){bflo(x1.z), bfhi(x1.z), bflo(x1.w), bfhi(x1.w)}; }
#else
#pragma unroll
        for (int j = 0; j < 4; ++j) x[j] = *((const f32x4*)xr + 4 * lane + j);
#endif
        float sq = 0.f;
#pragma unroll
        for (int j = 0; j < 4; ++j)
#pragma unroll
            for (int i = 0; i < 4; ++i) { x[j][i] += (float)acc[2 * j + (i >> 1)][i & 1]; sq += x[j][i] * x[j][i]; }
        sq = wave_sum(sq);
        const float rn = __builtin_amdgcn_rsqf(sq * (1.0f / D) + EPS);
        if (!(DRY && rn != 12345.678f)) {
        f32x4 gg[4];
        if (LAST || !XB16) {
#pragma unroll
        for (int j = 0; j < 4; ++j) gg[j] = *((const f32x4*)gnext + 4 * lane + j);
        }
        if (LAST) {
#pragma unroll
            for (int j = 0; j < 4; ++j) *((f32x4*)xr + 4 * lane + j) = x[j] * gg[j] * rn;
        } else {
#if XB16
            u32x4 o0, o1; const f32x4 y0 = x[0], y1 = x[1], y2 = x[2], y3 = x[3];
#else
#pragma unroll
            for (int j = 0; j < 4; ++j) *((f32x4*)xr + 4 * lane + j) = x[j];
            u32x4 o0, o1; const f32x4 y0 = x[0] * gg[0], y1 = x[1] * gg[1], y2 = x[2] * gg[2], y3 = x[3] * gg[3];
#endif
            o0.x = pk2(y0[0], y0[1]); o0.y = pk2(y0[2], y0[3]); o0.z = pk2(y1[0], y1[1]); o0.w = pk2(y1[2], y1[3]);
            o1.x = pk2(y2[0], y2[1]); o1.y = pk2(y2[2], y2[3]); o1.z = pk2(y3[0], y3[1]); o1.w = pk2(y3[2], y3[3]);
#if XB16 && OUT_PREFILL == 2
            xr[16 * lane] = 0.f;
#endif
            bf16_t* const xw = XB16 ? xo : xg;
            *((u32x4*)(xw + (size_t)m * D) + 2 * lane) = o0; *((u32x4*)(xw + (size_t)m * D) + 2 * lane + 1) = o1;
            if (GATE_F8) { u32x4 o8; o8.x = pk4_fp8(y0[0], y0[1], y0[2], y0[3]); o8.y = pk4_fp8(y1[0], y1[1], y1[2], y1[3]); o8.z = pk4_fp8(y2[0], y2[1], y2[2], y2[3]); o8.w = pk4_fp8(y3[0], y3[1], y3[2], y3[3]);
                *((u32x4*)(h8p + (size_t)m * D) + lane) = o8; }
            if (lane == 0) st_wt(rstd1 + m, rn);
        }
        }
        T = Tn;
    }
}

constexpr int PS_WAVE = 12800, PS_AC = 0, PS_EID = 8192, PS_SH = 12288;
__device__ __forceinline__ void peer_fma8_v(const u32x2 (&buf)[8], unsigned cp0, unsigned cp1, int kbase, h2_t (&acc)[8]) {
#pragma unroll
    for (int e = 0; e < 8; ++e) { const int k = kbase + e; const h2_t ck = as_h2((unsigned)__builtin_amdgcn_readlane((int)(k < 64 ? cp0 : cp1), k & 63));
        const unsigned w4[2] = {buf[e].x, buf[e].y};
#pragma unroll
        for (int dd = 0; dd < 2; ++dd) {
#pragma unroll
            for (int sl = 0; sl < 4; ++sl) { h2_t pv;
                if (sl == 0) pv = __builtin_amdgcn_cvt_scalef32_pk_f16_fp4(w4[dd], 1.0f, 0); else if (sl == 1) pv = __builtin_amdgcn_cvt_scalef32_pk_f16_fp4(w4[dd], 1.0f, 1);
                else if (sl == 2) pv = __builtin_amdgcn_cvt_scalef32_pk_f16_fp4(w4[dd], 1.0f, 2); else pv = __builtin_amdgcn_cvt_scalef32_pk_f16_fp4(w4[dd], 1.0f, 3);
                acc[4 * dd + sl] = __builtin_elementwise_fma(pv, ck, acc[4 * dd + sl]); } } }
}
__device__ __forceinline__ void peer_load8_v(const unsigned char* tabV, int e0, int e1, int kbase, int lane, u32x2 (&buf)[8]) {
#pragma unroll
    for (int e = 0; e < 8; ++e) { const int k = kbase + e; const int ex = __builtin_amdgcn_readlane(k < 64 ? e0 : e1, k & 63);
        buf[e] = *((const u32x2*)(tabV + (size_t)ex * 512) + lane); }
}
__device__ __forceinline__ void ps_issue(LAS unsigned char* wl, int i, const unsigned char* uslice, int r, int p, u32x2 (&rows)[16]) {
    const u32x4 w0 = *(const LAS u32x4*)(wl + PS_EID + i * 256 + r * 32), w1 = *(const LAS u32x4*)(wl + PS_EID + i * 256 + r * 32 + 16);
    const unsigned w[8] = {w0.x, w0.y, w0.z, w0.w, w1.x, w1.y, w1.z, w1.w};
#pragma unroll
    for (int j = 0; j < 16; ++j) { const unsigned e = (j & 1) ? (w[j >> 1] >> 16) : (w[j >> 1] & 0xffffu); rows[j] = *(const u32x2*)(uslice + (size_t)e * 64 + p * 8); }
}
__device__ __forceinline__ void ps_consume(LAS unsigned char* wl, int i, const u32x2 (&rows)[16], const u32x4& hq4, int lane) {
    const unsigned hq[4] = {hq4.x, hq4.y, hq4.z, hq4.w};
    int d[16];
#pragma unroll
    for (int j = 0; j < 16; ++j) d[j] = idot16(rows[j], hq);
    const bool b2 = lane & 4, b1 = lane & 2, b0 = lane & 1;
    int r8[8], r4[4], r2[2];
#pragma unroll
    for (int k = 0; k < 8; ++k) { const int keep = b2 ? d[8 + k] : d[k], send = b2 ? d[k] : d[8 + k]; r8[k] = keep + shx<4>(send); }
#pragma unroll
    for (int k = 0; k < 4; ++k) { const int keep = b1 ? r8[4 + k] : r8[k], send = b1 ? r8[k] : r8[4 + k]; r4[k] = keep + shx<2>(send); }
#pragma unroll
    for (int k = 0; k < 2; ++k) { const int keep = b0 ? r4[2 + k] : r4[k], send = b0 ? r4[k] : r4[2 + k]; r2[k] = keep + shx<1>(send); }
    LAS int* ap = (LAS int*)(wl + PS_AC + i * 512) + (lane >> 3) * 16 + 2 * (lane & 7);
    const int o0 = ap[0], o1 = ap[1]; ap[0] = o0 + r2[0]; ap[1] = o1 + r2[1];
}
template <bool LAST, bool DRY = false>
__device__ __forceinline__ void peer_sweep(const Ctx& C, const unsigned char* tabUs, const unsigned char* tabV, const float* scU, const float* scV, const int* idx, const float* gate, const float* ss2,
                                           float* xs, bf16_t* xg, const float* gnext, float* rstd1, unsigned char* hqbuf) {
    const int lane = C.lane, r = lane >> 3, p = lane & 7;
    LAS unsigned char* wl = C.lds + C.wave * PS_WAVE;
#pragma unroll 1
    for (int i = 0; i < 16; ++i) {
        const int m = C.gw + i * C.ngw;
        const int e0 = idx[(size_t)m * 128 + lane], e1 = idx[(size_t)m * 128 + 64 + lane];
        const int p0 = (lane & 7) * 16 + (lane >> 3), p1 = p0 + 8;
        *(LAS unsigned short*)(wl + PS_EID + i * 256 + p0 * 2) = (unsigned short)e0; *(LAS unsigned short*)(wl + PS_EID + i * 256 + p1 * 2) = (unsigned short)e1;
        ((LAS int*)(wl + PS_AC + i * 512))[lane] = 0; ((LAS int*)(wl + PS_AC + i * 512))[64 + lane] = 0;
        const float rs = pg8::row_rs(ss2, m);
        const u32x4 x0 = *((const u32x4*)(xg + (size_t)m * D) + 2 * lane), x1 = *((const u32x4*)(xg + (size_t)m * D) + 2 * lane + 1);
        const unsigned w[8] = {x0.x, x0.y, x0.z, x0.w, x1.x, x1.y, x1.z, x1.w};
        float hv[16]; float mxh = 0.f;
#pragma unroll
        for (int q = 0; q < 8; ++q) { hv[2 * q] = bflo(w[q]) * rs; hv[2 * q + 1] = bfhi(w[q]) * rs; mxh = fmaxf(mxh, fmaxf(fabsf(hv[2 * q]), fabsf(hv[2 * q + 1]))); }
        mxh = wave_max(mxh);
        const float sh = fmaxf(mxh, 1e-30f) * (1.0f / 119.0f), inv = 1.0f / sh;
        unsigned hh[4];
#pragma unroll
        for (int dd = 0; dd < 2; ++dd) { unsigned th = 0u, tl = 0u;
#pragma unroll
            for (int j = 0; j < 8; ++j) { const int q8 = (int)rintf(hv[8 * dd + j] * inv), hi = (q8 + 8) >> 4, lo = q8 - (hi << 4); th |= ((unsigned)hi & 15u) << (4 * j); tl |= ((unsigned)lo & 15u) << (4 * j); }
            hh[dd] = th; hh[2 + dd] = tl; }
        *((u32x4*)(hqbuf + (size_t)m * 1024) + lane) = (u32x4){hh[0], hh[1], hh[2], hh[3]};
        if (lane == 0) ((LAS float*)(wl + PS_SH))[i] = sh;
    }
    asm volatile("s_waitcnt vmcnt(0) lgkmcnt(0)" ::: "memory");
#pragma unroll 1
    for (int s = 0; s < 8; ++s) {
        const unsigned char* uslice = tabUs + (size_t)s * MiB;
        u32x2 rA[16], rB[16]; u32x4 hA, hB;
        ps_issue(wl, 0, uslice, r, p, rA); hA = *((const u32x4*)(hqbuf + (size_t)C.gw * 1024) + s * 8 + p);
#pragma unroll 1
        for (int i = 0; i < 16; i += 2) {
            ps_issue(wl, i + 1, uslice, r, p, rB); hB = *((const u32x4*)(hqbuf + (size_t)(C.gw + (i + 1) * C.ngw) * 1024) + s * 8 + p);
            ps_consume(wl, i, rA, hA, lane);
            if (i + 2 < 16) { ps_issue(wl, i + 2, uslice, r, p, rA); hA = *((const u32x4*)(hqbuf + (size_t)(C.gw + (i + 2) * C.ngw) * 1024) + s * 8 + p); }
            ps_consume(wl, i + 1, rB, hB, lane);
        }
    }
#pragma unroll 1
    for (int i = 0; i < 16; ++i) {
        const int m = C.gw + i * C.ngw; const float sh = ((LAS float*)(wl + PS_SH))[i];
#pragma unroll
        for (int hf = 0; hf < 2; ++hf) { const int pos = lane + 64 * hf, k = (pos & 15) * 8 + (pos >> 4);
            const int e = *(LAS unsigned short*)(wl + PS_EID + i * 256 + pos * 2); const int a = ((LAS int*)(wl + PS_AC + i * 512))[pos];
            const float g = gate[(size_t)m * 128 + k], su = scU[e], sv = scV[e];
            const float c = ABL_PEER ? 0.f : g * gelu_tanh((float)a * (su * sh)) * sv;
            ((LAS float*)(wl + PS_AC + i * 512))[pos] = c; }
    }
#pragma unroll 1
    for (int i = 0; i < 16; ++i) {
        const int m = C.gw + i * C.ngw;
        const int e0 = idx[(size_t)m * 128 + lane], e1 = idx[(size_t)m * 128 + 64 + lane];
        const int p0 = (lane & 7) * 16 + (lane >> 3);
        const float c0 = ((LAS float*)(wl + PS_AC + i * 512))[p0], c1 = ((LAS float*)(wl + PS_AC + i * 512))[p0 + 8];
        h2_t acc[8];
#pragma unroll
        for (int q = 0; q < 8; ++q) acc[q] = (h2_t){(_Float16)0.f, (_Float16)0.f};
        const unsigned cp0 = pkh2(c0, c0), cp1 = pkh2(c1, c1);
        u32x2 bA[8], bB[8];
        peer_load8_v(tabV, e0, e1, 0, lane, bA);
#pragma unroll 1
        for (int j = 0; j < 16; j += 2) {
            peer_load8_v(tabV, e0, e1, 8 * (j + 1), lane, bB); peer_fma8_v(bA, cp0, cp1, 8 * j, acc);
            if (j + 2 < 16) peer_load8_v(tabV, e0, e1, 8 * (j + 2), lane, bA);
            peer_fma8_v(bB, cp0, cp1, 8 * (j + 1), acc);
        }
        float* xr = xs + (size_t)m * D;
        f32x4 x[4];
#pragma unroll
        for (int j = 0; j < 4; ++j) x[j] = *((const f32x4*)xr + 4 * lane + j);
        float sq = 0.f;
#pragma unroll
        for (int j = 0; j < 4; ++j)
#pragma unroll
            for (int q = 0; q < 4; ++q) { x[j][q] += (float)acc[2 * j + (q >> 1)][q & 1]; sq += x[j][q] * x[j][q]; }
        sq = wave_sum(sq);
        const float rn = __builtin_amdgcn_rsqf(sq * (1.0f / D) + EPS);
        if (!(DRY && rn != 12345.678f)) {
        f32x4 gg[4];
#pragma unroll
        for (int j = 0; j < 4; ++j) gg[j] = *((const f32x4*)gnext + 4 * lane + j);
        if (LAST) {
#pragma unroll
            for (int j = 0; j < 4; ++j) *((f32x4*)xr + 4 * lane + j) = x[j] * gg[j] * rn;
        } else {
#pragma unroll
            for (int j = 0; j < 4; ++j) *((f32x4*)xr + 4 * lane + j) = x[j];
            u32x4 o0, o1; const f32x4 y0 = x[0] * gg[0], y1 = x[1] * gg[1], y2 = x[2] * gg[2], y3 = x[3] * gg[3];
            o0.x = pk2(y0[0], y0[1]); o0.y = pk2(y0[2], y0[3]); o0.z = pk2(y1[0], y1[1]); o0.w = pk2(y1[2], y1[3]);
            o1.x = pk2(y2[0], y2[1]); o1.y = pk2(y2[2], y2[3]); o1.z = pk2(y3[0], y3[1]); o1.w = pk2(y3[2], y3[3]);
            *((u32x4*)(xg + (size_t)m * D) + 2 * lane) = o0; *((u32x4*)(xg + (size_t)m * D) + 2 * lane + 1) = o1;
            if (GATE_F8) { u32x4 o8; o8.x = pk4_fp8(y0[0], y0[1], y0[2], y0[3]); o8.y = pk4_fp8(y1[0], y1[1], y1[2], y1[3]); o8.z = pk4_fp8(y2[0], y2[1], y2[2], y2[3]); o8.w = pk4_fp8(y3[0], y3[1], y3[2], y3[3]);
                *((u32x4*)((unsigned char*)xg + (WS_H8 - WS_E) + (size_t)m * D) + lane) = o8; }
            if (lane == 0) st_wt(rstd1 + m, rn);
        }
        }
    }
}

typedef int v8i_t __attribute__((ext_vector_type(8)));
constexpr int PM_WAVE = 2048, PM_H = 0, PM_A = 1024;
#define PM_MFMA8(ACC, UA, BF, SC) asm volatile("s_nop 4\n\t" \
    "v_mfma_scale_f32_16x16x128_f8f6f4 %0, %1, %9, %0, %17, %17 op_sel_hi:[0,0,0] cbsz:4\n\t" \
    "v_mfma_scale_f32_16x16x128_f8f6f4 %0, %2, %10, %0, %17, %17 op_sel_hi:[0,0,0] cbsz:4\n\t" \
    "v_mfma_scale_f32_16x16x128_f8f6f4 %0, %3, %11, %0, %17, %17 op_sel_hi:[0,0,0] cbsz:4\n\t" \
    "v_mfma_scale_f32_16x16x128_f8f6f4 %0, %4, %12, %0, %17, %17 op_sel_hi:[0,0,0] cbsz:4\n\t" \
    "v_mfma_scale_f32_16x16x128_f8f6f4 %0, %5, %13, %0, %17, %17 op_sel_hi:[0,0,0] cbsz:4\n\t" \
    "v_mfma_scale_f32_16x16x128_f8f6f4 %0, %6, %14, %0, %17, %17 op_sel_hi:[0,0,0] cbsz:4\n\t" \
    "v_mfma_scale_f32_16x16x128_f8f6f4 %0, %7, %15, %0, %17, %17 op_sel_hi:[0,0,0] cbsz:4\n\t" \
    "v_mfma_scale_f32_16x16x128_f8f6f4 %0, %8, %16, %0, %17, %17 op_sel_hi:[0,0,0] cbsz:4\n\t" \
    "s_nop 15\n\ts_nop 7" \
    : "+v"(ACC) : "v"(UA[0]), "v"(UA[1]), "v"(UA[2]), "v"(UA[3]), "v"(UA[4]), "v"(UA[5]), "v"(UA[6]), "v"(UA[7]), \
      "v"(BF[0]), "v"(BF[1]), "v"(BF[2]), "v"(BF[3]), "v"(BF[4]), "v"(BF[5]), "v"(BF[6]), "v"(BF[7]), "v"(SC))
struct TokM { int e0, e1; float g0, g1, su0, su1, sv0, sv1; int er[8]; };
__device__ __forceinline__ void tokm_idx(TokM& T, int m, const int* idx, const float* gate, int lane) {
    T.e0 = idx[(size_t)m * 128 + lane]; T.e1 = idx[(size_t)m * 128 + 64 + lane]; T.g0 = gate[(size_t)m * 128 + lane]; T.g1 = gate[(size_t)m * 128 + 64 + lane];
#pragma unroll
    for (int mb = 0; mb < 8; ++mb) T.er[mb] = idx[(size_t)m * 128 + 16 * mb + (lane & 15)];
}
__device__ __forceinline__ void tokm_scales(TokM& T, const float* scU, const float* scV) { T.su0 = scU[T.e0]; T.su1 = scU[T.e1]; T.sv0 = scV[T.e0]; T.sv1 = scV[T.e1]; }
__device__ __forceinline__ void pm_issue_u(const unsigned char* tab, int er, int quad, u32x4 (&ua)[8]) {
    const u32x4* bp = (const u32x4*)(tab + (size_t)er * 1024 + 16 * quad);
#pragma unroll
    for (int kb = 0; kb < 8; ++kb) ua[kb] = bp[4 * kb];
}
__device__ __forceinline__ void pm_issue_v(int grp, const unsigned char* tab, const TokM& T, int lane, u32x2 (&buf)[8]) {
#pragma unroll
    for (int e = 0; e < 8; ++e) { const int k = 8 * grp + e; const int ex = __builtin_amdgcn_readlane(k < 64 ? T.e0 : T.e1, k & 63);
        buf[e] = *((const u32x2*)(tab + (size_t)ex * 1024 + 512) + lane); }
}
__device__ __forceinline__ void pm_fma_v(const u32x2 (&buf)[8], unsigned cp0, unsigned cp1, int grp, h2_t (&acc)[8]) {
#pragma unroll
    for (int e = 0; e < 8; ++e) { const int k = 8 * grp + e; const h2_t ck = as_h2((unsigned)__builtin_amdgcn_readlane((int)(k < 64 ? cp0 : cp1), k & 63));
        const unsigned w4[2] = {buf[e].x, buf[e].y};
#pragma unroll
        for (int dd = 0; dd < 2; ++dd) {
#pragma unroll
            for (int sl = 0; sl < 4; ++sl) { h2_t pv;
                if (sl == 0) pv = __builtin_amdgcn_cvt_scalef32_pk_f16_fp4(w4[dd], 1.0f, 0); else if (sl == 1) pv = __builtin_amdgcn_cvt_scalef32_pk_f16_fp4(w4[dd], 1.0f, 1);
                else if (sl == 2) pv = __builtin_amdgcn_cvt_scalef32_pk_f16_fp4(w4[dd], 1.0f, 2); else pv = __builtin_amdgcn_cvt_scalef32_pk_f16_fp4(w4[dd], 1.0f, 3);
                acc[4 * dd + sl] = __builtin_elementwise_fma(pv, ck, acc[4 * dd + sl]); } } }
}
template <bool LAST, bool DRY = false>
__device__ __forceinline__ void peer_tokens_mf(const Ctx& C, int m0, int step, const unsigned char* tab, const float* scU, const float* scV, const int* idx, const float* gate, const float* ss2,
                                               float* xs, bf16_t* xg, const float* gnext, float* rstd1) {
    const int lane = C.lane, n16 = lane & 15, quad = lane >> 4;
    if (m0 >= M) return;
    LAS unsigned char* wl = C.lds + C.wave * PM_WAVE;
    TokM T, Tn;
    tokm_idx(T, m0, idx, gate, lane); tokm_scales(T, scU, scV);
    unsigned e8m0_one = 0x7F7F7F7Fu; asm volatile("" : "+v"(e8m0_one));
    for (int m = m0; m < M; m += step) {
        const int mn = m + step; const bool has_next = mn < M;
        u32x4 uA[8], uB[8];
        pm_issue_u(tab, T.er[0], quad, uA);
        if (has_next) tokm_idx(Tn, mn, idx, gate, lane);
        const float rs = pg8::row_rs(ss2, m);
        float sh;
        { const u32x4 x0 = *((const u32x4*)(xg + (size_t)m * D) + 2 * lane), x1 = *((const u32x4*)(xg + (size_t)m * D) + 2 * lane + 1);
          const unsigned w[8] = {x0.x, x0.y, x0.z, x0.w, x1.x, x1.y, x1.z, x1.w};
          float hv[16]; float mxh = 0.f;
#pragma unroll
          for (int q = 0; q < 8; ++q) { hv[2 * q] = bflo(w[q]) * rs; hv[2 * q + 1] = bfhi(w[q]) * rs; mxh = fmaxf(mxh, fmaxf(fabsf(hv[2 * q]), fabsf(hv[2 * q + 1]))); }
          mxh = wave_max(mxh);
          sh = fmaxf(mxh, 1e-30f) * (1.0f / 240.0f); const float inv = 1.0f / sh;
          unsigned hb[4];
#pragma unroll
          for (int q = 0; q < 4; ++q) { unsigned t = __builtin_amdgcn_cvt_pk_fp8_f32(hv[4 * q] * inv, hv[4 * q + 1] * inv, 0u, false); hb[q] = __builtin_amdgcn_cvt_pk_fp8_f32(hv[4 * q + 2] * inv, hv[4 * q + 3] * inv, t, true); }
          *(LAS u32x4*)(wl + PM_H + 16 * lane) = (u32x4){hb[0], hb[1], hb[2], hb[3]}; }
        v8i_t bfr[8];
#pragma unroll
        for (int kb = 0; kb < 8; ++kb) { const u32x4 b0 = *(const LAS u32x4*)(wl + PM_H + 128 * kb + 16 * quad), b1 = *(const LAS u32x4*)(wl + PM_H + 128 * kb + 64 + 16 * quad);
            bfr[kb] = (v8i_t){(int)b0.x, (int)b0.y, (int)b0.z, (int)b0.w, (int)b1.x, (int)b1.y, (int)b1.z, (int)b1.w}; }
#pragma unroll
        for (int mb = 0; mb < 8; ++mb) {
            if (mb + 1 < 8) { if (mb & 1) pm_issue_u(tab, T.er[mb + 1], quad, uA); else pm_issue_u(tab, T.er[mb + 1], quad, uB); }
            f32x4 acc = {0.f, 0.f, 0.f, 0.f};
            if (mb & 1) PM_MFMA8(acc, uB, bfr, e8m0_one); else PM_MFMA8(acc, uA, bfr, e8m0_one);
            *(LAS f32x4*)(wl + PM_A + (16 * mb + 4 * quad) * 4) = acc;
        }
        const float a0 = ((const LAS float*)(wl + PM_A))[lane], a1 = ((const LAS float*)(wl + PM_A))[64 + lane];
        const float c0 = ABL_PEER ? 0.f : T.g0 * gelu_tanh(a0 * (T.su0 * sh)) * T.sv0, c1 = ABL_PEER ? 0.f : T.g1 * gelu_tanh(a1 * (T.su1 * sh)) * T.sv1;
        const unsigned cp0 = pkh2(c0, c0), cp1 = pkh2(c1, c1);
        if (has_next) tokm_scales(Tn, scU, scV);
        h2_t acc[8];
#pragma unroll
        for (int i = 0; i < 8; ++i) acc[i] = (h2_t){(_Float16)0.f, (_Float16)0.f};
        u32x2 vA[8], vB[8];
        pm_issue_v(0, tab, T, lane, vA);
#pragma unroll 1
        for (int j = 0; j < 16; j += 2) {
            pm_issue_v(j + 1, tab, T, lane, vB); pm_fma_v(vA, cp0, cp1, j, acc);
            if (j + 2 < 16) pm_issue_v(j + 2, tab, T, lane, vA);
            pm_fma_v(vB, cp0, cp1, j + 1, acc);
        }
        float* xr = xs + (size_t)m * D;
        f32x4 x[4];
#pragma unroll
        for (int j = 0; j < 4; ++j) x[j] = *((const f32x4*)xr + 4 * lane + j);
        float sq = 0.f;
#pragma unroll
        for (int j = 0; j < 4; ++j)
#pragma unroll
            for (int i = 0; i < 4; ++i) { x[j][i] += (float)acc[2 * j + (i >> 1)][i & 1]; sq += x[j][i] * x[j][i]; }
        sq = wave_sum(sq);
        const float rn = __builtin_amdgcn_rsqf(sq * (1.0f / D) + EPS);
        if (!(DRY && rn != 12345.678f)) {
        f32x4 gg[4];
#pragma unroll
        for (int j = 0; j < 4; ++j) gg[j] = *((const f32x4*)gnext + 4 * lane + j);
        if (LAST) {
#pragma unroll
            for (int j = 0; j < 4; ++j) *((f32x4*)xr + 4 * lane + j) = x[j] * gg[j] * rn;
        } else {
#pragma unroll
            for (int j = 0; j < 4; ++j) *((f32x4*)xr + 4 * lane + j) = x[j];
            u32x4 o0, o1; const f32x4 y0 = x[0] * gg[0], y1 = x[1] * gg[1], y2 = x[2] * gg[2], y3 = x[3] * gg[3];
            o0.x = pk2(y0[0], y0[1]); o0.y = pk2(y0[2], y0[3]); o0.z = pk2(y1[0], y1[1]); o0.w = pk2(y1[2], y1[3]);
            o1.x = pk2(y2[0], y2[1]); o1.y = pk2(y2[2], y2[3]); o1.z = pk2(y3[0], y3[1]); o1.w = pk2(y3[2], y3[3]);
            *((u32x4*)(xg + (size_t)m * D) + 2 * lane) = o0; *((u32x4*)(xg + (size_t)m * D) + 2 * lane + 1) = o1;
            if (GATE_F8) { u32x4 o8; o8.x = pk4_fp8(y0[0], y0[1], y0[2], y0[3]); o8.y = pk4_fp8(y1[0], y1[1], y1[2], y1[3]); o8.z = pk4_fp8(y2[0], y2[1], y2[2], y2[3]); o8.w = pk4_fp8(y3[0], y3[1], y3[2], y3[3]);
                *((u32x4*)((unsigned char*)xg + (WS_H8 - WS_E) + (size_t)m * D) + lane) = o8; }
            if (lane == 0) st_wt(rstd1 + m, rn);
        }
        }
        T = Tn;
    }
}
typedef __attribute__((address_space(1))) unsigned gu32;
#define XB_TMO      128
#define XB_XCNT(j)  (256  + 64 * (j))
#define XB_XSUB(j)  (1280 + 64 * (j))
#define XB_XGEN(j)  (2304 + 64 * (j))
#define XB_TOP      3328
#define XB_TOPGEN   3392
#define XCD_BAR_WORDS 3456
#define XB_SPIN_CAP (1u << 18)

__device__ __forceinline__ unsigned xb_ld(unsigned* p)              { return __hip_atomic_load(p, __ATOMIC_RELAXED, __HIP_MEMORY_SCOPE_AGENT); }
__device__ __forceinline__ unsigned xb_add(unsigned* p, unsigned v) { return __hip_atomic_fetch_add(p, v, __ATOMIC_RELAXED, __HIP_MEMORY_SCOPE_AGENT); }
__device__ __forceinline__ unsigned xb_xcc_id() { return (unsigned)__builtin_amdgcn_s_getreg((3 << 11) | 20) & 0xFu; }
#define XB_SPIN(cond, bar) do { unsigned _sp = 0; while (cond) { __builtin_amdgcn_s_sleep(1); \
    if ((++_sp & 255u) == 0u) { if (xb_ld(&(bar)[XB_TMO])) break; if (_sp > XB_SPIN_CAP) { atomicAdd(&(bar)[XB_TMO], 1u); break; } } } } while (0)

struct XcdBarrier {
    unsigned* bar; unsigned x;
    volatile LAS unsigned* st;
};

__device__ __forceinline__ XcdBarrier xcd_barrier_post(unsigned* bar, volatile LAS unsigned* st) {
    XcdBarrier b; b.bar = bar; b.x = xb_xcc_id(); b.st = st;
    if (threadIdx.x == 0) (void)xb_add(&bar[XB_XCNT(b.x)], 1u);
    return b;
}
__device__ __forceinline__ void xcd_barrier_complete(unsigned* bar, unsigned x, unsigned& nloc, unsigned& nx) {
    const unsigned G = gridDim.x * gridDim.y * gridDim.z;
    unsigned sum, cnt, mine, sp = 0u;
    for (;;) {
        sum = 0u; cnt = 0u; mine = 0u;
#pragma unroll
        for (unsigned j = 0; j < 16; ++j) { const unsigned c = xb_ld(&bar[XB_XCNT(j)]); sum += c; cnt += (c > 0u) ? 1u : 0u; mine = (j == x) ? c : mine; }
        if (sum == G) break;
        __builtin_amdgcn_s_sleep(1);
        if ((++sp & 255u) == 0u) { if (xb_ld(&bar[XB_TMO])) break; if (sp > XB_SPIN_CAP) { atomicAdd(&bar[XB_TMO], 1u); break; } }
    }
    nloc = mine > 0u ? mine : 1u; nx = cnt > 0u ? cnt : 1u;
}

template <bool FIRST>
__device__ __forceinline__ void xcd_barrier(unsigned* bar_, volatile LAS unsigned* st_, int tid0) {
    XcdBarrier b; b.bar = bar_; b.x = xb_xcc_id(); b.st = st_;
    asm volatile("s_waitcnt vmcnt(0)" ::: "memory");
#if XB_SAFE == 8
    __builtin_amdgcn_fence(__ATOMIC_RELEASE, "agent");
    asm volatile("s_waitcnt vmcnt(0)" ::: "memory");
#endif
    __syncthreads();
    if (tid0 == 0) {
        unsigned* bar = b.bar;
        __builtin_amdgcn_s_waitcnt(0);
#if XB_SAFE == 4
        __builtin_amdgcn_fence(__ATOMIC_RELEASE, "");
        asm volatile("s_waitcnt vmcnt(0)" ::: "memory");
#endif
#if XB_SAFE == 1 || XB_SAFE == 2 || XB_SAFE == 5 || XB_SAFE == 8
        __builtin_amdgcn_fence(__ATOMIC_RELEASE, "agent");
        asm volatile("s_waitcnt vmcnt(0)" ::: "memory");
#endif
        unsigned nloc = b.st[0], nx = b.st[1];
        if constexpr (FIRST) { xcd_barrier_complete(bar, b.x, nloc, nx); b.st[0] = nloc; b.st[1] = nx; }
        const unsigned old = xb_add(&bar[XB_XSUB(b.x)], 1u);
        const unsigned gen = old / nloc;
        if (old + 1u == (gen + 1u) * nloc) {
            __builtin_amdgcn_fence(__ATOMIC_RELEASE, "agent");
            asm volatile("s_waitcnt vmcnt(0)" ::: "memory");
            const unsigned og = xb_add(&bar[XB_TOP], 1u);
            const unsigned tg = og / nx;
            if (og + 1u == (tg + 1u) * nx) xb_add(&bar[XB_TOPGEN], 1u);
            else XB_SPIN(xb_ld(&bar[XB_TOPGEN]) == tg, bar);
#if XB_SAFE == 4 || XB_SAFE == 5 || XB_SAFE == 6 || XB_SAFE == 8
            __builtin_amdgcn_fence(__ATOMIC_ACQUIRE, "");
#endif
            __builtin_amdgcn_fence(__ATOMIC_ACQUIRE, "agent");
            xb_add(&bar[XB_XGEN(b.x)], 1u);
            asm volatile("s_waitcnt vmcnt(0)" ::: "memory");
        } else {
            XB_SPIN(xb_ld(&bar[XB_XGEN(b.x)]) == gen, bar);
#if XB_SAFE == 4
            __builtin_amdgcn_fence(__ATOMIC_ACQUIRE, "");
#endif
            __builtin_amdgcn_fence(__ATOMIC_ACQUIRE, "agent");
            asm volatile("s_waitcnt vmcnt(0)" ::: "memory");
        }
    }
    __syncthreads();
#if XB_SAFE == 1 || XB_SAFE == 3
    __builtin_amdgcn_fence(__ATOMIC_ACQUIRE, "agent");
    asm volatile("s_waitcnt vmcnt(0)" ::: "memory");
    __syncthreads();
#endif
}

constexpr int LDS_BYTES = 147456;
#ifndef MK_SYNC_CG
#define MK_SYNC_CG 1
#endif

__device__ __forceinline__ int lane_now() { int l; asm volatile("v_mbcnt_lo_u32_b32 %0, -1, 0\n\tv_mbcnt_hi_u32_b32 %0, -1, %0" : "=v"(l)); return l; }
__device__ __forceinline__ Ctx make_ctx(LAS unsigned char* lds, int tidx) {
    Ctx C; int tid = tidx; asm volatile("" : "+v"(tid));
    C.tid = tid; C.lane = tid & 63; C.wave = __builtin_amdgcn_readfirstlane(tid >> 6); C.G = gridDim.x; C.bid = blockIdx.x;
    C.gw = C.bid * NWAVES + C.wave; C.ngw = C.G * NWAVES; C.gt = C.bid * NTHREADS + tid; C.ngt = C.G * NTHREADS; C.lds = lds;
    return C;
}
template <class Epi, bool F8 = false>
__device__ __forceinline__ void run_gemm(const Ctx& C, const bf16_t* A, int lda, const bf16_t* Bt, int ldb, int N, int K, const Epi& E) {
    pg8::Gemm g{A, Bt, M, N, K, lda, ldb}; pg8::StaticOrder S; S.init(M, N, C.G, C.bid);
    pg8::gemm_phase<Epi, pg8::StaticOrder, true, true, F8>(C.lds, g, S, E, C.tid);
}

__device__ __forceinline__ const void* karg(int i) {
    const __attribute__((address_space(4))) unsigned long long* ka = (const __attribute__((address_space(4))) unsigned long long*)__builtin_amdgcn_kernarg_segment_ptr();
    int z = 0; asm volatile("" : "+s"(z));
    return (const void*)(const __attribute__((address_space(1))) void*)ka[i + z];
}
#define KWS() ((unsigned char*)karg(27))
#define KIN(i) ((const float*)karg(i))


#if PEER_SLICED
#define PEER_CALL(LAST_, DRY_) PEER_CALL_S_<LAST_, DRY_>
template <bool LAST, bool DRY>
__device__ __forceinline__ void PEER_CALL_S_(const Ctx& C, unsigned char* ws, const unsigned char* tab, const float* scU, const float* scV, const int* idx, const float* gate, const float* ssp, float* xs, bf16_t* xg, const float* gn, float* rstd1) {
    peer_sweep<LAST, DRY>(C, tab, tab + 16 * MiB, scU, scV, idx, gate, ssp, xs, xg, gn, rstd1, ws + WS_HQ);
}
#else
#define PEER_CALL(LAST_, DRY_) PEER_CALL_T_<LAST_, DRY_>
template <bool LAST, bool DRY>
__device__ __forceinline__ void PEER_CALL_T_(const Ctx& C, unsigned char* ws, const unsigned char* tab, const float* scU, const float* scV, const int* idx, const float* gate, const float* ssp, float* xs, bf16_t* xg, const float* gn, float* rstd1, const float* g2 = nullptr, bf16_t* xo = nullptr) {
#if PEER_MFMA
    peer_tokens_mf<LAST, DRY>(C, C.gw, C.ngw, tab, scU, scV, idx, gate, ssp, xs, xg, gn, rstd1);
#else
    peer_tokens<LAST, DRY>(C, C.gw, C.ngw, tab, scU, scV, idx, gate, ssp, xs, xg, gn, rstd1, g2, xo, ws + WS_H8);
#endif
}
#endif
#ifndef XB16_INPLACE
#define XB16_INPLACE 1
#endif

#ifndef DBG_WHAT
#define DBG_WHAT 0
#endif
#define DBG_DUMP_RET() do { const Ctx C = MKCTX(); unsigned char* ws = KWS(); float* o = (float*)karg(26); \
    for (size_t i = C.gt; i < (size_t)M * D; i += C.ngt) { const size_t m = i >> 10; const int c = (int)(i & 1023); float v; \
      if (DBG_WHAT == 0) v = bflo((unsigned)((const bf16_t*)(ws + WS_E))[i]); else if (DBG_WHAT == 2) v = bflo((unsigned)((const bf16_t*)(ws + WS_F))[i]); else if (DBG_WHAT == 3) v = bflo((unsigned)((const bf16_t*)(ws + WS_C))[i]); \
      else if (DBG_WHAT == 5) v = bflo((unsigned)((const bf16_t*)(ws + WS_D))[m * QKVW + c]) + 2.0f * bflo((unsigned)((const bf16_t*)(ws + WS_D))[m * QKVW + 1024 + c]); \
      else v = bflo((unsigned)((const bf16_t*)(ws + WS_D))[m * PQ + c]) + 3.0f * bflo((unsigned)((const bf16_t*)(ws + WS_D))[m * PQ + 1024 + c]); \
      o[i] = v; } return; } while (0)
#ifndef DBG_STOP
#define DBG_STOP 0
#endif
#ifndef DBG_LAYER
#define DBG_LAYER 1
#endif
#ifndef DUP_PHASE
#define DUP_PHASE 0
#endif
#ifndef STAG_P1
#define STAG_P1 0
#endif
#ifndef STAG_P5
#define STAG_P5 0
#endif
#ifndef STAG_P6
#define STAG_P6 0
#endif
#ifndef STAG_P7
#define STAG_P7 0
#endif
__device__ __forceinline__ void stagger(unsigned ticks) {
    if (ticks != 0u && blockIdx.x >= 128u) { const unsigned long long t0 = (unsigned long long)wall_clock64(); while ((unsigned long long)wall_clock64() - t0 < ticks) __builtin_amdgcn_s_sleep(16); }
}
#ifndef DUP_LAYER
#define DUP_LAYER -1
#endif
__global__ void __launch_bounds__(NTHREADS, 2) mk_fwd(Args args) {
    extern __shared__ __attribute__((aligned(16))) unsigned char lds_raw[];
    cg::grid_group grid = cg::this_grid();
    const int wid0 = __builtin_amdgcn_readfirstlane((int)threadIdx.x >> 6);
#define TIDX() ((wid0 << 6) | lane_now())
#define MKCTX() make_ctx((LAS unsigned char*)lds_raw, TIDX())
    volatile LAS unsigned* bst = (volatile LAS unsigned*)((LAS unsigned char*)lds_raw + 131072 + 64);
    if (threadIdx.x < 2) bst[threadIdx.x] = 0u;
    __syncthreads();
    (void)xcd_barrier_post((unsigned*)(args.ws + WS_CTL) + 4096, bst);
#define GRID_SYNC() xcd_barrier<false>((unsigned*)(KWS() + WS_CTL) + 4096, (volatile LAS unsigned*)((LAS unsigned char*)lds_raw + 131072 + 64), TIDX())
#define GRID_SYNC_FIRST() xcd_barrier<true>((unsigned*)(KWS() + WS_CTL) + 4096, (volatile LAS unsigned*)((LAS unsigned char*)lds_raw + 131072 + 64), TIDX())
#define GRID_SYNC_CG() do { asm volatile("s_waitcnt vmcnt(0)" ::: "memory"); grid.sync(); if (threadIdx.x == 0) { __builtin_amdgcn_fence(__ATOMIC_ACQUIRE, ""); asm volatile("s_waitcnt vmcnt(0)" ::: "memory"); } __syncthreads(); } while (0)

    for (int rep_ = 0; rep_ < (DUP_PHASE == 10 ? 2 : 1); ++rep_) { const Ctx C = MKCTX(); phase_prologue(C, args); }
#if XB16 && OUT_PREFILL == 1
    { const Ctx C = MKCTX(); f32x4* o = (f32x4*)karg(26); for (size_t i = C.gt; i < (size_t)M * D / 4; i += C.ngt) o[i] = (f32x4){3.0f, 3.0f, 3.0f, 3.0f}; }
#endif
    if (gridDim.y == 0x7fffffffu) GRID_SYNC_CG();
    GRID_SYNC_FIRST();

    if (DUP_PHASE == 11) { for (int rep_ = 0; rep_ < 10; ++rep_) GRID_SYNC(); }
    for (int l = 0; l < DEPTH; ++l) {
#define WL(ws) ((ws) + WS_W + (size_t)l * W_LAYER)
#if XB16 && !XB16_INPLACE
        static_assert(DEPTH == 2, "residual buffer rotation is written for two layers");
#define XA_(ws) (l == 0 ? (bf16_t*)((ws) + WS_E) : (bf16_t*)((unsigned char*)karg(26) + 64 * MiB))
#define X1_(ws) (l == 0 ? (bf16_t*)karg(26) : (bf16_t*)((ws) + WS_E))
#define X2_(ws) ((bf16_t*)((unsigned char*)karg(26) + 64 * MiB))
#else
#define XA_(ws) ((bf16_t*)((ws) + WS_E))
#define X1_(ws) ((bf16_t*)((ws) + WS_E))
#define X2_(ws) ((bf16_t*)((ws) + WS_E))
#endif
        const size_t o_rstd = l == 0 ? WS_RSTD1 : WS_L1, o_lse = l == 0 ? WS_LSE : WS_L1 + 1 * MiB, o_send = l == 0 ? WS_SEND : WS_L1 + 3 * MiB, o_ssp = l == 0 ? WS_SSP : WS_L1 + 5 * MiB;
        const size_t o_rstd_next = WS_L1;
        for (int rep_ = 0; rep_ < ((DUP_PHASE == 1 && (DUP_LAYER < 0 || DUP_LAYER == l)) ? 2 : 1); ++rep_) {
        stagger(STAG_P1);
        { const Ctx C = MKCTX(); unsigned char* ws = KWS(); pg8::EpiZ E{(bf16_t*)(ws + WS_C), (bf16_t*)(ws + WS_D), (const float*)(ws + o_rstd)};
          run_gemm(C, (const bf16_t*)XA_(ws), D, (const bf16_t*)(WL(ws) + WO_WIN), D, NZ, D, E);
#if TABQ_DEFER
          static_assert(DEPTH == 2, "deferred table conversion is written for two layers");
          if (C.G == 256 && C.bid >= 128) { const int iw = (C.bid - 128) * NWAVES + C.wave;
              quant_rows(KIN(I_PU) + (size_t)NEXP * D, KIN(I_PV) + (size_t)NEXP * D, ws + WS_TAB + TAB_LAYER, (float*)(ws + WS_TSC + 131072), (float*)(ws + WS_TSC + 131072 + 65536), (NEXP / 2) * l + iw, (NEXP / 2) * (l + 1), 1024, C.lane);
 }
#endif
        }
        GRID_SYNC();
        }
#if DBG_STOP >= 11 && DBG_STOP <= 18
        if (DBG_STOP == 10 + 1 && l == DBG_LAYER) DBG_DUMP_RET();
#endif
        for (int rep_ = 0; rep_ < ((DUP_PHASE == 2 && (DUP_LAYER < 0 || DUP_LAYER == l)) ? 2 : 1); ++rep_) {
        for (int r2_ = 0; r2_ < (DUP_PHASE == 21 ? 2 : 1); ++r2_)
        { const Ctx C = MKCTX(); unsigned char* ws = KWS();
          attn_items(C, (const bf16_t*)(ws + WS_D), ROPE_FLY ? (const f32x2*)KIN(I_POS) : (const f32x2*)(ws + WS_ROPE), (bf16_t*)(ws + WS_F), (float*)(ws + o_lse)); }
        for (int r2_ = 0; r2_ < (DUP_PHASE == 22 ? 2 : 1); ++r2_)
        { const Ctx C = MKCTX(); unsigned char* ws = KWS();
          for (int it = C.gw; it < BATCH * NCH * SSM_G; it += C.ngw) ssm_item<false>(C, it, (const bf16_t*)(ws + WS_C), ws + WS_SSMC + (size_t)l * SSMC_LAYER, (f32x2*)(ws + o_send), nullptr, nullptr, nullptr, nullptr); }
        GRID_SYNC();
        }
#if DBG_STOP >= 11 && DBG_STOP <= 18
        if (DBG_STOP == 10 + 2 && l == DBG_LAYER) DBG_DUMP_RET();
#endif
        for (int rep_ = 0; rep_ < ((DUP_PHASE == 3 && (DUP_LAYER < 0 || DUP_LAYER == l)) ? 2 : 1); ++rep_) {
        for (int r2_ = 0; r2_ < (DUP_PHASE == 31 ? 2 : 1); ++r2_)
        { const Ctx C = MKCTX(); unsigned char* ws = KWS();
          const float* cre = KIN(I_CRE) + (size_t)l * SSM_G * SSM_P * SSM_N; const float* cim = KIN(I_CIM) + (size_t)l * SSM_G * SSM_P * SSM_N; const float* dsk = KIN(I_SD) + (size_t)l * SSMW;
          for (int it = C.gw; it < BATCH * NCH * SSM_G; it += C.ngw)
              ssm_item<true>(C, it, (const bf16_t*)(ws + WS_C), ws + WS_SSMC + (size_t)l * SSMC_LAYER, (f32x2*)(ws + o_send), cre, cim, dsk, (bf16_t*)(ws + WS_D + 32 * MiB)); }
        for (int r2_ = 0; r2_ < (DUP_PHASE == 32 ? 2 : 1); ++r2_)
        { const Ctx C = MKCTX(); unsigned char* ws = KWS();
          pool_items(C, (const bf16_t*)(ws + WS_C), (bf16_t*)(ws + WS_D));
          attn_merge_items(C, (const bf16_t*)(ws + WS_F), (const float*)(ws + o_lse), (bf16_t*)(ws + WS_D + 64 * MiB));
          }
        GRID_SYNC();
        }
#if DBG_STOP >= 11 && DBG_STOP <= 18
        if (DBG_STOP == 10 + 3 && l == DBG_LAYER) DBG_DUMP_RET();
#endif
        for (int rep_ = 0; rep_ < ((DUP_PHASE == 4 && (DUP_LAYER < 0 || DUP_LAYER == l)) ? 2 : 1); ++rep_) {
        { const Ctx C = MKCTX(); unsigned char* ws = KWS(); pg8::EpiPlain E{(bf16_t*)(ws + WS_C), POOLW, nullptr};
          run_gemm(C, (const bf16_t*)(ws + WS_D), POOLW, (const bf16_t*)(WL(ws) + WO_POOL), POOLW, POOLW, POOLW, E); }
        { const Ctx C = MKCTX(); unsigned char* ws = KWS(); pg8::EpiGlu E{(bf16_t*)(ws + WS_C + 32 * MiB)};
          run_gemm(C, (const bf16_t*)(ws + WS_D + 32 * MiB), SSMW, (const bf16_t*)(WL(ws) + WO_GLU), SSMW, 2 * SSMW, SSMW, E); }
        GRID_SYNC();
        }
#if DBG_STOP >= 11 && DBG_STOP <= 18
        if (DBG_STOP == 10 + 4 && l == DBG_LAYER) DBG_DUMP_RET();
#endif
        for (int rep_ = 0; rep_ < ((DUP_PHASE == 5 && (DUP_LAYER < 0 || DUP_LAYER == l)) ? 2 : 1); ++rep_) {
#if GATE_F8
#define GATE_GEMM(b) { const Ctx C = MKCTX(); unsigned char* ws = KWS(); pg8::EpiGate E{(bf16_t*)(ws + WS_D + 80 * MiB), (const float*)(ws + o_rstd), 1.0f / GATE_WSC}; \
          run_gemm<pg8::EpiGate, true>(C, (const bf16_t*)(ws + WS_H8), D / 2, (const bf16_t*)(WL(ws) + WO_WIN + (size_t)NZ * D * 2 + (size_t)(b) * D * D), D / 2, D, D / 2, E); }
#else
#define GATE_GEMM(b) { const Ctx C = MKCTX(); unsigned char* ws = KWS(); pg8::EpiGate E{(bf16_t*)(ws + WS_D + 80 * MiB), (const float*)(ws + o_rstd), 1.0f}; \
          run_gemm(C, (const bf16_t*)XA_(ws), D, (const bf16_t*)(WL(ws) + WO_WIN) + (size_t)(NZ + (b) * D) * D, D, D, D, E); }
#endif
        stagger(STAG_P5);
        GATE_GEMM(0)
        { const Ctx C = MKCTX(); unsigned char* ws = KWS(); pg8::EpiMerge<true> E{(const bf16_t*)(ws + WS_D + 80 * MiB), (bf16_t*)(ws + WS_F), ABL_POOL ? 0.f : (S_U8 ? 1.0f / 255.0f : 1.f)};
          run_gemm(C, (const bf16_t*)(ws + WS_C), POOLW, (const bf16_t*)(WL(ws) + WO_PPROJ), POOLW, D, POOLW, E); }
        GATE_GEMM(1)
        { const Ctx C = MKCTX(); unsigned char* ws = KWS(); pg8::EpiMerge<false> E{(const bf16_t*)(ws + WS_D + 80 * MiB), (bf16_t*)(ws + WS_F), ABL_SSM ? 0.f : (S_U8 ? 1.0f / 255.0f : 1.f)};
          run_gemm(C, (const bf16_t*)(ws + WS_C + 32 * MiB), SSMW, (const bf16_t*)(WL(ws) + WO_SPROJ), SSMW, D, SSMW, E); }
        GATE_GEMM(2)
        { const Ctx C = MKCTX(); unsigned char* ws = KWS(); pg8::EpiMerge<false> E{(const bf16_t*)(ws + WS_D + 80 * MiB), (bf16_t*)(ws + WS_F), ABL_ATTN ? 0.f : (S_U8 ? 1.0f / 255.0f : 1.f)};
          run_gemm(C, (const bf16_t*)(ws + WS_D + 64 * MiB), AOUT, (const bf16_t*)(WL(ws) + WO_APROJ), AOUT, D, AOUT, E); }
        GRID_SYNC();
        }
#if DBG_STOP >= 11 && DBG_STOP <= 18
        if (DBG_STOP == 10 + 5 && l == DBG_LAYER) DBG_DUMP_RET();
#endif
        for (int rep_ = 0; rep_ < ((DUP_PHASE == 6 && (DUP_LAYER < 0 || DUP_LAYER == l)) ? 2 : 1); ++rep_) {
        stagger(STAG_P6);
        { const Ctx C = MKCTX(); unsigned char* ws = KWS(); float* xs = (float*)karg(26);
#if XB16
          pg8::EpiOut E{(const bf16_t*)XA_(ws), X1_(ws), (float*)(ws + o_ssp), ws + WS_H8};
#else
          pg8::EpiOut E{l == 0 ? KIN(I_X) : (const float*)xs, xs, (bf16_t*)(ws + WS_E), KIN(I_N2G) + (size_t)l * D, (float*)(ws + o_ssp), ws + WS_H8};
#endif
          run_gemm(C, (const bf16_t*)(ws + WS_F), D, (const bf16_t*)(WL(ws) + WO_WOUT), D, D, D, E); }
        GRID_SYNC();
        }
#if DBG_STOP >= 11 && DBG_STOP <= 18
        if (DBG_STOP == 10 + 6 && l == DBG_LAYER) DBG_DUMP_RET();
#endif
        for (int rep_ = 0; rep_ < ((DUP_PHASE == 7 && (DUP_LAYER < 0 || DUP_LAYER == l)) ? 2 : 1); ++rep_) {
        stagger(STAG_P7);
#if Q_F8
        { const Ctx C = MKCTX(); unsigned char* ws = KWS(); pg8::EpiPlain E{(bf16_t*)(ws + WS_D), PQ, (const float*)(ws + o_ssp), 1.0f / GATE_WSC};
          run_gemm<pg8::EpiPlain, true>(C, (const bf16_t*)(ws + WS_H8), D / 2, (const bf16_t*)(WL(ws) + WO_WQ), D / 2, PQ, D / 2, E); }
#else
        { const Ctx C = MKCTX(); unsigned char* ws = KWS(); pg8::EpiPlain E{(bf16_t*)(ws + WS_D), PQ, (const float*)(ws + o_ssp)};
          run_gemm(C, (const bf16_t*)X1_(ws), D, (const bf16_t*)(WL(ws) + WO_WQ), D, PQ, D, E); }
#endif
#if FUSE78
        { const Ctx C = MKCTX(); unsigned char* ws = KWS();
          asm volatile("s_waitcnt vmcnt(0)" ::: "memory"); __syncthreads();
          topk_stage_keys(C, (const bf16_t*)(WL(ws) + WO_K1), (const bf16_t*)(WL(ws) + WO_K2));
          __syncthreads();
          pg8::StaticOrder S; S.init(M, PQ, C.G, C.bid);
          topk_own_items(C, S, (const bf16_t*)(ws + WS_D), (int*)(ws + WS_C), (float*)(ws + WS_C + 16 * MiB)); }
#endif
        GRID_SYNC();
        }
#if DBG_STOP >= 11 && DBG_STOP <= 18
        if (DBG_STOP == 10 + 7 && l == DBG_LAYER) DBG_DUMP_RET();
#endif
#if !FUSE78
        for (int rep_ = 0; rep_ < ((DUP_PHASE == 8 && (DUP_LAYER < 0 || DUP_LAYER == l)) ? 2 : 1); ++rep_) {
        { const Ctx C = MKCTX(); unsigned char* ws = KWS();
          topk_stage_keys(C, (const bf16_t*)(WL(ws) + WO_K1), (const bf16_t*)(WL(ws) + WO_K2));
          __syncthreads();
          topk_items(C, (const bf16_t*)(ws + WS_D), (int*)(ws + WS_C), (float*)(ws + WS_C + 16 * MiB)); }
        GRID_SYNC();
        }
#endif
#if DBG_STOP >= 11 && DBG_STOP <= 18
        if (DBG_STOP == 10 + 8 && l == DBG_LAYER) DBG_DUMP_RET();
#endif
#if DBG_STOP == 28 || DBG_STOP == 27
        if (l == DBG_LAYER) { const Ctx C = MKCTX(); unsigned char* ws = KWS(); float* o = (float*)karg(26);
          if (DBG_STOP == 28) { const int* pi = (const int*)(ws + WS_C); for (size_t i = C.gt; i < (size_t)M * D; i += C.ngt) { const size_t m = i >> 10; const int c = (int)(i & 1023); o[i] = c < 128 ? (float)pi[m * 128 + c] : 0.f; } }
          else { const bf16_t* q = (const bf16_t*)(ws + WS_D); for (size_t i = C.gt; i < (size_t)M * D; i += C.ngt) { const size_t m = i >> 10; const int c = (int)(i & 1023); o[i] = bflo((unsigned)q[m * PQ + c]) + bflo((unsigned)q[m * PQ + 1024 + c]) * 3.0f; } }
          return; }
#endif
        if (l + 1 < DEPTH) {
            { const Ctx C = MKCTX(); unsigned char* ws = KWS(); float* xs = (float*)karg(26); const float* gn = KIN(I_N1G) + (size_t)(l + 1) * D;
              if (DUP_PHASE == 9) { PEER_CALL(false, true)(C, ws, ws + WS_TAB + (size_t)l * TAB_LAYER, (const float*)(ws + WS_TSC + (size_t)l * 131072), (const float*)(ws + WS_TSC + (size_t)l * 131072 + 65536), (const int*)(ws + WS_C), (const float*)(ws + WS_C + 16 * MiB),
                                                                     (const float*)(ws + o_ssp), xs, X1_(ws), gn, (float*)(ws + o_rstd_next), KIN(I_N2G) + (size_t)l * D, X2_(ws)); }
              PEER_CALL(false, false)(C, ws, ws + WS_TAB + (size_t)l * TAB_LAYER, (const float*)(ws + WS_TSC + (size_t)l * 131072), (const float*)(ws + WS_TSC + (size_t)l * 131072 + 65536), (const int*)(ws + WS_C), (const float*)(ws + WS_C + 16 * MiB),
                                                                     (const float*)(ws + o_ssp), xs, X1_(ws), gn, (float*)(ws + o_rstd_next), KIN(I_N2G) + (size_t)l * D, X2_(ws)); }
            GRID_SYNC();
#if DBG_STOP == 6
            DBG_DUMP_RET();
#endif
        } else {
            const Ctx C = MKCTX(); unsigned char* ws = KWS(); float* xs = (float*)karg(26); const float* gn = KIN(I_FG);
            PEER_CALL(true, false)(C, ws, ws + WS_TAB + (size_t)l * TAB_LAYER, (const float*)(ws + WS_TSC + (size_t)l * 131072), (const float*)(ws + WS_TSC + (size_t)l * 131072 + 65536), (const int*)(ws + WS_C), (const float*)(ws + WS_C + 16 * MiB),
                                                                  (const float*)(ws + o_ssp), xs, X1_(ws), gn, (float*)(ws + o_rstd_next), KIN(I_N2G) + (size_t)l * D, X2_(ws));
#ifdef PROBE_END_RELEASE
            asm volatile("s_waitcnt vmcnt(0)" ::: "memory"); __syncthreads();
            if (TIDX() == 0) { __builtin_amdgcn_fence(__ATOMIC_RELEASE, ""); asm volatile("s_waitcnt vmcnt(0)" ::: "memory"); }
#endif
        }
    }
}

extern "C" void kernel_launch(void* const* d_in, const int* in_sizes, int n_in, void* d_out, int out_size, void* d_ws, size_t ws_size, hipStream_t stream) {
    static int grid = 0;
    if (grid == 0) {
        if (n_in != 26 || in_sizes[0] != M * D || out_size != M * D || ws_size < WS_END) { fprintf(stderr, "kernel_launch: unexpected shapes (n_in %d, in0 %d, out %d, ws %zu); nothing launched\n", n_in, n_in > 0 ? in_sizes[0] : -1, out_size, ws_size); grid = -1; return; }
        int dev = 0, cus = 0, per_cu = 0;
        if (hipGetDevice(&dev) != hipSuccess || hipDeviceGetAttribute(&cus, hipDeviceAttributeMultiprocessorCount, dev) != hipSuccess) { grid = -1; return; }
        if (hipFuncSetAttribute((const void*)mk_fwd, hipFuncAttributeMaxDynamicSharedMemorySize, LDS_BYTES) != hipSuccess) { fprintf(stderr, "kernel_launch: hipFuncSetAttribute failed\n"); grid = -1; return; }
        if (hipOccupancyMaxActiveBlocksPerMultiprocessor(&per_cu, (const void*)mk_fwd, NTHREADS, LDS_BYTES) != hipSuccess || per_cu < 1) { fprintf(stderr, "kernel_launch: occupancy query says %d\n", per_cu); grid = -1; (void)hipGetLastError(); return; }
        grid = cus;
    }
    if (grid < 0) return;
    (void)hipMemsetAsync((char*)d_ws + WS_CTL, 0, CTL_BYTES, stream);
    Args a{};
    for (int i = 0; i < 26; ++i) a.in[i] = d_in[i];
    a.out = (float*)d_out; a.ws = (unsigned char*)d_ws;
    void* kargs[] = {&a};
    const hipError_t e = hipLaunchCooperativeKernel((const void*)mk_fwd, dim3(grid), dim3(NTHREADS), kargs, LDS_BYTES, stream);
    if (e != hipSuccess) fprintf(stderr, "kernel_launch: cooperative launch failed: %s (grid %d)\n", hipGetErrorString(e), grid);
}
```

```cpp
#include <hip/hip_runtime.h>
#include <hip/hip_cooperative_groups.h>
#include <cstdio>
#include <cstdint>
namespace cg = cooperative_groups;

#ifndef TAB_BITS
#define TAB_BITS 4
#endif
#ifndef GATE_F8
#define GATE_F8 1
#endif
#ifndef XB16
#define XB16 1
#endif
#if XB16 && (PEER_SLICED || PEER_MFMA)
#error "XB16 is implemented for the fused token-major PEER path only"
#endif
#ifndef PEER_RESDMA
#define PEER_RESDMA 1
#endif
#ifndef PEER_HDMA
#define PEER_HDMA 0
#endif
#ifndef FUSE78
#define FUSE78 1
#endif
#if FUSE78 && Q_F8
#error "FUSE78 is wired for the bf16 q GEMM call"
#endif
#ifndef TABQ_DEFER
#define TABQ_DEFER 1
#endif
#ifndef XB_INVWAIT
#define XB_INVWAIT 1
#endif
#ifndef ST_WT_MODE
#define ST_WT_MODE 1
#endif
#ifndef ROPE_FLY
#define ROPE_FLY 1
#endif
#ifndef OUT_PREFILL
#define OUT_PREFILL 0
#endif
#ifndef S_U8
#define S_U8 2
#endif
#ifndef Q_F8
#define Q_F8 0
#endif
constexpr float GATE_WSC = 64.0f;
#ifndef PEER_DRAIN
#define PEER_DRAIN 0
#endif
#ifndef PEER_MFMA
#define PEER_MFMA 0
#endif
#ifndef EPI_NT
#define EPI_NT 0
#endif
#ifndef PEER_SLICED
#define PEER_SLICED 0
#endif
#ifndef XB_SAFE
#define XB_SAFE 5
#endif
#ifndef PEER_RING
#define PEER_RING 2
#endif
#ifndef PEER_XTOK
#define PEER_XTOK 1
#endif
#ifndef ABL_POOL
#define ABL_POOL 0
#endif
#ifndef ABL_SSM
#define ABL_SSM 0
#endif
#ifndef ABL_ATTN
#define ABL_ATTN 0
#endif
#ifndef ABL_PEER
#define ABL_PEER 0
#endif
constexpr int D = 1024, BATCH = 4, SEQ = 8192, M = BATCH * SEQ, DEPTH = 2;
constexpr int IN_COLS = 6400, NZ = 3328;
constexpr int POOLW = 512, SSMW = 512, AW = 768, AOUT = 256, QKVW = 2304;
constexpr int SSM_G = 32, SSM_P = 16, SSM_N = 64;
constexpr int CH = 256, NCH = SEQ / CH;
constexpr int PH = 8, NKEYS = 128, TOPK = 16, NEXP = 16384, PQ = 2048;
constexpr float EPS = 1e-6f;
constexpr int NWAVES = 8, NTHREADS = 512;

constexpr size_t MiB = 1u << 20;
constexpr size_t WS_CTL = 0;
constexpr size_t WS_W = 1 * MiB, W_LAYER = 23 * MiB;
constexpr size_t WO_WIN = 0, WO_POOL = 13107200, WO_PPROJ = WO_POOL + 524288, WO_GLU = WO_PPROJ + 1048576, WO_SPROJ = WO_GLU + 1048576,
                 WO_APROJ = WO_SPROJ + 1048576, WO_WOUT = WO_APROJ + 524288, WO_WQ = WO_WOUT + 2097152, WO_K1 = WO_WQ + 4194304, WO_K2 = WO_K1 + 32768, WO_END = WO_K2 + 32768;
static_assert(WO_END <= W_LAYER, "weights");
constexpr size_t WS_SSMC = 47 * MiB, SSMC_LAYER = 512 * 1024;
constexpr size_t WS_ROPE = 48 * MiB;
constexpr size_t WS_RSTD1 = 56 * MiB, WS_SS2 = WS_RSTD1 + 131072, WS_LSE = WS_SS2 + 131072  , WS_SEND = WS_LSE + 3 * (size_t)M * 16  ;
constexpr size_t WS_TAB = 60 * MiB, TAB_LAYER = 32 * MiB;
constexpr size_t WS_TSC = 59 * MiB + 768 * 1024;
constexpr size_t WS_C = 124 * MiB;
constexpr size_t WS_D = 188 * MiB;
constexpr size_t WS_E = 332 * MiB;
constexpr size_t WS_F = 396 * MiB;
constexpr size_t WS_SSP = 460 * MiB;
constexpr size_t WS_L1 = 462 * MiB, L1_SIZE = 8 * MiB;
constexpr size_t WS_HQ = 470 * MiB;
constexpr size_t WS_H8 = WS_HQ;
constexpr size_t WS_END = 502 * MiB;
constexpr size_t CTL_BYTES = 1 * MiB;
static_assert(WS_SEND + (size_t)BATCH * NCH * 32 * 64 * 8 <= WS_TSC && WS_TSC + 2 * 131072 <= 60 * MiB && WS_TAB + 2 * TAB_LAYER <= WS_C, "small");

#define LAS __attribute__((address_space(3)))
typedef unsigned short bf16_t;
typedef short bf16x8 __attribute__((ext_vector_type(8)));
typedef float f32x4 __attribute__((ext_vector_type(4)));
typedef float f32x2 __attribute__((ext_vector_type(2)));
typedef unsigned u32x4 __attribute__((ext_vector_type(4)));
typedef unsigned u32x2 __attribute__((ext_vector_type(2)));
typedef _Float16 h2_t __attribute__((ext_vector_type(2)));
typedef __bf16 b2_t __attribute__((ext_vector_type(2)));
typedef short v4i16_t __attribute__((ext_vector_type(4)));

__device__ __forceinline__ unsigned f2bf(float f) { unsigned u = __builtin_bit_cast(unsigned, f); return (u + 0x7fffu + ((u >> 16) & 1u)) >> 16; }
__device__ __forceinline__ unsigned pk2(float lo, float hi) { f32x2 v = {lo, hi}; b2_t b = __builtin_convertvector(v, b2_t); return __builtin_bit_cast(unsigned, b); }
__device__ __forceinline__ unsigned pk4_fp8(float a, float b, float c, float d) {
    a = __builtin_fminf(__builtin_fmaxf(a, -448.f), 448.f); b = __builtin_fminf(__builtin_fmaxf(b, -448.f), 448.f); c = __builtin_fminf(__builtin_fmaxf(c, -448.f), 448.f); d = __builtin_fminf(__builtin_fmaxf(d, -448.f), 448.f);
    int w = __builtin_amdgcn_cvt_pk_fp8_f32(a, b, 0, false); w = __builtin_amdgcn_cvt_pk_fp8_f32(c, d, w, true); return (unsigned)w;
}
__device__ __forceinline__ float bflo(unsigned w) { return __builtin_bit_cast(float, w << 16); }
__device__ __forceinline__ float bfhi(unsigned w) { return __builtin_bit_cast(float, w & 0xffff0000u); }
__device__ __forceinline__ unsigned pkh2(float lo, float hi) { h2_t h = {(_Float16)lo, (_Float16)hi}; return __builtin_bit_cast(unsigned, h); }
__device__ __forceinline__ float fast_exp2(float x) { return __builtin_amdgcn_exp2f(x); }
__device__ __forceinline__ float fast_rcp(float x) { return __builtin_amdgcn_rcpf(x); }
__device__ __forceinline__ float sigmoidf_(float x) { return fast_rcp(1.0f + fast_exp2(-1.4426950408889634f * x)); }
__device__ __forceinline__ float gelu_tanh(float x) { const float u = 1.5957691216057308f * (x + 0.044715f * x * x * x); return x * sigmoidf_(u); }
__device__ __forceinline__ unsigned fbits(float f) { return __builtin_bit_cast(unsigned, f); }
__device__ __forceinline__ float bitsf(unsigned u) { return __builtin_bit_cast(float, u); }
template <int MASK> __device__ __forceinline__ unsigned shx_u(unsigned v) {
    if constexpr (MASK < 32) return (unsigned)__builtin_amdgcn_ds_swizzle((int)v, 0x1F | (MASK << 10));
    else { const auto r = __builtin_amdgcn_permlane32_swap(v, v, false, false);
           return (unsigned)__builtin_amdgcn_update_dpp((int)r[1], (int)r[0], 0xE4, 0xC, 0xF, false); }
}
template <int MASK> __device__ __forceinline__ float shx(float v) { return bitsf(shx_u<MASK>(fbits(v))); }
template <int MASK> __device__ __forceinline__ int shx(int v) { return (int)shx_u<MASK>((unsigned)v); }
__device__ __forceinline__ float shfl_idx(float v, int src) { return bitsf((unsigned)__builtin_amdgcn_ds_bpermute(src << 2, (int)fbits(v))); }
__device__ __forceinline__ int shfl_idx(int v, int src) { return __builtin_amdgcn_ds_bpermute(src << 2, v); }
__device__ __forceinline__ float wave_sum(float v) { v += shx<1>(v); v += shx<2>(v); v += shx<4>(v); v += shx<8>(v); v += shx<16>(v); v += shx<32>(v); return v; }
__device__ __forceinline__ float wave_max(float v) { v = fmaxf(v, shx<1>(v)); v = fmaxf(v, shx<2>(v)); v = fmaxf(v, shx<4>(v)); v = fmaxf(v, shx<8>(v)); v = fmaxf(v, shx<16>(v)); v = fmaxf(v, shx<32>(v)); return v; }
__device__ __forceinline__ h2_t as_h2(unsigned w) { return __builtin_bit_cast(h2_t, w); }
__device__ __forceinline__ void st_wt(float* p, float v) {
#if ST_WT_MODE == 1
    __hip_atomic_store(p, v, __ATOMIC_RELAXED, __HIP_MEMORY_SCOPE_AGENT);
#else
    *p = v;
#endif
}
#define LDS_WAIT() asm volatile("s_waitcnt lgkmcnt(0)" ::: "memory")
#define VM_WAIT() asm volatile("s_waitcnt vmcnt(0)" ::: "memory")
namespace pg8 {
#define PG8_LAS __attribute__((address_space(3)))
constexpr int BM = 256, BK = 64, HALF = 128, HTB = HALF * BK * 2  , STAGE_BYTES = 8 * HTB, NXCD = 8, WGM = 8;
__host__ __device__ __forceinline__ int lds_byte(int r, int c) { const int st = (r >> 4) * 2 + (c >> 5), rr = r & 15, cc = c & 31, ob = rr * 64 + cc * 2; return st * 1024 + (ob ^ (((ob >> 9) & 1) << 5)); }
__host__ __device__ __forceinline__ void stage_rc(int b, int& R, int& C) { const int st = b / 1024, sb = b % 1024, swz = sb ^ (((sb >> 9) & 1) << 5); R = (st >> 1) * 16 + swz / 64; C = (st & 1) * 32 + (swz % 64) / 2; }
__host__ __device__ __forceinline__ int perm32(int rho) { const int n = rho >> 4, i = rho & 15; return 8 * (i >> 2) + 4 * n + (i & 3); }

typedef int i32x8_t __attribute__((ext_vector_type(8)));
typedef int i32x4_t __attribute__((ext_vector_type(4)));
__device__ __forceinline__ i32x8_t cat8(const bf16x8 a, const bf16x8 b) { const i32x4_t x = __builtin_bit_cast(i32x4_t, a), y = __builtin_bit_cast(i32x4_t, b); return __builtin_shufflevector(x, y, 0, 1, 2, 3, 4, 5, 6, 7); }
struct Unit { int pm, pn; };
struct Gemm { const bf16_t* A; const bf16_t* Bt; int M, N, K, lda, ldb; };

struct StaticOrder {
    int nM, nN, nwg, G, c;
    __host__ __device__ void init(int M_, int N_, int G_, int c_) { nM = M_ / BM; nN = N_ / BM; nwg = nM * nN; G = G_; c = c_; }
    __host__ __device__ bool next(int i, Unit& u) const {
        const long L = (long)i * G + c; if (L >= nwg) return false;
        int wgid = (int)L; { const int q = nwg / NXCD, r = nwg % NXCD, xcd = wgid % NXCD, off = wgid / NXCD; wgid = (xcd < r ? xcd * (q + 1) : r * (q + 1) + (xcd - r) * q) + off; }
        const int nig = WGM * nN, gid = wgid / nig, fm = gid * WGM, gsz = (nM - fm) < WGM ? (nM - fm) : WGM;
        u.pm = fm + ((wgid % nig) % gsz); u.pn = (wgid % nig) / gsz; return true;
    }
    __device__ __forceinline__ void a_ready(const Unit&) const {}
    __device__ __forceinline__ void done(const Unit&) const {}
};

typedef f32x4 acc_t[2][2][4][2];

__device__ __forceinline__ u32x4 pack8(const f32x4& a, const f32x4& b) { u32x4 w; w.x = pk2(a[0], a[1]); w.y = pk2(a[2], a[3]); w.z = pk2(b[0], b[1]); w.w = pk2(b[2], b[3]); return w; }
__device__ __forceinline__ void unpack8(const u32x4& w, f32x4& a, f32x4& b) { a = (f32x4){bflo(w.x), bfhi(w.x), bflo(w.y), bfhi(w.y)}; b = (f32x4){bflo(w.z), bfhi(w.z), bflo(w.w), bfhi(w.w)}; }

__device__ __forceinline__ float row_rs(const float* ssp, int row) {
    const f32x4* p = (const f32x4*)(ssp + (size_t)row * 16); const f32x4 a = p[0], b = p[1], c = p[2], d = p[3];
    const float s = ((a[0] + a[1]) + (a[2] + a[3])) + ((b[0] + b[1]) + (b[2] + b[3])) + ((c[0] + c[1]) + (c[2] + c[3])) + ((d[0] + d[1]) + (d[2] + d[3]));
    return __builtin_amdgcn_rsqf(s * (1.0f / D) + EPS);
}
struct EpiZ {
    static constexpr bool PERM = true, AFTER_DRAIN = false;
    bf16_t* zps; bf16_t* zqkv; const float* rstd;
    __device__ __forceinline__ void operator()(const acc_t& acc, const Unit& u, int wr, int wc, int fr, int fq) const {
        const int row0 = u.pm * BM + wr * 64 + fr;
        bf16_t* base; int ldc, colt;
        if (u.pn < 4) { base = zps; ldc = 1024; colt = u.pn * BM; } else { base = zqkv; ldc = QKVW; colt = (u.pn - 4) * BM; }
        const int col0 = colt + wc * 32 + 8 * fq;
        float rsv[2][4];
#pragma unroll
        for (int ai = 0; ai < 2; ++ai)
#pragma unroll
            for (int m = 0; m < 4; ++m) rsv[ai][m] = rstd[row0 + ai * HALF + m * 16];
#pragma unroll
        for (int ai = 0; ai < 2; ++ai)
#pragma unroll
            for (int m = 0; m < 4; ++m) { const int row = row0 + ai * HALF + m * 16; const float rs = rsv[ai][m]; bf16_t* rowp = base + (size_t)row * ldc + col0;
#pragma unroll
                for (int bj = 0; bj < 2; ++bj) *(u32x4*)(rowp + bj * HALF) = pack8(acc[ai][bj][m][0] * rs, acc[ai][bj][m][1] * rs); }
    }
};
struct EpiPlain {
    static constexpr bool PERM = true, AFTER_DRAIN = false;
    bf16_t* O; int ldc; const float* ss; float wsc = 1.0f;
    __device__ __forceinline__ void operator()(const acc_t& acc, const Unit& u, int wr, int wc, int fr, int fq) const {
        const int row0 = u.pm * BM + wr * 64 + fr, col0 = u.pn * BM + wc * 32 + 8 * fq;
        float rsv[2][4];
#pragma unroll
        for (int ai = 0; ai < 2; ++ai)
#pragma unroll
            for (int m = 0; m < 4; ++m) rsv[ai][m] = ss ? row_rs(ss, row0 + ai * HALF + m * 16) * wsc : 1.0f;
#pragma unroll
        for (int ai = 0; ai < 2; ++ai)
#pragma unroll
            for (int m = 0; m < 4; ++m) { const int row = row0 + ai * HALF + m * 16; const float rs = rsv[ai][m]; bf16_t* rowp = O + (size_t)row * ldc + col0;
#pragma unroll
                for (int bj = 0; bj < 2; ++bj) *(u32x4*)(rowp + bj * HALF) = pack8(acc[ai][bj][m][0] * rs, acc[ai][bj][m][1] * rs); }
    }
};
struct EpiGlu {
    static constexpr bool PERM = true, AFTER_DRAIN = false;
    bf16_t* O;
    __device__ __forceinline__ void operator()(const acc_t& acc, const Unit& u, int wr, int wc, int fr, int fq) const {
        const int row0 = u.pm * BM + wr * 64 + fr, col0 = u.pn * HALF + wc * 32 + 8 * fq;
#pragma unroll
        for (int ai = 0; ai < 2; ++ai)
#pragma unroll
            for (int m = 0; m < 4; ++m) { const int row = row0 + ai * HALF + m * 16; f32x4 o[2];
#pragma unroll
                for (int n = 0; n < 2; ++n)
#pragma unroll
                    for (int j = 0; j < 4; ++j) o[n][j] = acc[ai][0][m][n][j] * sigmoidf_(acc[ai][1][m][n][j]);
                *(u32x4*)(O + (size_t)row * SSMW + col0) = pack8(o[0], o[1]); }
    }
};
struct EpiGate {
    static constexpr bool PERM = true, AFTER_DRAIN = false;
    bf16_t* S; const float* rstd; float wsc;
    __device__ __forceinline__ void operator()(const acc_t& acc, const Unit& u, int wr, int wc, int fr, int fq) const {
        const int row0 = u.pm * BM + wr * 64 + fr, col0 = u.pn * BM + wc * 32 + 8 * fq;
        float rsv[2][4];
#pragma unroll
        for (int ai = 0; ai < 2; ++ai)
#pragma unroll
            for (int m = 0; m < 4; ++m) rsv[ai][m] = rstd[row0 + ai * HALF + m * 16] * wsc;
#pragma unroll
        for (int ai = 0; ai < 2; ++ai)
#pragma unroll
            for (int m = 0; m < 4; ++m) { const int row = row0 + ai * HALF + m * 16; const float rs = rsv[ai][m]; bf16_t* rowp = S + (size_t)row * D + col0; u32x4 pk = {0u, 0u, 0u, 0u}; (void)rowp; (void)row;
#pragma unroll
                for (int bj = 0; bj < 2; ++bj) { f32x4 o[2];
#pragma unroll
                    for (int n = 0; n < 2; ++n)
#pragma unroll
                        for (int j = 0; j < 4; ++j) o[n][j] = sigmoidf_(acc[ai][bj][m][n][j] * rs);
#if S_U8 == 2
                    u32x2 w8 = {0u, 0u};
#pragma unroll
                    for (int j = 0; j < 4; ++j) { w8.x = __builtin_amdgcn_cvt_pk_u8_f32(o[0][j] * 255.0f, j, w8.x); w8.y = __builtin_amdgcn_cvt_pk_u8_f32(o[1][j] * 255.0f, j, w8.y); }
                    if (bj == 0) { pk.x = w8.x; pk.y = w8.y; } else { pk.z = w8.x; pk.w = w8.y; } }
                *((u32x4*)S + ((size_t)(u.pm * 4 + u.pn) * 8 + ai * 4 + m) * NTHREADS + ((wr * 4 + wc) * 64 + fq * 16 + fr)) = pk; }
#elif S_U8
                    u32x2 w8 = {0u, 0u};
#pragma unroll
                    for (int j = 0; j < 4; ++j) { w8.x = __builtin_amdgcn_cvt_pk_u8_f32(o[0][j] * 255.0f, j, w8.x); w8.y = __builtin_amdgcn_cvt_pk_u8_f32(o[1][j] * 255.0f, j, w8.y); }
                    *(u32x2*)((unsigned char*)S + (size_t)row * D + col0 + bj * HALF) = w8; } }
#else
                    *(u32x4*)(rowp + bj * HALF) = pack8(o[0], o[1]); } }
#endif
    }
};
#if EPI_NT
#define EPI_LD16(p) __builtin_nontemporal_load((const u32x4*)(p))
#else
#define EPI_LD16(p) (*(const u32x4*)(p))
#endif
template <bool FIRST> struct EpiMerge {
    static constexpr bool PERM = true, AFTER_DRAIN = false;
    const bf16_t* S; bf16_t* Mg; float sc;
    __device__ __forceinline__ void operator()(const acc_t& acc, const Unit& u, int wr, int wc, int fr, int fq) const {
        const int row0 = u.pm * BM + wr * 64 + fr, col0 = u.pn * BM + wc * 32 + 8 * fq;
#pragma unroll
        for (int ai = 0; ai < 2; ++ai) {
#if S_U8 == 2
            u32x4 sp[4]; u32x2 sv[4][2]; u32x4 gv[4][2];
#elif S_U8
            u32x2 sv[4][2]; u32x4 gv[4][2];
#else
            u32x4 sv[4][2], gv[4][2];
#endif
#pragma unroll
            for (int m = 0; m < 4; ++m) { const size_t off = (size_t)(row0 + ai * HALF + m * 16) * D + col0;
#if S_U8 == 2
                sp[m] = *((const u32x4*)S + ((size_t)(u.pm * 4 + u.pn) * 8 + ai * 4 + m) * NTHREADS + ((wr * 4 + wc) * 64 + fq * 16 + fr));
#endif
#pragma unroll
                for (int bj = 0; bj < 2; ++bj) {
#if S_U8 == 2
#elif S_U8
                    sv[m][bj] = *(const u32x2*)((const unsigned char*)S + off + bj * HALF);
#else
                    sv[m][bj] = EPI_LD16(S + off + bj * HALF);
#endif
                    if (!FIRST) gv[m][bj] = EPI_LD16(Mg + off + bj * HALF); } }
            asm volatile("" ::: "memory");
#pragma unroll
            for (int m = 0; m < 4; ++m) { const size_t off = (size_t)(row0 + ai * HALF + m * 16) * D + col0;
#pragma unroll
                for (int bj = 0; bj < 2; ++bj) { f32x4 s0, s1, g0, g1;
#if S_U8 == 2
                    sv[m][bj] = bj == 0 ? (u32x2){sp[m].x, sp[m].y} : (u32x2){sp[m].z, sp[m].w};
#endif
#if S_U8
                    { const unsigned wa = sv[m][bj].x, wb = sv[m][bj].y;
                      s0 = (f32x4){(float)((wa >> 0) & 0xffu), (float)((wa >> 8) & 0xffu), (float)((wa >> 16) & 0xffu), (float)((wa >> 24) & 0xffu)};
                      s1 = (f32x4){(float)((wb >> 0) & 0xffu), (float)((wb >> 8) & 0xffu), (float)((wb >> 16) & 0xffu), (float)((wb >> 24) & 0xffu)}; }
#else
                    unpack8(sv[m][bj], s0, s1);
#endif
                    if (FIRST) { g0 = (f32x4){0.f, 0.f, 0.f, 0.f}; g1 = g0; } else unpack8(gv[m][bj], g0, g1);
                    g0 += s0 * acc[ai][bj][m][0] * sc; g1 += s1 * acc[ai][bj][m][1] * sc;
                    *(u32x4*)(Mg + off + bj * HALF) = pack8(g0, g1); } }
            asm volatile("" ::: "memory");
        }
    }
};
#if XB16
struct EpiOut {
    static constexpr bool PERM = true, AFTER_DRAIN = false;
    const bf16_t* xa; bf16_t* xb; float* ss; unsigned char* h8;
    __device__ __forceinline__ void operator()(const acc_t& acc, const Unit& u, int wr, int wc, int fr, int fq) const {
        const int row0 = u.pm * BM + wr * 64 + fr, col0 = u.pn * BM + wc * 32 + 8 * fq;
#pragma unroll
        for (int ai = 0; ai < 2; ++ai) {
            u32x4 xv[4][2];
#pragma unroll
            for (int m = 0; m < 4; ++m) { const size_t off = (size_t)(row0 + ai * HALF + m * 16) * D + col0;
#pragma unroll
                for (int bj = 0; bj < 2; ++bj) xv[m][bj] = EPI_LD16(xa + off + bj * HALF); }
            asm volatile("" ::: "memory");
#pragma unroll
            for (int m = 0; m < 4; ++m) { const int row = row0 + ai * HALF + m * 16; const size_t off = (size_t)row * D + col0; float sq = 0.f;
#pragma unroll
                for (int bj = 0; bj < 2; ++bj) { f32x4 a0, a1; unpack8(xv[m][bj], a0, a1); a0 += acc[ai][bj][m][0]; a1 += acc[ai][bj][m][1];
                    *(u32x4*)(xb + off + bj * HALF) = pack8(a0, a1);
                    sq += ((a0[0] * a0[0] + a0[1] * a0[1]) + (a0[2] * a0[2] + a0[3] * a0[3])) + ((a1[0] * a1[0] + a1[1] * a1[1]) + (a1[2] * a1[2] + a1[3] * a1[3]));
                    if (Q_F8) { u32x2 w8; w8.x = pk4_fp8(a0[0], a0[1], a0[2], a0[3]); w8.y = pk4_fp8(a1[0], a1[1], a1[2], a1[3]); *(u32x2*)(h8 + off + bj * HALF) = w8; } }
                sq += shx<16>(sq); sq += shx<32>(sq);
                if (fq == 0) st_wt(ss + (size_t)row * 16 + u.pn * 4 + wc, sq); }
            asm volatile("" ::: "memory");
        }
    }
};
#else
struct EpiOut {
    static constexpr bool PERM = true, AFTER_DRAIN = false;
    const float* xin; float* xout; bf16_t* xg; const float* g; float* ss; unsigned char* h8;
    __device__ __forceinline__ void operator()(const acc_t& acc, const Unit& u, int wr, int wc, int fr, int fq) const {
        const int row0 = u.pm * BM + wr * 64 + fr, col0 = u.pn * BM + wc * 32 + 8 * fq;
        f32x4 gv[2][2];
#pragma unroll
        for (int bj = 0; bj < 2; ++bj)
#pragma unroll
            for (int n = 0; n < 2; ++n) gv[bj][n] = *(const f32x4*)(g + col0 + bj * HALF + 4 * n);
#pragma unroll
        for (int ai = 0; ai < 2; ++ai)
#pragma unroll
            for (int mh = 0; mh < 2; ++mh) {
                f32x4 xr[2][2][2];
#pragma unroll
                for (int mm = 0; mm < 2; ++mm) { const size_t off = (size_t)(row0 + ai * HALF + (2 * mh + mm) * 16) * D + col0;
#pragma unroll
                    for (int bj = 0; bj < 2; ++bj)
#pragma unroll
                        for (int n = 0; n < 2; ++n) xr[mm][bj][n] = *(const f32x4*)(xin + off + bj * HALF + 4 * n); }
                asm volatile("" ::: "memory");
#pragma unroll
                for (int mm = 0; mm < 2; ++mm) { const int m = 2 * mh + mm; const int row = row0 + ai * HALF + m * 16; const size_t off = (size_t)row * D + col0; float sq = 0.f;
#pragma unroll
                    for (int bj = 0; bj < 2; ++bj) { f32x4 x1[2], xs[2];
#pragma unroll
                        for (int n = 0; n < 2; ++n) { x1[n] = xr[mm][bj][n] + acc[ai][bj][m][n];
                            *(f32x4*)(xout + off + bj * HALF + 4 * n) = x1[n]; sq += (x1[n][0] * x1[n][0] + x1[n][1] * x1[n][1]) + (x1[n][2] * x1[n][2] + x1[n][3] * x1[n][3]); xs[n] = x1[n] * gv[bj][n]; }
                        *(u32x4*)(xg + off + bj * HALF) = pack8(xs[0], xs[1]);
                        if (Q_F8) { u32x2 w8; w8.x = pk4_fp8(xs[0][0], xs[0][1], xs[0][2], xs[0][3]); w8.y = pk4_fp8(xs[1][0], xs[1][1], xs[1][2], xs[1][3]); *(u32x2*)(h8 + off + bj * HALF) = w8; } }
                    sq += shx<16>(sq); sq += shx<32>(sq);
                    if (fq == 0) st_wt(ss + (size_t)row * 16 + u.pn * 4 + wc, sq); }
                asm volatile("" ::: "memory");
            }
    }
};
#endif
template <class Epi, class Sched, bool ALIGN_EPI = false, bool SP2 = false, bool F8 = false>
__device__ __forceinline__ void gemm_phase(PG8_LAS unsigned char* lds, const Gemm g, const Sched& S, const Epi& E, int tid0) {
    int tid_ = tid0; asm volatile("" : "+v"(tid_));
    const int tid = tid_, wid = __builtin_amdgcn_readfirstlane(tid >> 6), lane = tid & 63, wr = wid >> 2, wc = wid & 3, fr = lane & 15, fq = lane >> 4;
    const int K = g.K, nt = K / BK, lda = g.lda, ldb = g.ldb;
    unsigned voffA[2], voffB[2];
#pragma unroll
    for (int i = 0; i < 2; ++i) { int R, C; stage_rc(tid * 16 + i * 8192, R, C); const int Rb = Epi::PERM ? ((R & ~31) + perm32(R & 31)) : R;
        voffA[i] = (unsigned)(R * lda + C) * 2u; voffB[i] = (unsigned)(Rb * ldb + C) * 2u; }
    const size_t kstep = (size_t)(BK * 2);
    const size_t hstepA = (size_t)HALF * lda * 2, hstepB = (size_t)HALF * ldb * 2;
    const size_t tstepA = 2 * hstepA, tstepB = 2 * hstepB;
    const unsigned ldsw = (unsigned)wid * 1024u;
    const int aoff = lds_byte(wr * 64 + fr, fq * 8), boff = lds_byte(wc * 32 + fr, fq * 8);
#define PG8_SA(b, h) (((b) * 2 + (h)) * HTB)
#define PG8_SB(b, h) ((4 + (b) * 2 + (h)) * HTB)
#define PG8_STAGE(bufoff, gbase, voff) do { const char* gb_ = (const char*)(gbase); asm volatile("" : "+s"(gb_));     \
        _Pragma("unroll") for (int _i = 0; _i < 2; ++_i) { unsigned vo_ = (voff)[_i]; asm volatile("" : "+v"(vo_));       \
        __builtin_amdgcn_global_load_lds((const unsigned*)(gb_ + vo_), (PG8_LAS unsigned*)(lds + (bufoff) + ldsw + _i * 8192), 16, 0, 0); } } while (0)
#define PG8_LDA(dst, b, h) do { if constexpr (F8) { _Pragma("unroll") for (int m = 0; m < 4; ++m) { const i32x4_t lo_ = *(const PG8_LAS i32x4_t*)(lds + PG8_SA(b, h) + aoff + m * 2048), hi_ = *(const PG8_LAS i32x4_t*)(lds + PG8_SA(b, h) + aoff + m * 2048 + 1024); \
            dst##8[m] = __builtin_shufflevector(lo_, hi_, 0, 1, 2, 3, 4, 5, 6, 7); } } \
        else { _Pragma("unroll") for (int m = 0; m < 4; ++m) _Pragma("unroll") for (int k = 0; k < 2; ++k) dst[m][k] = *(const PG8_LAS bf16x8*)(lds + PG8_SA(b, h) + aoff + m * 2048 + k * 1024); } } while (0)
#define PG8_LDB(dst, b, h) do { if constexpr (F8) { _Pragma("unroll") for (int n = 0; n < 2; ++n) { const i32x4_t lo_ = *(const PG8_LAS i32x4_t*)(lds + PG8_SB(b, h) + boff + n * 2048), hi_ = *(const PG8_LAS i32x4_t*)(lds + PG8_SB(b, h) + boff + n * 2048 + 1024); \
            dst##8[n] = __builtin_shufflevector(lo_, hi_, 0, 1, 2, 3, 4, 5, 6, 7); } } \
        else { _Pragma("unroll") for (int n = 0; n < 2; ++n) _Pragma("unroll") for (int k = 0; k < 2; ++k) dst[n][k] = *(const PG8_LAS bf16x8*)(lds + PG8_SB(b, h) + boff + n * 2048 + k * 1024); } } while (0)
#define PG8_MMA(ai, bj, At, Bt) do { __builtin_amdgcn_s_setprio(1); _Pragma("unroll") for (int m = 0; m < 4; ++m) _Pragma("unroll") for (int n = 0; n < 2; ++n) { \
        if constexpr (F8) acc[ai][bj][m][n] = __builtin_amdgcn_mfma_scale_f32_16x16x128_f8f6f4(Bt##8[n], At##8[m], acc[ai][bj][m][n], 0, 0, 0, 0, 0, 0); \
        else { _Pragma("unroll") for (int k = 0; k < 2; ++k) acc[ai][bj][m][n] = __builtin_amdgcn_mfma_f32_16x16x32_bf16(Bt[n][k], At[m][k], acc[ai][bj][m][n], 0, 0, 0); } } __builtin_amdgcn_s_setprio(0); } while (0)
#define PG8_WAIT_V(n) asm volatile("s_waitcnt vmcnt(" #n ")" ::: "memory")
#define PG8_WAIT_L(n) asm volatile("s_waitcnt lgkmcnt(" #n ")" ::: "memory")
#define PG8_BAR __builtin_amdgcn_s_barrier()
#define PG8_SCHED __builtin_amdgcn_sched_barrier(0)
    Unit cur, nxt; int ui = 0;
    if (!S.next(0, cur)) return;
    f32x4 acc[2][2][4][2];
#pragma unroll
    for (int a = 0; a < 2; ++a)
#pragma unroll
        for (int b = 0; b < 2; ++b)
#pragma unroll
            for (int m = 0; m < 4; ++m)
#pragma unroll
                for (int n = 0; n < 2; ++n) acc[a][b][m][n] = (f32x4){0.f, 0.f, 0.f, 0.f};
    bf16x8 At[4][2], B0[2][2], B1[2][2];
    i32x8_t At8[4], B08[2], B18[2];
    const char* cA = (const char*)g.A + (size_t)cur.pm * tstepA; const char* cB = (const char*)g.Bt + (size_t)cur.pn * tstepB;
    S.a_ready(cur);
    if constexpr (SP2) {
        PG8_STAGE(PG8_SB(0, 0), cB, voffB); PG8_STAGE(PG8_SB(0, 1), cB + hstepB, voffB); PG8_STAGE(PG8_SA(0, 0), cA, voffA); PG8_STAGE(PG8_SA(0, 1), cA + hstepA, voffA);
        if (wr == 1) PG8_BAR;
        PG8_WAIT_V(2); PG8_BAR;
        PG8_STAGE(PG8_SB(1, 0), cB + kstep, voffB); PG8_STAGE(PG8_SA(1, 0), cA + kstep, voffA); PG8_STAGE(PG8_SB(1, 1), cB + hstepB + kstep, voffB);
        PG8_WAIT_V(6); PG8_BAR;
    } else {
        PG8_STAGE(PG8_SB(0, 0), cB, voffB); PG8_STAGE(PG8_SA(0, 0), cA, voffA); PG8_STAGE(PG8_SB(0, 1), cB + hstepB, voffB); PG8_STAGE(PG8_SA(0, 1), cA + hstepA, voffA);
        if (wr == 1) PG8_BAR;
        PG8_WAIT_V(4); PG8_BAR;
        PG8_STAGE(PG8_SB(1, 0), cB + kstep, voffB); PG8_STAGE(PG8_SA(1, 0), cA + kstep, voffA); PG8_STAGE(PG8_SB(1, 1), cB + hstepB + kstep, voffB);
        PG8_WAIT_V(6); PG8_BAR;
    }
    for (;;) {
        const bool has_next = S.next(ui + 1, nxt);
        const char* nA = has_next ? (const char*)g.A + (size_t)nxt.pm * tstepA : cA; const char* nB = has_next ? (const char*)g.Bt + (size_t)nxt.pn * tstepB : cB;
#pragma nounroll
        for (int t = 0; t < nt; t += 2) {
            const bool last = (t == nt - 2);
            const char* a1 = cA + (size_t)(t + 1) * kstep;
            const char* a2 = last ? nA : cA + (size_t)(t + 2) * kstep; const char* b2 = last ? nB : cB + (size_t)(t + 2) * kstep;
            const char* a3 = a2 + kstep; const char* b3 = b2 + kstep;
            if (last && has_next) S.a_ready(nxt);
            if constexpr (SP2) {
            PG8_LDB(B0, 0, 0); PG8_LDB(B1, 0, 1); PG8_SCHED; PG8_LDA(At, 0, 0); PG8_STAGE(PG8_SA(1, 1), a1 + hstepA, voffA);
            PG8_WAIT_V(8); PG8_WAIT_L(0); PG8_BAR; PG8_MMA(0, 0, At, B0); PG8_MMA(0, 1, At, B1); PG8_BAR; PG8_SCHED;
            PG8_LDA(At, 0, 1); PG8_STAGE(PG8_SB(0, 0), b2, voffB); PG8_STAGE(PG8_SB(0, 1), b2 + hstepB, voffB); PG8_STAGE(PG8_SA(0, 0), a2, voffA);
            PG8_WAIT_V(8); PG8_WAIT_L(0); PG8_BAR; PG8_MMA(1, 0, At, B0); PG8_MMA(1, 1, At, B1); PG8_BAR; PG8_SCHED;
            PG8_LDB(B0, 1, 0); PG8_LDB(B1, 1, 1); PG8_SCHED; PG8_LDA(At, 1, 0); PG8_STAGE(PG8_SA(0, 1), a2 + hstepA, voffA);
            PG8_WAIT_V(8); PG8_WAIT_L(0); PG8_BAR; PG8_MMA(0, 0, At, B0); PG8_MMA(0, 1, At, B1); PG8_BAR; PG8_SCHED;
            PG8_LDA(At, 1, 1); PG8_STAGE(PG8_SB(1, 0), b3, voffB); PG8_STAGE(PG8_SB(1, 1), b3 + hstepB, voffB); PG8_STAGE(PG8_SA(1, 0), a3, voffA);
            PG8_WAIT_V(8); PG8_WAIT_L(0); PG8_BAR; PG8_MMA(1, 0, At, B0); PG8_MMA(1, 1, At, B1); PG8_BAR; PG8_SCHED;
            } else {
            PG8_LDB(B0, 0, 0); PG8_SCHED; PG8_LDA(At, 0, 0); PG8_STAGE(PG8_SA(1, 1), a1 + hstepA, voffA);
            PG8_WAIT_L(8); PG8_BAR; PG8_WAIT_L(0); PG8_MMA(0, 0, At, B0); PG8_BAR; PG8_SCHED;
            PG8_LDB(B1, 0, 1); PG8_STAGE(PG8_SB(0, 0), b2, voffB);
            PG8_BAR; PG8_WAIT_L(0); PG8_MMA(0, 1, At, B1); PG8_BAR;
            PG8_LDA(At, 0, 1); PG8_STAGE(PG8_SA(0, 0), a2, voffA);
            PG8_BAR; PG8_WAIT_L(0); PG8_MMA(1, 0, At, B0); PG8_BAR; PG8_SCHED;
            PG8_STAGE(PG8_SB(0, 1), b2 + hstepB, voffB);
            PG8_WAIT_V(6); PG8_BAR; PG8_MMA(1, 1, At, B1); PG8_BAR;
            PG8_LDB(B0, 1, 0); PG8_SCHED; PG8_LDA(At, 1, 0); PG8_STAGE(PG8_SA(0, 1), a2 + hstepA, voffA);
            PG8_WAIT_L(8); PG8_BAR; PG8_WAIT_L(0); PG8_MMA(0, 0, At, B0); PG8_BAR; PG8_SCHED;
            PG8_LDB(B1, 1, 1); PG8_STAGE(PG8_SB(1, 0), b3, voffB);
            PG8_BAR; PG8_WAIT_L(0); PG8_MMA(0, 1, At, B1); PG8_BAR;
            PG8_LDA(At, 1, 1); PG8_STAGE(PG8_SA(1, 0), a3, voffA);
            PG8_BAR; PG8_WAIT_L(0); PG8_MMA(1, 0, At, B0); PG8_BAR; PG8_SCHED;
            PG8_STAGE(PG8_SB(1, 1), b3 + hstepB, voffB);
            PG8_WAIT_V(6); PG8_BAR; PG8_MMA(1, 1, At, B1); PG8_BAR;
            }
        }
        if constexpr (ALIGN_EPI) { if (wr == 0) PG8_BAR; }
        if constexpr (!Epi::AFTER_DRAIN) { int te = tid; if constexpr (F8) asm volatile("" : "+v"(te));
            E(acc, cur, wr, wc, te & 15, (te & 63) >> 4); S.done(cur); }
        if (!has_next) break;
#pragma unroll
        for (int a = 0; a < 2; ++a)
#pragma unroll
            for (int b = 0; b < 2; ++b)
#pragma unroll
                for (int m = 0; m < 4; ++m)
#pragma unroll
                    for (int n = 0; n < 2; ++n) acc[a][b][m][n] = (f32x4){0.f, 0.f, 0.f, 0.f};
        cur = nxt; cA = nA; cB = nB; ++ui;
        if constexpr (ALIGN_EPI) { if (wr == 1) PG8_BAR; }
    }
    PG8_WAIT_V(0);
    if constexpr (!ALIGN_EPI) { if (wr == 0) PG8_BAR; }
    PG8_BAR;
    if constexpr (Epi::AFTER_DRAIN) { E.fused(acc, cur, wr, wc, fr, fq, lds, wid, lane); S.done(cur); }
#undef PG8_SA
#undef PG8_SB
#undef PG8_STAGE
#undef PG8_LDA
#undef PG8_LDB
#undef PG8_MMA
#undef PG8_WAIT_V
#undef PG8_WAIT_L
#undef PG8_BAR
#undef PG8_SCHED
}
}
struct Args { const void* in[26]; float* out; unsigned char* ws; };
enum { I_X = 0, I_POS, I_N1G, I_WIN, I_POOLW, I_POOLS, I_PPROJ, I_ARE, I_AIM, I_LDT, I_BRE, I_BIM, I_CRE, I_CIM, I_SD, I_GLU, I_SPROJ, I_APROJ, I_WOUT, I_N2G, I_WQ, I_K1, I_K2, I_PU, I_PV, I_FG };

struct Ctx {
    int tid, lane, wave, G, bid;
    int gw, ngw;
    int gt, ngt;
    LAS unsigned char* lds;
};

__device__ __forceinline__ void cis_f(float ang, float& c, float& s) {
    const double r = (double)ang * 0.15915494309189535;
    const double fr = r - __builtin_rint(r);
    const float f = (float)fr;
    c = __builtin_amdgcn_cosf(f); s = __builtin_amdgcn_sinf(f);
}

template <class RowMap>
__device__ __forceinline__ void p0_transpose_item(const float* W, int K, int N, bf16_t* WT, RowMap rm, LAS float* scr, int item, int lane, const float* gk = nullptr) {
    const int nblk = N / 32, kb = item / nblk, nb = item % nblk, k0 = 64 * kb, n0 = 32 * nb;
#pragma unroll 8
    for (int i = 0; i < 32; ++i) { const int kk = 2 * i + (lane >> 5); scr[kk * 33 + (lane & 31)] = W[(size_t)(k0 + kk) * N + n0 + (lane & 31)] * (gk ? gk[k0 + kk] : 1.0f); }
    LDS_WAIT(); asm volatile("" ::: "memory");
    const int c = lane & 7;
#pragma unroll
    for (int j = 0; j < 4; ++j) { const int n = (lane >> 3) + 8 * j; const LAS float* s = scr + (8 * c) * 33 + n;
        u32x4 o; o.x = pk2(s[0 * 33], s[1 * 33]); o.y = pk2(s[2 * 33], s[3 * 33]); o.z = pk2(s[4 * 33], s[5 * 33]); o.w = pk2(s[6 * 33], s[7 * 33]);
        *(u32x4*)(WT + (size_t)rm(n0 + n) * K + k0 + 8 * c) = o; }
    LDS_WAIT(); asm volatile("" ::: "memory");
}
__device__ __forceinline__ void p0_transpose_item_f8(const float* W, int K, int N, unsigned char* WT8, int nbase, float sc, LAS float* scr, int item, int lane, const float* gk = nullptr) {
    const int nblk = N / 32, kb = item / nblk, nb = item % nblk, k0 = 64 * kb, n0 = 32 * nb;
#pragma unroll 8
    for (int i = 0; i < 32; ++i) { const int kk = 2 * i + (lane >> 5); scr[kk * 33 + (lane & 31)] = W[(size_t)(k0 + kk) * N + n0 + (lane & 31)] * (gk ? gk[k0 + kk] : 1.0f); }
    LDS_WAIT(); asm volatile("" ::: "memory");
    const int c = lane & 7;
#pragma unroll
    for (int j = 0; j < 4; ++j) { const int n = (lane >> 3) + 8 * j; const LAS float* s = scr + (8 * c) * 33 + n;
        u32x2 o; o.x = pk4_fp8(s[0 * 33] * sc, s[1 * 33] * sc, s[2 * 33] * sc, s[3 * 33] * sc); o.y = pk4_fp8(s[4 * 33] * sc, s[5 * 33] * sc, s[6 * 33] * sc, s[7 * 33] * sc);
        *(u32x2*)(WT8 + (size_t)(n0 + n - nbase) * K + k0 + 8 * c) = o; }
    LDS_WAIT(); asm volatile("" ::: "memory");
}
struct RmId { __device__ __forceinline__ int operator()(int n) const { return n; } };
struct RmGlu { __device__ __forceinline__ int operator()(int n) const { return 256 * ((n & 511) >> 7) + 128 * (n >> 9) + (n & 127); } };

__device__ __forceinline__ void convert_f16(const Ctx& C, const float* src, unsigned short* dst, size_t n8) {
    for (size_t i = C.gt; i < n8; i += C.ngt) { const f32x4 a = *(const f32x4*)(src + i * 8), b = *(const f32x4*)(src + i * 8 + 4);
        u32x4 o; o.x = pkh2(a[0], a[1]); o.y = pkh2(a[2], a[3]); o.z = pkh2(b[0], b[1]); o.w = pkh2(b[2], b[3]); *(u32x4*)(dst + i * 8) = o; }
}
__device__ __forceinline__ void norm_row(const float* xrow, const float* g, bf16_t* orow, unsigned char* h8row, float* rstd_out, int lane, float* frow = nullptr) {
    f32x4 v[4]; float s = 0.f;
#pragma unroll
    for (int j = 0; j < 4; ++j) { v[j] = *((const f32x4*)xrow + lane + 64 * j); s += (v[j][0] * v[j][0] + v[j][1] * v[j][1]) + (v[j][2] * v[j][2] + v[j][3] * v[j][3]); }
    s = wave_sum(s);
#pragma unroll
    for (int j = 0; j < 4; ++j) { const f32x4 gg = *((const f32x4*)g + lane + 64 * j); const f32x4 o = XB16 ? v[j] : v[j] * gg; u32x2 w; w.x = pk2(o[0], o[1]); w.y = pk2(o[2], o[3]); *((u32x2*)orow + lane + 64 * j) = w;
        if (GATE_F8) *((unsigned*)h8row + lane + 64 * j) = pk4_fp8(o[0], o[1], o[2], o[3]);
 }
    if (lane == 0) st_wt(rstd_out, __builtin_amdgcn_rsqf(s * (1.0f / D) + EPS));
}

__device__ __forceinline__ void quant_load(const float* usrc, const float* vsrc, int lane, f32x4 (&u)[4], f32x4 (&v)[4]) {
#pragma unroll
    for (int j = 0; j < 4; ++j) { u[j] = *((const f32x4*)usrc + 4 * lane + j); v[j] = *((const f32x4*)vsrc + 4 * lane + j); }
}
__device__ __forceinline__ void quant_finish(const f32x4 (&u)[4], const f32x4 (&v)[4], unsigned char* dst, int e, float* su_out, float* sv_out, int lane) {
    float mu = 0.f, mv = 0.f;
#pragma unroll
    for (int j = 0; j < 4; ++j) {
        mu = fmaxf(mu, fmaxf(fmaxf(fabsf(u[j][0]), fabsf(u[j][1])), fmaxf(fabsf(u[j][2]), fabsf(u[j][3])))); mv = fmaxf(mv, fmaxf(fmaxf(fabsf(v[j][0]), fabsf(v[j][1])), fmaxf(fabsf(v[j][2]), fabsf(v[j][3])))); }
    mu = wave_max(mu); mv = wave_max(mv);
    const float su = fmaxf(mu, 1e-30f) * (PEER_MFMA ? (1.0f / 6.0f) : (1.0f / 7.0f)), iu = 1.0f / su, sv = fmaxf(mv, 1e-30f) * (1.0f / 6.0f), iv = 1.0f / sv;
    unsigned w[4];
#if PEER_MFMA
#pragma unroll
    for (int dd = 0; dd < 2; ++dd) { unsigned t = 0u;
#pragma unroll
        for (int j = 0; j < 8; ++j) { const float x = u[2 * dd + (j >> 2)][j & 3] * iu, ax = fabsf(x);
            const unsigned c = (unsigned)(ax > 0.25f) + (unsigned)(ax > 0.75f) + (unsigned)(ax > 1.25f) + (unsigned)(ax > 1.75f) + (unsigned)(ax > 2.5f) + (unsigned)(ax > 3.5f) + (unsigned)(ax > 5.0f);
            t |= (c | (x < 0.f ? 8u : 0u)) << (4 * j); }
        w[dd] = t; }
#else
#pragma unroll
    for (int dd = 0; dd < 2; ++dd) { unsigned t = 0u;
#pragma unroll
        for (int j = 0; j < 8; ++j) { const float x = u[2 * dd + (j >> 2)][j & 3] * iu; int q = (int)rintf(x); q = q > 7 ? 7 : (q < -7 ? -7 : q); t |= ((unsigned)q & 15u) << (4 * j); }
        w[dd] = t; }
#endif
#pragma unroll
    for (int dd = 0; dd < 2; ++dd) { unsigned t = 0u;
        t = __builtin_amdgcn_cvt_scalef32_pk_fp4_f32(t, v[2 * dd][0] * iv, v[2 * dd][1] * iv, 1.0f, 0); t = __builtin_amdgcn_cvt_scalef32_pk_fp4_f32(t, v[2 * dd][2] * iv, v[2 * dd][3] * iv, 1.0f, 1);
        t = __builtin_amdgcn_cvt_scalef32_pk_fp4_f32(t, v[2 * dd + 1][0] * iv, v[2 * dd + 1][1] * iv, 1.0f, 2); t = __builtin_amdgcn_cvt_scalef32_pk_fp4_f32(t, v[2 * dd + 1][2] * iv, v[2 * dd + 1][3] * iv, 1.0f, 3); w[2 + dd] = t; }
#if PEER_SLICED
    *(u32x2*)(dst + (size_t)(lane >> 3) * MiB + (size_t)e * 64 + (lane & 7) * 8) = (u32x2){w[0], w[1]};
    *((u32x2*)(dst + 16 * MiB + (size_t)e * 512) + lane) = (u32x2){w[2], w[3]};
#elif PEER_MFMA
    *((u32x2*)(dst + (size_t)e * 1024) + lane) = (u32x2){w[0], w[1]};
    *((u32x2*)(dst + (size_t)e * 1024 + 512) + lane) = (u32x2){w[2], w[3]};
#else
    *((u32x4*)(dst + (size_t)e * 1024) + lane) = (u32x4){w[0], w[1], w[2], w[3]};
#endif
    if (lane == 0) { st_wt(su_out, su); st_wt(sv_out, sv); }
}
__device__ __forceinline__ void quant_expert(const float* usrc, const float* vsrc, unsigned char* dst, int e, float* su_out, float* sv_out, int lane) {
    f32x4 u[4], v[4]; quant_load(usrc, vsrc, lane, u, v); quant_finish(u, v, dst, e, su_out, sv_out, lane);
}
__device__ __forceinline__ void quant_rows(const float* pu, const float* pv, unsigned char* dst, float* su, float* sv, int e0, int eend, int estep, int lane) {
    if (e0 >= eend) return;
    f32x4 u[4], v[4]; quant_load(pu + (size_t)e0 * D, pv + (size_t)e0 * D, lane, u, v);
    for (int e = e0;;) {
        const int en = e + estep; f32x4 un[4], vn[4];
        if (en < eend) quant_load(pu + (size_t)en * D, pv + (size_t)en * D, lane, un, vn);
        quant_finish(u, v, dst, e, su + e, sv + e, lane);
        if (en >= eend) break;
#pragma unroll
        for (int j = 0; j < 4; ++j) { u[j] = un[j]; v[j] = vn[j]; }
        e = en;
    }
}

__device__ __forceinline__ void phase_prologue(const Ctx& C, const Args& a) {
    unsigned char* ws = a.ws;
    LAS float* scr = (LAS float*)(C.lds) + C.wave * (64 * 33);
    constexpr int I_WINI = 16 * 200, I_PP = 8 * 32, I_GL = 8 * 32, I_SP = 8 * 32, I_AP = 4 * 32, I_WO = 16 * 32, I_WQI = 16 * 64, I_LAYER = I_WINI + I_PP + I_GL + I_SP + I_AP + I_WO + I_WQI;
    for (int it = C.gw; it < DEPTH * I_LAYER; it += C.ngw) {
        const int l = it / I_LAYER; int r = it % I_LAYER; unsigned char* wl = ws + WS_W + (size_t)l * W_LAYER;
        if (GATE_F8 && r < I_WINI && (r % 200) >= NZ / 32) { p0_transpose_item_f8((const float*)a.in[I_WIN] + (size_t)l * D * IN_COLS, D, IN_COLS, wl + WO_WIN + (size_t)NZ * D * 2, NZ, GATE_WSC, scr, r, C.lane, XB16 ? (const float*)a.in[I_N1G] + (size_t)l * D : nullptr); continue; }
        if (r < I_WINI) { p0_transpose_item((const float*)a.in[I_WIN] + (size_t)l * D * IN_COLS, D, IN_COLS, (bf16_t*)(wl + WO_WIN), RmId(), scr, r, C.lane, XB16 ? (const float*)a.in[I_N1G] + (size_t)l * D : nullptr); continue; } r -= I_WINI;
        if (r < I_PP) { p0_transpose_item((const float*)a.in[I_PPROJ] + (size_t)l * POOLW * D, POOLW, D, (bf16_t*)(wl + WO_PPROJ), RmId(), scr, r, C.lane); continue; } r -= I_PP;
        if (r < I_GL) { p0_transpose_item((const float*)a.in[I_GLU] + (size_t)l * SSMW * 2 * SSMW, SSMW, 2 * SSMW, (bf16_t*)(wl + WO_GLU), RmGlu(), scr, r, C.lane); continue; } r -= I_GL;
        if (r < I_SP) { p0_transpose_item((const float*)a.in[I_SPROJ] + (size_t)l * SSMW * D, SSMW, D, (bf16_t*)(wl + WO_SPROJ), RmId(), scr, r, C.lane); continue; } r -= I_SP;
        if (r < I_AP) { p0_transpose_item((const float*)a.in[I_APROJ] + (size_t)l * AOUT * D, AOUT, D, (bf16_t*)(wl + WO_APROJ), RmId(), scr, r, C.lane); continue; } r -= I_AP;
        if (r < I_WO) { p0_transpose_item((const float*)a.in[I_WOUT] + (size_t)l * D * D, D, D, (bf16_t*)(wl + WO_WOUT), RmId(), scr, r, C.lane); continue; } r -= I_WO;
        if (Q_F8) p0_transpose_item_f8((const float*)a.in[I_WQ] + (size_t)l * D * PQ, D, PQ, wl + WO_WQ, 0, GATE_WSC, scr, r, C.lane, XB16 ? (const float*)a.in[I_N2G] + (size_t)l * D : nullptr);
        else p0_transpose_item((const float*)a.in[I_WQ] + (size_t)l * D * PQ, D, PQ, (bf16_t*)(wl + WO_WQ), RmId(), scr, r, C.lane, XB16 ? (const float*)a.in[I_N2G] + (size_t)l * D : nullptr);
    }
    for (int i = C.gt; i < DEPTH * 512 * 512; i += C.ngt) {
        const int l = i / (512 * 512), r = i % (512 * 512), n = r / 512, k = r % 512, gn = n >> 7, gk = k >> 7;
        float v = 0.f;
        if (gn == gk) v = ((const float*)a.in[I_POOLW])[((size_t)(l * 4 + gn) * 128 + (k & 127)) * 128 + (n & 127)] * ((const float*)a.in[I_POOLS])[l * POOLW + n];
        ((bf16_t*)(ws + WS_W + (size_t)l * W_LAYER + WO_POOL))[r] = (bf16_t)f2bf(v);
    }
    for (int i = C.gt; i < DEPTH * 2 * 128 * 128; i += C.ngt) {
        const int l = i / (2 * 16384), r = i % (2 * 16384), t = r / 16384, e = r % 16384;
        const float v = ((const float*)a.in[t ? I_K2 : I_K1])[(size_t)l * 16384 + e];
        ((bf16_t*)(ws + WS_W + (size_t)l * W_LAYER + (t ? WO_K2 : WO_K1)))[e] = (bf16_t)f2bf(v);
    }
    {
        const bool defer = TABQ_DEFER && C.G == 256;
        for (int l = 0; l < (defer ? 1 : DEPTH); ++l)
            quant_rows((const float*)a.in[I_PU] + (size_t)l * NEXP * D, (const float*)a.in[I_PV] + (size_t)l * NEXP * D, ws + WS_TAB + (size_t)l * TAB_LAYER,
                       (float*)(ws + WS_TSC + (size_t)l * 131072), (float*)(ws + WS_TSC + (size_t)l * 131072 + 65536), C.gw, NEXP, C.ngw, C.lane);
    }
    if (!ROPE_FLY)
    for (int i = C.gt; i < M * 32; i += C.ngt) {
        const int m = i >> 5, f = i & 31;
        const float invf = exp2f(-(float)f * (13.287712379549449f / 32.0f));
        const float ang = (float)((const int*)a.in[I_POS])[m] * invf;
        float c, s; cis_f(ang, c, s);
        ((f32x2*)(ws + WS_ROPE))[i] = (f32x2){c, s};
    }
    for (int i = C.gt; i < DEPTH * SSM_G * SSM_N; i += C.ngt) {
        const int l = i / (SSM_G * SSM_N), gn = i % (SSM_G * SSM_N), g = gn / SSM_N;
        unsigned char* sc = ws + WS_SSMC + (size_t)l * SSMC_LAYER;
        const float dt = expf(((const float*)a.in[I_LDT])[l * SSM_G + g]);
        const float ar = ((const float*)a.in[I_ARE])[i], ai = ((const float*)a.in[I_AIM])[i];
        const float decay = expf(ar * dt); float cc, ss; cis_f(ai * dt, cc, ss);
        const float abr = decay * cc, abi = decay * ss;
        const float den = ar * ar + ai * ai, nr = abr - 1.0f;
        const float kr = (nr * ar + abi * ai) / den, ki = (abi * ar - nr * ai) / den;
        ((f32x2*)sc)[gn] = (f32x2){abr, abi};
        double pr = (double)abr, pi = (double)abi;
#pragma unroll
        for (int q = 0; q < 8; ++q) { const double nr2 = pr * pr - pi * pi, ni2 = 2.0 * pr * pi; pr = nr2; pi = ni2; }
        ((f32x2*)(sc + 16384))[gn] = (f32x2){(float)pr, (float)pi};
        const float* br = (const float*)a.in[I_BRE] + (size_t)i * SSM_P; const float* bi = (const float*)a.in[I_BIM] + (size_t)i * SSM_P;
        f32x2* bb = (f32x2*)(sc + 32768) + (size_t)gn * SSM_P;
#pragma unroll
        for (int q = 0; q < SSM_P; ++q) bb[q] = (f32x2){kr * br[q] - ki * bi[q], kr * bi[q] + ki * br[q]};
    }
    for (int m = C.gw; m < M; m += C.ngw) norm_row((const float*)a.in[I_X] + (size_t)m * D, (const float*)a.in[I_N1G], (bf16_t*)(ws + WS_E) + (size_t)m * D, ws + WS_H8 + (size_t)m * D, (float*)(ws + WS_RSTD1) + m, C.lane);
}
constexpr int AT_K_OFF = 0, AT_V_OFF = 49152, AT_VROW = 160, AT_LDS = AT_V_OFF + 384 * AT_VROW;
constexpr float AT_QSCALE = 0.125f * 1.4426950408889634f;

#if ROPE_FLY
struct AttnRegs { u32x4 kx[2][2]; int kpos[2]; u32x4 vv[4]; u32x4 qx[2]; int qpos; };
__device__ __forceinline__ void rope8(int pos, int f0, f32x2 (&cs)[8]) {
#pragma unroll
    for (int q = 0; q < 8; ++q) { const float invf = fast_exp2(-(float)(f0 + q) * (13.287712379549449f / 32.0f)); const float rev = __builtin_amdgcn_fractf(((float)pos * invf) * 0.15915494309189535f);
        cs[q] = (f32x2){__builtin_amdgcn_cosf(rev), __builtin_amdgcn_sinf(rev)}; }
}
#else
struct AttnRegs { u32x4 kx[2][2]; f32x2 kr[2][8]; u32x4 vv[4]; u32x4 qx[2]; f32x2 qr[8]; };
#endif
struct AttnIdx { int b, head, grp, hs, dil, cls, nb, slot0; size_t rowb; };
__device__ __forceinline__ AttnIdx attn_idx(int it) {
    AttnIdx I; I.b = it / 768; const int rem = it % 768; I.head = rem >> 6; const int blk = rem & 63;
    I.grp = I.head >> 2; I.hs = I.head & 3; const int dsh = 2 * I.grp; I.dil = 1 << dsh; const int nbpc = 64 >> dsh; I.cls = blk / nbpc; I.nb = blk % nbpc;
    I.rowb = (size_t)I.b * SEQ; I.slot0 = 128 * (I.nb - 1); return I;
}
#if !ROPE_FLY
#error "the block-reuse attention path is written for ROPE_FLY"
#endif
__device__ __forceinline__ void attn_load_blk(const Ctx& C, const AttnIdx& I, int kb  , int s  , const bf16_t* zqkv, const int* pos, AttnRegs& R) {
    { const int e = C.tid, j = e >> 2, c = e & 3; const size_t m = I.rowb + (size_t)(128 * kb + j) * I.dil + I.cls;
      const bf16_t* kp = zqkv + m * QKVW + AW + I.head * 64 + 8 * c;
      R.kx[s][0] = *(const u32x4*)kp; R.kx[s][1] = *(const u32x4*)(kp + 32); R.kpos[s] = pos[m]; }
#pragma unroll
    for (int p = 0; p < 2; ++p) { const int e = C.tid + p * NTHREADS, j = e >> 3, c = e & 7;
        R.vv[2 * s + p] = *(const u32x4*)(zqkv + (I.rowb + (size_t)(128 * kb + j) * I.dil + I.cls) * QKVW + 2 * AW + I.head * 64 + 8 * c); }
}
__device__ __forceinline__ void attn_load(const Ctx& C, int it, bool both, const bf16_t* zqkv, const f32x2* rope, AttnRegs& R) {
    const AttnIdx I = attn_idx(it); const int* pos = (const int*)rope;
    attn_load_blk(C, I, I.nb, 1, zqkv, pos, R);
    if (both && I.nb > 0) attn_load_blk(C, I, I.nb - 1, 0, zqkv, pos, R);
    const int w = C.wave, ql = C.lane & 15, quad = C.lane >> 4;
    const size_t mq = I.rowb + (size_t)(128 * I.nb + 16 * w + ql) * I.dil + I.cls;
    const bf16_t* qp = zqkv + mq * QKVW + I.head * 64 + 8 * quad;
    R.qx[0] = *(const u32x4*)qp; R.qx[1] = *(const u32x4*)(qp + 32); R.qpos = pos[mq];
}
__device__ __forceinline__ void attn_store_blk(const Ctx& C, int hf  , int s, bool zero, const AttnRegs& R) {
    LAS unsigned char* Ks = C.lds + AT_K_OFF; LAS unsigned char* Vs = C.lds + AT_V_OFF;
    { const int e = C.tid, j = 128 * hf + (e >> 2), c = e & 3;
      u32x4 o1 = {0u, 0u, 0u, 0u}, o2 = o1;
      if (!zero) {
          const u32x4 x1 = R.kx[s][0], x2 = R.kx[s][1];
          unsigned w1[4] = {x1.x, x1.y, x1.z, x1.w}, w2[4] = {x2.x, x2.y, x2.z, x2.w}, r1[4], r2[4];
          f32x2 kcs[8]; rope8(R.kpos[s], 8 * c, kcs);
#pragma unroll
          for (int q = 0; q < 4; ++q) {
              const f32x2 cs0 = kcs[2 * q], cs1 = kcs[2 * q + 1];
              const float a0 = bflo(w1[q]), a1 = bfhi(w1[q]), b0 = bflo(w2[q]), b1 = bfhi(w2[q]);
              r1[q] = pk2(a0 * cs0[0] - b0 * cs0[1], a1 * cs1[0] - b1 * cs1[1]);
              r2[q] = pk2(b0 * cs0[0] + a0 * cs0[1], b1 * cs1[0] + a1 * cs1[1]);
          }
          o1 = (u32x4){r1[0], r1[1], r1[2], r1[3]}; o2 = (u32x4){r2[0], r2[1], r2[2], r2[3]};
      }
      *(LAS u32x4*)(Ks + j * 128 + ((c ^ (j & 7)) << 4)) = o1;
      *(LAS u32x4*)(Ks + j * 128 + (((c + 4) ^ (j & 7)) << 4)) = o2; }
#pragma unroll
    for (int p = 0; p < 2; ++p) { const int e = C.tid + p * NTHREADS, j = 128 * hf + (e >> 3), c = e & 7;
        u32x4 v = {0u, 0u, 0u, 0u};
        if (!zero) v = R.vv[2 * s + p];
        *(LAS u32x4*)(Vs + j * AT_VROW + c * 16) = v; }
}
__device__ __forceinline__ void attn_store(const Ctx& C, int it, bool both, const AttnRegs& R, bf16x8 (&qf)[2]) {
    const AttnIdx I = attn_idx(it);
    attn_store_blk(C, I.nb % 3, 1, false, R);
    if (both) attn_store_blk(C, (I.nb + 2) % 3, 0, I.nb == 0, R);
    {
        const u32x4 x1 = R.qx[0], x2 = R.qx[1];
        unsigned w1[4] = {x1.x, x1.y, x1.z, x1.w}, w2[4] = {x2.x, x2.y, x2.z, x2.w}, r1[4], r2[4];
        f32x2 qcs[8]; rope8(R.qpos, 8 * (C.lane >> 4), qcs);
#pragma unroll
        for (int q = 0; q < 4; ++q) {
            const f32x2 cs0 = qcs[2 * q] * AT_QSCALE, cs1 = qcs[2 * q + 1] * AT_QSCALE;
            const float a0 = bflo(w1[q]), a1 = bfhi(w1[q]), b0 = bflo(w2[q]), b1 = bfhi(w2[q]);
            r1[q] = pk2(a0 * cs0[0] - b0 * cs0[1], a1 * cs1[0] - b1 * cs1[1]);
            r2[q] = pk2(b0 * cs0[0] + a0 * cs0[1], b1 * cs1[0] + a1 * cs1[1]);
        }
        qf[0] = __builtin_bit_cast(bf16x8, (u32x4){r1[0], r1[1], r1[2], r1[3]}); qf[1] = __builtin_bit_cast(bf16x8, (u32x4){r2[0], r2[1], r2[2], r2[3]});
    }
}
__device__ __forceinline__ void attn_compute(const Ctx& C, int it, const bf16x8 (&qf)[2], bf16_t* og, float* lse_out) {
    const AttnIdx I = attn_idx(it);
    const int grp = I.grp, hs = I.hs, nb = I.nb;
    LAS unsigned char* Ks = C.lds + AT_K_OFF; LAS unsigned char* Vs = C.lds + AT_V_OFF;
    const int w = C.wave, ql = C.lane & 15, quad = C.lane >> 4;
    const size_t mq = I.rowb + (size_t)(128 * nb + 16 * w + ql) * I.dil + I.cls;
    const int slo = 128 * ((nb + 2) % 3), sup = 128 * (nb % 3);
    f32x4 st[9];
#pragma unroll
    for (int r = 0; r < 9; ++r) {
        const int lrow = 16 * (w + r) + ql, row = ((lrow & 128) ? sup : slo) + (lrow & 127);
        f32x4 acc = {0.f, 0.f, 0.f, 0.f};
#pragma unroll
        for (int kk = 0; kk < 2; ++kk) {
            const bf16x8 kf = *(const LAS bf16x8*)(Ks + row * 128 + (((4 * kk + quad) ^ (row & 7)) << 4));
            acc = __builtin_amdgcn_mfma_f32_16x16x32_bf16(kf, qf[kk], acc, 0, 0, 0);
        }
        st[r] = acc;
    }
    const float NEG = -INFINITY;
    float mx = NEG;
#pragma unroll
    for (int r = 0; r < 9; ++r)
#pragma unroll
        for (int i = 0; i < 4; ++i) {
            bool ok = true;
            if (r == 0) ok = (4 * quad + i >= ql);
            if (r == 8) ok = (4 * quad + i <= ql);
            if (nb == 0 && (w + r) < 8) ok = false;
            st[r][i] = ok ? st[r][i] : NEG;
            mx = fmaxf(mx, st[r][i]);
        }
    mx = fmaxf(mx, shx<16>(mx)); mx = fmaxf(mx, shx<32>(mx));
    float den = 0.f;
#pragma unroll
    for (int r = 0; r < 9; ++r)
#pragma unroll
        for (int i = 0; i < 4; ++i) { const float p = fast_exp2(st[r][i] - mx); st[r][i] = p; den += p; }
    den += shx<16>(den); den += shx<32>(den);
    f32x4 o[4];
#pragma unroll
    for (int mb = 0; mb < 4; ++mb) o[mb] = (f32x4){0.f, 0.f, 0.f, 0.f};
    const int li = C.lane & 15, trr = li >> 2, trc = li & 3;
#pragma unroll
    for (int jj = 0; jj < 5; ++jj) {
        u32x4 pw; pw.x = pk2(st[2 * jj][0], st[2 * jj][1]); pw.y = pk2(st[2 * jj][2], st[2 * jj][3]);
        if (jj < 4) { pw.z = pk2(st[2 * jj + 1][0], st[2 * jj + 1][1]); pw.w = pk2(st[2 * jj + 1][2], st[2 * jj + 1][3]); } else { pw.z = 0u; pw.w = 0u; }
        const bf16x8 pf = __builtin_bit_cast(bf16x8, pw);
        const int jb1 = w + 2 * jj; int jb2 = jb1 + 1; jb2 = jb2 > 15 ? 15 : jb2;
        const int l1 = 16 * jb1 + 4 * quad + trr, l2 = 16 * jb2 + 4 * quad + trr, row1 = ((l1 & 128) ? sup : slo) + (l1 & 127), row2 = ((l2 & 128) ? sup : slo) + (l2 & 127);
#pragma unroll
        for (int mb = 0; mb < 4; ++mb) {
            const v4i16_t lo = __builtin_amdgcn_ds_read_tr16_b64_v4i16((LAS v4i16_t*)(Vs + row1 * AT_VROW + (16 * mb + 4 * trc) * 2));
            const v4i16_t hi = __builtin_amdgcn_ds_read_tr16_b64_v4i16((LAS v4i16_t*)(Vs + row2 * AT_VROW + (16 * mb + 4 * trc) * 2));
            const bf16x8 vf = {lo[0], lo[1], lo[2], lo[3], hi[0], hi[1], hi[2], hi[3]};
            o[mb] = __builtin_amdgcn_mfma_f32_16x16x32_bf16(vf, pf, o[mb], 0, 0, 0);
        }
    }
    const float rden = 1.0f / den;
    bf16_t* op = og + ((size_t)grp * M + mq) * AOUT + hs * 64 + 4 * quad;
#pragma unroll
    for (int mb = 0; mb < 4; ++mb) { u32x2 wv; wv.x = pk2(o[mb][0] * rden, o[mb][1] * rden); wv.y = pk2(o[mb][2] * rden, o[mb][3] * rden); *(u32x2*)(op + 16 * mb) = wv; }
    if (quad == 0) st_wt(lse_out + ((size_t)grp * M + mq) * 4 + hs, (mx + __builtin_amdgcn_logf(den)) * 0.6931471805599453f);
}

__device__ __forceinline__ void attn_items(const Ctx& C, const bf16_t* zqkv, const f32x2* rope, bf16_t* og, float* lse_out) {
    constexpr int NI = BATCH * 768; const int per = (NI + C.G - 1) / C.G, lo = C.bid * per, hi = (lo + per) < NI ? (lo + per) : NI;
    int it = lo; if (it >= hi) return;
    AttnRegs R; attn_load(C, it, true, zqkv, rope, R);
    bf16x8 qf[2];
    attn_store(C, it, true, R, qf);
    __syncthreads();
    for (;;) {
        const int nxt = it + 1; const bool nboth = (nxt & ((64 >> (2 * (((nxt % 768) >> 6) >> 2))) - 1)) == 0;
        if (nxt < hi) attn_load(C, nxt, nboth, zqkv, rope, R);
        attn_compute(C, it, qf, og, lse_out);
        if (nxt >= hi) break;
        if (nboth) __syncthreads();
        attn_store(C, nxt, nboth, R, qf);
        __syncthreads();
        it = nxt;
    }
    __syncthreads();
}
typedef float f32x16 __attribute__((ext_vector_type(16)));
constexpr int SS_TILE = 32 * 256;
__device__ __forceinline__ void cstep(float& sr, float& si, float ar, float ai, float xr, float xi) { const float nr = fmaf(ar, sr, fmaf(-ai, si, xr)), ni = fmaf(ar, si, fmaf(ai, sr, xi)); sr = nr; si = ni; }
template <bool OUT>
__device__ __forceinline__ void ssm_item(const Ctx& C, int it, const bf16_t* zps, const unsigned char* sc, f32x2* send, const float* cre, const float* cim, const float* dsk, bf16_t* ssmy) {
    const int b = it / (NCH * SSM_G), rem = it % (NCH * SSM_G), c = rem / SSM_G, g = rem % SSM_G;
    const int lane = C.lane, n = lane & 31, hi = lane >> 5, tl = lane & 15, quad = lane >> 4;
    const f32x2 ab0 = ((const f32x2*)sc)[g * SSM_N + n], ab1 = ((const f32x2*)sc)[g * SSM_N + 32 + n];
    bf16x8 bfr[4];
    { const f32x4* p0 = (const f32x4*)(sc + 32768) + (size_t)(g * SSM_N + n) * 8 + 4 * hi; const f32x4* p1 = (const f32x4*)(sc + 32768) + (size_t)(g * SSM_N + 32 + n) * 8 + 4 * hi;
      const f32x4 a0 = p0[0], a1 = p0[1], a2 = p0[2], a3 = p0[3], c0 = p1[0], c1 = p1[1], c2 = p1[2], c3 = p1[3];
      bfr[0] = __builtin_bit_cast(bf16x8, (u32x4){pk2(a0[0], a0[2]), pk2(a1[0], a1[2]), pk2(a2[0], a2[2]), pk2(a3[0], a3[2])});
      bfr[2] = __builtin_bit_cast(bf16x8, (u32x4){pk2(a0[1], a0[3]), pk2(a1[1], a1[3]), pk2(a2[1], a2[3]), pk2(a3[1], a3[3])});
      bfr[1] = __builtin_bit_cast(bf16x8, (u32x4){pk2(c0[0], c0[2]), pk2(c1[0], c1[2]), pk2(c2[0], c2[2]), pk2(c3[0], c3[2])});
      bfr[3] = __builtin_bit_cast(bf16x8, (u32x4){pk2(c0[1], c0[3]), pk2(c1[1], c1[3]), pk2(c2[1], c2[3]), pk2(c3[1], c3[3])}); }
    float s0r = 0.f, s0i = 0.f, s1r = 0.f, s1i = 0.f;
    float p0r = ab0[0], p0i = ab0[1], p1r = ab1[0], p1i = ab1[1];
    if (!OUT) {
#pragma unroll
        for (int q = 0; q < 4; ++q) { const float t0 = p0r * p0r - p0i * p0i, t1 = 2.f * p0r * p0i, t2 = p1r * p1r - p1i * p1i, t3 = 2.f * p1r * p1i; p0r = t0; p0i = t1; p1r = t2; p1i = t3; }
    }
    bf16x8 cf[4]; float dq[4];
    LAS unsigned char* tile = C.lds + C.wave * SS_TILE;
    if (OUT) {
        const f32x2 aC0 = ((const f32x2*)(sc + 16384))[g * SSM_N + n], aC1 = ((const f32x2*)(sc + 16384))[g * SSM_N + 32 + n];
        const f32x2* sp = send + ((size_t)(b * NCH) * SSM_G + g) * SSM_N + n;
        f32x2 sv0[NCH], sv1[NCH];
#pragma unroll
        for (int k = 0; k < NCH; ++k) { const int kc = k < c ? k : 0; sv0[k] = sp[(size_t)kc * SSM_G * SSM_N]; sv1[k] = sp[(size_t)kc * SSM_G * SSM_N + 32]; }
#pragma unroll
        for (int k = 0; k < NCH; ++k) if (k < c) { cstep(s0r, s0i, aC0[0], aC0[1], sv0[k][0], sv0[k][1]); cstep(s1r, s1i, aC1[0], aC1[1], sv1[k][0], sv1[k][1]); }
        const float* crp = cre + ((size_t)g * SSM_P + tl) * SSM_N; const float* cip = cim + ((size_t)g * SSM_P + tl) * SSM_N;
#pragma unroll
        for (int kk = 0; kk < 4; ++kk) { const float* src = (kk < 2 ? crp : cip) + (kk & 1) * 32 + 8 * quad; const float sg = kk < 2 ? 1.f : -1.f;
            const f32x4 a = *(const f32x4*)src * sg, bq = *(const f32x4*)(src + 4) * sg;
            cf[kk] = __builtin_bit_cast(bf16x8, (u32x4){pk2(a[0], a[1]), pk2(a[2], a[3]), pk2(bq[0], bq[1]), pk2(bq[2], bq[3])}); }
#pragma unroll
        for (int i = 0; i < 4; ++i) dq[i] = dsk[g * SSM_P + 4 * quad + i];
    }
    const size_t m0 = (size_t)b * SEQ + (size_t)c * CH;
    const int tau = 16 * ((n >> 2) & 1) + (n & 3) + 4 * (n >> 3);
    const bf16_t* up = zps + (m0 + tau) * 1024 + POOLW + g * SSM_P + 8 * hi;
    const bf16_t* ue = zps + (m0 + tl) * 1024 + POOLW + g * SSM_P + 4 * quad;
    bf16x8 ua = *(const bf16x8*)up;
    u32x2 ue0 = {0u, 0u}, ue1 = {0u, 0u};
    if (OUT) { ue0 = *(const u32x2*)ue; ue1 = *(const u32x2*)(ue + 16 * 1024); }
    for (int blk = 0; blk < CH / 32; ++blk) {
        const bf16x8 ucur = ua; const u32x2 uc0 = ue0, uc1 = ue1;
        if (blk + 1 < CH / 32) { ua = *(const bf16x8*)(up + (size_t)(blk + 1) * 32 * 1024); if (OUT) { ue0 = *(const u32x2*)(ue + (size_t)(blk + 1) * 32 * 1024); ue1 = *(const u32x2*)(ue + (size_t)((blk + 1) * 32 + 16) * 1024); } }
        f32x16 xr0 = {}, xr1 = {}, xi0 = {}, xi1 = {};
        xr0 = __builtin_amdgcn_mfma_f32_32x32x16_bf16(ucur, bfr[0], xr0, 0, 0, 0);
        xr1 = __builtin_amdgcn_mfma_f32_32x32x16_bf16(ucur, bfr[1], xr1, 0, 0, 0);
        xi0 = __builtin_amdgcn_mfma_f32_32x32x16_bf16(ucur, bfr[2], xi0, 0, 0, 0);
        xi1 = __builtin_amdgcn_mfma_f32_32x32x16_bf16(ucur, bfr[3], xi1, 0, 0, 0);
        float e0r = hi ? 0.f : s0r, e0i = hi ? 0.f : s0i, e1r = hi ? 0.f : s1r, e1i = hi ? 0.f : s1i;
#pragma unroll
        for (int r = 0; r < 16; ++r) { cstep(e0r, e0i, ab0[0], ab0[1], xr0[r], xi0[r]); cstep(e1r, e1i, ab1[0], ab1[1], xr1[r], xi1[r]); }
        const float q0r = shx<32>(e0r), q0i = shx<32>(e0i), q1r = shx<32>(e1r), q1i = shx<32>(e1i);
        if (!OUT) {
            float f0r = e0r, f0i = e0i, f1r = e1r, f1i = e1i;
            { const float nr = fmaf(p0r, q0r, fmaf(-p0i, q0i, f0r)), ni = fmaf(p0r, q0i, fmaf(p0i, q0r, f0i)); f0r = nr; f0i = ni; }
            { const float nr = fmaf(p1r, q1r, fmaf(-p1i, q1i, f1r)), ni = fmaf(p1r, q1i, fmaf(p1i, q1r, f1i)); f1r = nr; f1i = ni; }
            const float g0r = shx<32>(f0r), g0i = shx<32>(f0i), g1r = shx<32>(f1r), g1i = shx<32>(f1i);
            s0r = hi ? f0r : g0r; s0i = hi ? f0i : g0i; s1r = hi ? f1r : g1r; s1i = hi ? f1i : g1i;
        } else {
            float t0r = hi ? q0r : s0r, t0i = hi ? q0i : s0i, t1r = hi ? q1r : s1r, t1i = hi ? q1i : s1i;
#pragma unroll
            for (int r = 0; r < 16; ++r) { cstep(t0r, t0i, ab0[0], ab0[1], xr0[r], xi0[r]); xr0[r] = t0r; xi0[r] = t0i; cstep(t1r, t1i, ab1[0], ab1[1], xr1[r], xi1[r]); xr1[r] = t1r; xi1[r] = t1i; }
            const float g0r = shx<32>(t0r), g0i = shx<32>(t0i), g1r = shx<32>(t1r), g1i = shx<32>(t1i);
            s0r = hi ? t0r : g0r; s0i = hi ? t0i : g0i; s1r = hi ? t1r : g1r; s1i = hi ? t1i : g1i;
#pragma unroll
            for (int r = 0; r < 16; ++r) { LAS unsigned char* rowp = tile + (16 * hi + r) * 256 + (n & 7) * 2; const int cb = n >> 3;
                const unsigned wre = pk2(xr0[r], xr1[r]), wim = pk2(xi0[r], xi1[r]);
                *(LAS bf16_t*)(rowp + (((cb) ^ r) << 4)) = (bf16_t)(wre & 0xffffu); *(LAS bf16_t*)(rowp + (((cb + 4) ^ r) << 4)) = (bf16_t)(wre >> 16);
                *(LAS bf16_t*)(rowp + (((cb + 8) ^ r) << 4)) = (bf16_t)(wim & 0xffffu); *(LAS bf16_t*)(rowp + (((cb + 12) ^ r) << 4)) = (bf16_t)(wim >> 16); }
            LDS_WAIT(); asm volatile("" ::: "memory");
#pragma unroll
            for (int h2 = 0; h2 < 2; ++h2) {
                f32x4 y = {0.f, 0.f, 0.f, 0.f};
#pragma unroll
                for (int kk = 0; kk < 4; ++kk) { const bf16x8 sf = *(const LAS bf16x8*)(tile + (16 * h2 + tl) * 256 + (((4 * kk + quad) ^ tl) << 4)); y = __builtin_amdgcn_mfma_f32_16x16x32_bf16(cf[kk], sf, y, 0, 0, 0); }
                const size_t m = m0 + 32 * blk + 16 * h2 + tl;
                const u32x2 uu = h2 ? uc1 : uc0;
                const float uf[4] = {bflo(uu.x), bfhi(uu.x), bflo(uu.y), bfhi(uu.y)};
                float o[4];
#pragma unroll
                for (int i = 0; i < 4; ++i) o[i] = gelu_tanh(y[i] + dq[i] * uf[i]);
                u32x2 wv; wv.x = pk2(o[0], o[1]); wv.y = pk2(o[2], o[3]);
                *(u32x2*)(ssmy + m * SSMW + g * SSM_P + 4 * quad) = wv;
            }
            LDS_WAIT(); asm volatile("" ::: "memory");
        }
    }
    if (!OUT && hi == 0) { f32x2* dst = send + (((size_t)b * NCH + c) * SSM_G + g) * SSM_N + n; dst[0] = (f32x2){s0r, s0i}; dst[32] = (f32x2){s1r, s1i}; }
}

template <int WIN>
__device__ __forceinline__ void pool_run(const bf16_t* zps, bf16_t* pooled, int m0, int c) {
    const int t0 = m0 & (SEQ - 1);
    u32x4 v[15 + WIN];
#pragma unroll
    for (int j = 0; j < 15 + WIN; ++j) { const int dt = j - (WIN - 1); v[j] = (u32x4){0u, 0u, 0u, 0u}; if (t0 + dt >= 0) v[j] = *(const u32x4*)(zps + (size_t)(m0 + dt) * 1024 + 8 * c); }
    float s[8];
#pragma unroll
    for (int e = 0; e < 8; ++e) s[e] = 0.f;
#pragma unroll
    for (int j = 0; j < WIN - 1; ++j) { s[0] += bflo(v[j].x); s[1] += bfhi(v[j].x); s[2] += bflo(v[j].y); s[3] += bfhi(v[j].y); s[4] += bflo(v[j].z); s[5] += bfhi(v[j].z); s[6] += bflo(v[j].w); s[7] += bfhi(v[j].w); }
#pragma unroll
    for (int k = 0; k < 16; ++k) {
        const u32x4 cur = v[WIN - 1 + k];
        s[0] += bflo(cur.x); s[1] += bfhi(cur.x); s[2] += bflo(cur.y); s[3] += bfhi(cur.y); s[4] += bflo(cur.z); s[5] += bfhi(cur.z); s[6] += bflo(cur.w); s[7] += bfhi(cur.w);
        const int cnt = (t0 + k + 1) < WIN ? (t0 + k + 1) : WIN; const float inv = 1.0f / (float)cnt;
        u32x4 o; o.x = pk2(s[0] * inv - bflo(cur.x), s[1] * inv - bfhi(cur.x)); o.y = pk2(s[2] * inv - bflo(cur.y), s[3] * inv - bfhi(cur.y));
        o.z = pk2(s[4] * inv - bflo(cur.z), s[5] * inv - bfhi(cur.z)); o.w = pk2(s[6] * inv - bflo(cur.w), s[7] * inv - bfhi(cur.w));
        *(u32x4*)(pooled + (size_t)(m0 + k) * POOLW + 8 * c) = o;
        const u32x4 old = v[k];
        s[0] -= bflo(old.x); s[1] -= bfhi(old.x); s[2] -= bflo(old.y); s[3] -= bfhi(old.y); s[4] -= bflo(old.z); s[5] -= bfhi(old.z); s[6] -= bflo(old.w); s[7] -= bfhi(old.w);
    }
}
__device__ __forceinline__ void pool_items(const Ctx& C, const bf16_t* zps, bf16_t* pooled) {
    for (int w = C.gw; w < (M / 64) * 4; w += C.ngw) {
        const int gi = w & 3, m0 = 64 * (w >> 2) + 16 * (C.lane >> 4), c = 16 * gi + (C.lane & 15);
        if (gi == 0) pool_run<2>(zps, pooled, m0, c); else if (gi == 1) pool_run<4>(zps, pooled, m0, c); else if (gi == 2) pool_run<8>(zps, pooled, m0, c); else pool_run<16>(zps, pooled, m0, c);
    }
}
__device__ __forceinline__ void attn_merge_items(const Ctx& C, const bf16_t* og, const float* lse, bf16_t* attn) {
    for (int i = C.gt; i < M * 32; i += C.ngt) {
        const int m = i >> 5, c = i & 31, hs = c >> 3;
        const float l0 = lse[((size_t)0 * M + m) * 4 + hs], l1 = lse[((size_t)1 * M + m) * 4 + hs], l2 = lse[((size_t)2 * M + m) * 4 + hs];
        const float mx = fmaxf(l0, fmaxf(l1, l2));
        float w0 = __expf(l0 - mx), w1 = __expf(l1 - mx), w2 = __expf(l2 - mx); const float inv = 1.0f / (w0 + w1 + w2); w0 *= inv; w1 *= inv; w2 *= inv;
        const u32x4 a = *(const u32x4*)(og + ((size_t)0 * M + m) * AOUT + 8 * c), bq = *(const u32x4*)(og + ((size_t)1 * M + m) * AOUT + 8 * c), cq = *(const u32x4*)(og + ((size_t)2 * M + m) * AOUT + 8 * c);
        u32x4 o;
        o.x = pk2(w0 * bflo(a.x) + w1 * bflo(bq.x) + w2 * bflo(cq.x), w0 * bfhi(a.x) + w1 * bfhi(bq.x) + w2 * bfhi(cq.x));
        o.y = pk2(w0 * bflo(a.y) + w1 * bflo(bq.y) + w2 * bflo(cq.y), w0 * bfhi(a.y) + w1 * bfhi(bq.y) + w2 * bfhi(cq.y));
        o.z = pk2(w0 * bflo(a.z) + w1 * bflo(bq.z) + w2 * bflo(cq.z), w0 * bfhi(a.z) + w1 * bfhi(bq.z) + w2 * bfhi(cq.z));
        o.w = pk2(w0 * bflo(a.w) + w1 * bflo(bq.w) + w2 * bflo(cq.w), w0 * bfhi(a.w) + w1 * bfhi(bq.w) + w2 * bfhi(cq.w));
        *(u32x4*)(attn + (size_t)m * AOUT + 8 * c) = o;
    }
}
constexpr int TK_KEYS = 65536, TK_CIJ = TK_KEYS, TK_WSCR = TK_KEYS + 256, TK_LDS = TK_WSCR + 8 * 1024;
__device__ __forceinline__ void topk_stage_keys(const Ctx& C, const bf16_t* k1, const bf16_t* k2) {
#pragma unroll
    for (int p = 0; p < 8; ++p) { const int e = C.tid + p * NTHREADS, tab = e >> 11, row = (e >> 4) & 127, ch = e & 15;
        const u32x4 v = *(const u32x4*)((tab ? k2 : k1) + row * 128 + ch * 8);
        *(LAS u32x4*)(C.lds + tab * 32768 + row * 256 + ((ch ^ (row & 15)) << 4)) = v; }
    if (C.tid < 64) { int c = C.tid, i = 0, j = 0, found = 0, cnt = 0;
        for (int ii = 0; ii < 16; ++ii) for (int jj = 0; jj < 16; ++jj) if ((ii + 1) * (jj + 1) <= 16) { if (cnt == c) { i = ii; j = jj; found = 1; } ++cnt; }
        *(LAS unsigned char*)(C.lds + TK_CIJ + c) = (unsigned char)(found ? ((i << 4) | j) : 0); }
}
template <int N> __device__ __forceinline__ void bitonic_sort_desc(float (&a)[N]) {
#pragma unroll
    for (int k = 2; k <= N; k <<= 1)
#pragma unroll
        for (int j = k >> 1; j > 0; j >>= 1)
#pragma unroll
            for (int i = 0; i < N; ++i) { const int l = i ^ j; if (l > i) { const bool desc = (i & k) == 0; const float hi = fmaxf(a[i], a[l]), lo = fminf(a[i], a[l]); a[i] = desc ? hi : lo; a[l] = desc ? lo : hi; } }
}
template <int N> __device__ __forceinline__ void bitonic_merge_desc(float (&a)[N]) {
#pragma unroll
    for (int j = N >> 1; j > 0; j >>= 1)
#pragma unroll
        for (int i = 0; i < N; ++i) { const int l = i ^ j; if (l > i) { const float hi = fmaxf(a[i], a[l]), lo = fminf(a[i], a[l]); a[i] = hi; a[l] = lo; } }
}
template <int MASK>
__device__ __forceinline__ void merge_lanes16(float (&top)[16]) {
    float c[16];
#pragma unroll
    for (int i = 0; i < 16; ++i) c[i] = fmaxf(top[i], shx<MASK>(top[15 - i]));
    bitonic_merge_desc<16>(c);
#pragma unroll
    for (int i = 0; i < 16; ++i) top[i] = c[i];
}
struct TkQ { bf16x8 q[2][4]; };
__device__ __forceinline__ void topk_load(const Ctx& C, int it, const bf16_t* qbuf, TkQ& Q) {
    const int tg = it >> 3, h = it & 7, tl = C.lane & 15, quad = C.lane >> 4;
    const bf16_t* qrow = qbuf + ((size_t)16 * tg + tl) * PQ + h * 256 + 8 * quad;
#pragma unroll
    for (int t = 0; t < 2; ++t)
#pragma unroll
        for (int kk = 0; kk < 4; ++kk) Q.q[t][kk] = *(const bf16x8*)(qrow + 128 * t + 32 * kk);
}
__device__ __forceinline__ void topk_table(const Ctx& C, int tab, const bf16x8 (&qf)[4], float (&top)[16]) {
    const int tl = C.lane & 15, quad = C.lane >> 4;
    float v[32];
#pragma unroll
    for (int mb = 0; mb < 8; ++mb) {
        f32x4 acc = {0.f, 0.f, 0.f, 0.f}; const int row = 16 * mb + tl;
#pragma unroll
        for (int kk = 0; kk < 4; ++kk) { const bf16x8 kf = *(const LAS bf16x8*)(C.lds + tab * 32768 + row * 256 + (((4 * kk + quad) ^ (row & 15)) << 4));
            acc = __builtin_amdgcn_mfma_f32_16x16x32_bf16(kf, qf[kk], acc, 0, 0, 0); }
#pragma unroll
        for (int i = 0; i < 4; ++i) { const float sc_ = acc[i]; v[4 * mb + i] = bitsf((fbits(sc_) & ~127u) | (unsigned)(16 * mb + 4 * quad + i)); }
    }
#pragma unroll
    for (int k = 2; k <= 16; k <<= 1)
#pragma unroll
        for (int j = k >> 1; j > 0; j >>= 1)
#pragma unroll
            for (int i = 0; i < 32; ++i) { const int l = i ^ j; if (l > i) { const bool desc = (i & k) == 0; const float hi = fmaxf(v[i], v[l]), lo = fminf(v[i], v[l]); v[i] = desc ? hi : lo; v[l] = desc ? lo : hi; } }
#pragma unroll
    for (int i = 0; i < 16; ++i) top[i] = fmaxf(v[i], v[16 + i]);
    bitonic_merge_desc<16>(top);
    merge_lanes16<16>(top); merge_lanes16<32>(top);
}

__device__ __forceinline__ void topk_item(const Ctx& C, int it, const TkQ& Q, int* idx, float* gate) {
    const int tg = it >> 3, h = it & 7, tl = C.lane & 15, quad = C.lane >> 4;
    const size_t m = (size_t)16 * tg + tl;
    float t1[16], t2[16];
    topk_table(C, 0, Q.q[0], t1);
    __builtin_amdgcn_sched_barrier(0);
    topk_table(C, 1, Q.q[1], t2);
    __builtin_amdgcn_sched_barrier(0);
    constexpr int CI[50] = {0,0,0,0,0,0,0,0,0,0,0,0,0,0,0,0,1,1,1,1,1,1,1,1,2,2,2,2,2,3,3,3,3,4,4,4,5,5,6,6,7,7,8,9,10,11,12,13,14,15};
    constexpr int CJ[50] = {0,1,2,3,4,5,6,7,8,9,10,11,12,13,14,15,0,1,2,3,4,5,6,7,0,1,2,3,4,0,1,2,3,0,1,2,0,1,0,1,0,1,0,0,0,0,0,0,0,0};
    float c1[16], c2[16];
#pragma unroll
    for (int i = 0; i < 16; ++i) { c1[i] = bitsf(fbits(t1[i]) & ~127u); c2[i] = bitsf(fbits(t2[i]) & ~127u); }
    LAS unsigned char* wscr = C.lds + TK_WSCR + C.wave * 1024 + tl * 32;
    {
        unsigned p1 = 0u, p2 = 0u;
#pragma unroll
        for (int i = 0; i < 4; ++i) { const unsigned a = quad == 0 ? fbits(t1[i]) : quad == 1 ? fbits(t1[4 + i]) : quad == 2 ? fbits(t1[8 + i]) : fbits(t1[12 + i]);
            const unsigned b = quad == 0 ? fbits(t2[i]) : quad == 1 ? fbits(t2[4 + i]) : quad == 2 ? fbits(t2[8 + i]) : fbits(t2[12 + i]);
            p1 |= (a & 127u) << (8 * i); p2 |= (b & 127u) << (8 * i); }
        *(LAS unsigned*)(wscr + 4 * quad) = p1; *(LAS unsigned*)(wscr + 16 + 4 * quad) = p2;
    }
    float cv[16];
#pragma unroll
    for (int s = 0; s < 16; ++s) {
        float vv = -INFINITY;
        if (s < 13) {
#pragma unroll
            for (int qd = 0; qd < 4; ++qd) { const int c = 4 * s + qd;
                if (c < 50) { const float sum = c1[CI[c < 50 ? c : 0]] + c2[CJ[c < 50 ? c : 0]];
                    const float pv = bitsf((fbits(sum) & ~63u) | (unsigned)c);
                    if (quad == qd) vv = pv; } } }
        cv[s] = vv;
    }
    bitonic_sort_desc<16>(cv);
    merge_lanes16<16>(cv); merge_lanes16<32>(cv);
    float ex[16], sum = 0.f;
#pragma unroll
    for (int r = 0; r < 16; ++r) { ex[r] = __expf(cv[r] - cv[0]); sum += ex[r]; }
    const float inv = 1.0f / sum;
    int oe[4]; float og_[4];
#pragma unroll
    for (int i = 0; i < 4; ++i) {
        const float rvv = quad == 0 ? cv[i] : quad == 1 ? cv[4 + i] : quad == 2 ? cv[8 + i] : cv[12 + i];
        og_[i] = (quad == 0 ? ex[i] : quad == 1 ? ex[4 + i] : quad == 2 ? ex[8 + i] : ex[12 + i]) * inv;
        const unsigned c = fbits(rvv) & 63u;
        const unsigned ij = *(const LAS unsigned char*)(C.lds + TK_CIJ + c);
        const unsigned e1 = *(const LAS unsigned char*)(wscr + (ij >> 4)), e2 = *(const LAS unsigned char*)(wscr + 16 + (ij & 15u));
        oe[i] = (int)((e1 * NKEYS + e2) & (NEXP - 1));
    }
    *(int4*)(idx + m * 128 + h * 16 + 4 * quad) = make_int4(oe[0], oe[1], oe[2], oe[3]);
    *(f32x4*)(gate + m * 128 + h * 16 + 4 * quad) = (f32x4){og_[0], og_[1], og_[2], og_[3]};
}
__device__ __forceinline__ void topk_items(const Ctx& C, const bf16_t* qbuf, int* idx, float* gate) {
    constexpr int NI = (M / 16) * PH;
    int it = C.gw; if (it >= NI) return;
    TkQ Q; topk_load(C, it, qbuf, Q);
    for (;;) {
        const int nxt = it + C.ngw; TkQ Qn;
        if (nxt < NI) topk_load(C, nxt, qbuf, Qn);
        topk_item(C, it, Q, idx, gate);
        if (nxt >= NI) break;
        Q = Qn; it = nxt;
    }
}
__device__ __forceinline__ int topk_own_item(const pg8::StaticOrder& S, int wave, int k) { pg8::Unit u; if (!S.next(k >> 1, u)) return -1; return (16 * u.pm + wave + 8 * (k & 1)) * PH + u.pn; }
__device__ __forceinline__ void topk_own_items(const Ctx& C, const pg8::StaticOrder& S, const bf16_t* qbuf, int* idx, float* gate) {
    int k = 0, it = topk_own_item(S, C.wave, 0); if (it < 0) return;
    TkQ Q; topk_load(C, it, qbuf, Q);
    for (;;) {
        const int nxt = topk_own_item(S, C.wave, k + 1); TkQ Qn;
        if (nxt >= 0) topk_load(C, nxt, qbuf, Qn);
        topk_item(C, it, Q, idx, gate);
        if (nxt < 0) break;
        Q = Qn; it = nxt; ++k;
    }
}
#if TAB_BITS == 8
typedef u32x4 tabv_t;
#else
typedef u32x2 tabv_t;
#endif
constexpr int TABROW = D * TAB_BITS / 8;
__device__ __forceinline__ void peer_load8(const unsigned char* tab, int e0, int e1, int kbase, int lane, tabv_t (&buf)[8]) {
#pragma unroll
    for (int e = 0; e < 8; ++e) { const int k = kbase + e; const int ex = __builtin_amdgcn_readlane(k < 64 ? e0 : e1, k & 63);
        buf[e] = *((const tabv_t*)(tab + (size_t)ex * TABROW) + lane); }
}
__device__ __forceinline__ float dot16(const tabv_t& a, const unsigned (&hh)[8]) {
    float d = 0.f;
#if TAB_BITS == 8
    const unsigned w[4] = {a.x, a.y, a.z, a.w};
#pragma unroll
    for (int q = 0; q < 4; ++q) {
        d = __builtin_amdgcn_fdot2(__builtin_amdgcn_cvt_scalef32_pk_f16_fp8(w[q], 1.0f, false), as_h2(hh[2 * q]), d, false);
        d = __builtin_amdgcn_fdot2(__builtin_amdgcn_cvt_scalef32_pk_f16_fp8(w[q], 1.0f, true), as_h2(hh[2 * q + 1]), d, false);
    }
#else
    const unsigned w[2] = {a.x, a.y};
#pragma unroll
    for (int dd = 0; dd < 2; ++dd) {
        d = __builtin_amdgcn_fdot2(__builtin_amdgcn_cvt_scalef32_pk_f16_fp4(w[dd], 1.0f, 0), as_h2(hh[4 * dd + 0]), d, false);
        d = __builtin_amdgcn_fdot2(__builtin_amdgcn_cvt_scalef32_pk_f16_fp4(w[dd], 1.0f, 1), as_h2(hh[4 * dd + 1]), d, false);
        d = __builtin_amdgcn_fdot2(__builtin_amdgcn_cvt_scalef32_pk_f16_fp4(w[dd], 1.0f, 2), as_h2(hh[4 * dd + 2]), d, false);
        d = __builtin_amdgcn_fdot2(__builtin_amdgcn_cvt_scalef32_pk_f16_fp4(w[dd], 1.0f, 3), as_h2(hh[4 * dd + 3]), d, false);
    }
#endif
    return d;
}
__device__ __forceinline__ float reduce8(const float (&d)[8], int lane) {
    const bool b5 = lane & 32, b4 = lane & 16, b3 = lane & 8;
    float r4[4];
#pragma unroll
    for (int i = 0; i < 4; ++i) { const float keep = b5 ? d[4 + i] : d[i], send = b5 ? d[i] : d[4 + i]; r4[i] = keep + shx<32>(send); }
    float r2[2];
#pragma unroll
    for (int i = 0; i < 2; ++i) { const float keep = b4 ? r4[2 + i] : r4[i], send = b4 ? r4[i] : r4[2 + i]; r2[i] = keep + shx<16>(send); }
    float r1; { const float keep = b3 ? r2[1] : r2[0], send = b3 ? r2[0] : r2[1]; r1 = keep + shx<8>(send); }
    r1 += shx<4>(r1); r1 += shx<2>(r1); r1 += shx<1>(r1);
    return r1;
}
#if TAB_BITS == 4
__device__ __forceinline__ int idot16(const tabv_t& a, const unsigned (&hq)[4]) {
    const int s_hi = __builtin_amdgcn_sdot8((int)a.y, (int)hq[1], __builtin_amdgcn_sdot8((int)a.x, (int)hq[0], 0, false), false);
    const int s_lo = __builtin_amdgcn_sdot8((int)a.y, (int)hq[3], __builtin_amdgcn_sdot8((int)a.x, (int)hq[2], 0, false), false);
    return 16 * s_hi + s_lo;
}
__device__ __forceinline__ int reduce8i(const int (&d)[8], int lane) {
    const bool b5 = lane & 32, b4 = lane & 16, b3 = lane & 8;
    int r4[4];
#pragma unroll
    for (int i = 0; i < 4; ++i) { const int keep = b5 ? d[4 + i] : d[i], send = b5 ? d[i] : d[4 + i]; r4[i] = keep + shx<32>(send); }
    int r2[2];
#pragma unroll
    for (int i = 0; i < 2; ++i) { const int keep = b4 ? r4[2 + i] : r4[i], send = b4 ? r4[i] : r4[2 + i]; r2[i] = keep + shx<16>(send); }
    int r1; { const int keep = b3 ? r2[1] : r2[0], send = b3 ? r2[0] : r2[1]; r1 = keep + shx<8>(send); }
    r1 += shx<4>(r1); r1 += shx<2>(r1); r1 += shx<1>(r1);
    return r1;
}
__device__ __forceinline__ void peer_dots(const tabv_t (&buf)[8], const unsigned (&hq)[4], int grp, int lane, float& a0, float& a1) {
    int d[8];
#pragma unroll
    for (int e = 0; e < 8; ++e) d[e] = idot16(buf[e], hq);
    const int r1 = reduce8i(d, lane);
    const int e = lane & 7, src = ((e >> 2) & 1) * 32 + ((e >> 1) & 1) * 16 + (e & 1) * 8;
    const float val = (float)shfl_idx(r1, src);
    if ((lane >> 3) == (grp & 7)) { if (grp < 8) a0 = val; else a1 = val; }
}
#else
__device__ __forceinline__ void peer_dots(const tabv_t (&buf)[8], const unsigned (&hh)[8], int grp, int lane, float& a0, float& a1) {
    float d[8];
#pragma unroll
    for (int e = 0; e < 8; ++e) d[e] = dot16(buf[e], hh);
    const float r1 = reduce8(d, lane);
    const int e = lane & 7, src = ((e >> 2) & 1) * 32 + ((e >> 1) & 1) * 16 + (e & 1) * 8;
    const float val = shfl_idx(r1, src);
    if ((lane >> 3) == (grp & 7)) { if (grp < 8) a0 = val; else a1 = val; }
}
#endif
__device__ __forceinline__ void peer_fma8(const tabv_t (&buf)[8], float c0, float c1, int kbase, float (&acc)[16]) {
#pragma unroll
    for (int e = 0; e < 8; ++e) { const int k = kbase + e; const float ck = bitsf((unsigned)__builtin_amdgcn_readlane((int)fbits(k < 64 ? c0 : c1), k & 63));
#if TAB_BITS == 4
        const unsigned w4[2] = {buf[e].x, buf[e].y};
#pragma unroll
        for (int dd = 0; dd < 2; ++dd) {
            const h2_t p0 = __builtin_amdgcn_cvt_scalef32_pk_f16_fp4(w4[dd], 1.0f, 0), p1 = __builtin_amdgcn_cvt_scalef32_pk_f16_fp4(w4[dd], 1.0f, 1),
                       p2 = __builtin_amdgcn_cvt_scalef32_pk_f16_fp4(w4[dd], 1.0f, 2), p3 = __builtin_amdgcn_cvt_scalef32_pk_f16_fp4(w4[dd], 1.0f, 3);
            acc[8 * dd + 0] = fmaf((float)p0[0], ck, acc[8 * dd + 0]); acc[8 * dd + 1] = fmaf((float)p0[1], ck, acc[8 * dd + 1]);
            acc[8 * dd + 2] = fmaf((float)p1[0], ck, acc[8 * dd + 2]); acc[8 * dd + 3] = fmaf((float)p1[1], ck, acc[8 * dd + 3]);
            acc[8 * dd + 4] = fmaf((float)p2[0], ck, acc[8 * dd + 4]); acc[8 * dd + 5] = fmaf((float)p2[1], ck, acc[8 * dd + 5]);
            acc[8 * dd + 6] = fmaf((float)p3[0], ck, acc[8 * dd + 6]); acc[8 * dd + 7] = fmaf((float)p3[1], ck, acc[8 * dd + 7]); }
#else
        const unsigned w[4] = {buf[e].x, buf[e].y, buf[e].z, buf[e].w};
#pragma unroll
        for (int q = 0; q < 4; ++q) { const h2_t lo = __builtin_amdgcn_cvt_scalef32_pk_f16_fp8(w[q], 1.0f, false), hi = __builtin_amdgcn_cvt_scalef32_pk_f16_fp8(w[q], 1.0f, true);
            acc[4 * q] = fmaf((float)lo[0], ck, acc[4 * q]); acc[4 * q + 1] = fmaf((float)lo[1], ck, acc[4 * q + 1]);
            acc[4 * q + 2] = fmaf((float)hi[0], ck, acc[4 * q + 2]); acc[4 * q + 3] = fmaf((float)hi[1], ck, acc[4 * q + 3]); }
#endif
    }
}
struct PeerTok { int e0, e1; float g0, g1, su0, su1, sv0, sv1; };
__device__ __forceinline__ void peer_tok_idx(PeerTok& T, int m, const int* idx, const float* gate, int lane) {
    T.e0 = idx[(size_t)m * 128 + lane]; T.e1 = idx[(size_t)m * 128 + 64 + lane]; T.g0 = gate[(size_t)m * 128 + lane]; T.g1 = gate[(size_t)m * 128 + 64 + lane];
}
__device__ __forceinline__ void peer_tok_scales(PeerTok& T, const float* scU, const float* scV) { T.su0 = scU[T.e0]; T.su1 = scU[T.e1]; T.sv0 = scV[T.e0]; T.sv1 = scV[T.e1]; }
__device__ __forceinline__ void peer_issue_f(int grp, const unsigned char* tab, const PeerTok& T, int lane, u32x4 (&buf)[8]) {
#pragma unroll
    for (int e = 0; e < 8; ++e) { const int k = 8 * grp + e; const int ex = __builtin_amdgcn_readlane(k < 64 ? T.e0 : T.e1, k & 63);
        buf[e] = *((const u32x4*)(tab + (size_t)ex * 1024) + lane); }
}
__device__ __forceinline__ void peer_group(const u32x4 (&buf)[8], const unsigned (&hq)[4], int grp, int lane, const PeerTok& T, float sh, h2_t (&acc)[8]) {
    int d[8];
#pragma unroll
    for (int e = 0; e < 8; ++e) { const u32x2 up = {buf[e].x, buf[e].y}; d[e] = idot16(up, hq); }
    const int r1 = reduce8i(d, lane);
    const int el = lane & 7, src = ((el >> 2) & 1) * 32 + ((el >> 1) & 1) * 16 + (el & 1) * 8;
    const float a = (float)shfl_idx(r1, src);
    const bool lo = grp < 8;
    const float c = ABL_PEER ? 0.f : (lo ? T.g0 : T.g1) * gelu_tanh(a * ((lo ? T.su0 : T.su1) * sh)) * (lo ? T.sv0 : T.sv1);
    const unsigned cpk = pkh2(c, c);
#pragma unroll
    for (int e = 0; e < 8; ++e) { const h2_t ck = as_h2((unsigned)__builtin_amdgcn_readlane((int)cpk, 8 * (grp & 7) + e));
        const unsigned w4[2] = {buf[e].z, buf[e].w};
#pragma unroll
        for (int dd = 0; dd < 2; ++dd) {
#pragma unroll
            for (int sl = 0; sl < 4; ++sl) { h2_t pv;
                if (sl == 0) pv = __builtin_amdgcn_cvt_scalef32_pk_f16_fp4(w4[dd], 1.0f, 0); else if (sl == 1) pv = __builtin_amdgcn_cvt_scalef32_pk_f16_fp4(w4[dd], 1.0f, 1);
                else if (sl == 2) pv = __builtin_amdgcn_cvt_scalef32_pk_f16_fp4(w4[dd], 1.0f, 2); else pv = __builtin_amdgcn_cvt_scalef32_pk_f16_fp4(w4[dd], 1.0f, 3);
                acc[4 * dd + sl] = __builtin_elementwise_fma(pv, ck, acc[4 * dd + sl]); } } }
}
template <bool LAST, bool DRY = false>
__device__ __forceinline__ void peer_tokens(const Ctx& C, int m0, int step, const unsigned char* tab, const float* scU, const float* scV, const int* idx, const float* gate, const float* ss2,
                                            float* xs, bf16_t* xg, const float* gnext, float* rstd1, const float* g2 = nullptr, bf16_t* xo = nullptr, unsigned char* h8p = nullptr) {
    const int lane = C.lane;
    if (m0 >= M) return;
    PeerTok T, Tn;
    peer_tok_idx(T, m0, idx, gate, lane); peer_tok_scales(T, scU, scV);
#if PEER_RING == 3
    u32x4 bA[8], bB[8], bC[8];
#else
    u32x4 bA[8], bB[8];
#endif
    int tokpar = 0;
    for (int m = m0; m < M; m += step) {
        const int mn = m + step; const bool has_next = mn < M;
        peer_issue_f(0, tab, T, lane, bA);
#if PEER_RING == 3
        peer_issue_f(1, tab, T, lane, bB);
#endif
        if (has_next) peer_tok_idx(Tn, mn, idx, gate, lane);
#if PEER_RESDMA
        { LAS unsigned char* slot = C.lds + C.wave * 4096;
#if XB16
#pragma unroll
          for (int j = 0; j < 2; ++j) __builtin_amdgcn_global_load_lds((const unsigned*)((const u32x4*)(xg + (size_t)m * D) + 2 * lane + j), (LAS unsigned*)(slot + j * 1024), 16, 0, 0);
#else
#pragma unroll
          for (int j = 0; j < 4; ++j) __builtin_amdgcn_global_load_lds((const unsigned*)((const f32x4*)(xs + (size_t)m * D) + 4 * lane + j), (LAS unsigned*)(slot + j * 1024), 16, 0, 0);
#endif
        }
#endif
        const float rs = pg8::row_rs(ss2, m);
        unsigned hh[4]; float sh;
        {
#if PEER_HDMA
          LAS unsigned char* hslot = C.lds + 32768 + C.wave * 4096 + (tokpar << 11);
          u32x4 x0, x1;
          if (m == m0) { x0 = *((const u32x4*)(xg + (size_t)m * D) + 2 * lane); x1 = *((const u32x4*)(xg + (size_t)m * D) + 2 * lane + 1); }
          else { x0 = *(const LAS u32x4*)(hslot + lane * 16); x1 = *(const LAS u32x4*)(hslot + 1024 + lane * 16); LDS_WAIT(); asm volatile("" ::: "memory"); }
          if (has_next) { LAS unsigned char* nslot = C.lds + 32768 + C.wave * 4096 + ((tokpar ^ 1) << 11);
#pragma unroll
              for (int j = 0; j < 2; ++j) __builtin_amdgcn_global_load_lds((const unsigned*)((const u32x4*)(xg + (size_t)mn * D) + 2 * lane + j), (LAS unsigned*)(nslot + j * 1024), 16, 0, 0); }
          tokpar ^= 1;
#else
          const u32x4 x0 = *((const u32x4*)(xg + (size_t)m * D) + 2 * lane), x1 = *((const u32x4*)(xg + (size_t)m * D) + 2 * lane + 1);
#endif
          const unsigned w[8] = {x0.x, x0.y, x0.z, x0.w, x1.x, x1.y, x1.z, x1.w};
          float hv[16]; float mxh = 0.f;
#pragma unroll
          for (int q = 0; q < 8; ++q) { hv[2 * q] = bflo(w[q]) * rs; hv[2 * q + 1] = bfhi(w[q]) * rs; }
#if XB16
#pragma unroll
          for (int q = 0; q < 4; ++q) { const f32x4 gq = *((const f32x4*)g2 + 4 * lane + q); hv[4 * q] *= gq[0]; hv[4 * q + 1] *= gq[1]; hv[4 * q + 2] *= gq[2]; hv[4 * q + 3] *= gq[3]; }
#endif
#pragma unroll
          for (int q = 0; q < 16; ++q) mxh = fmaxf(mxh, fabsf(hv[q]));
          mxh = wave_max(mxh);
          sh = fmaxf(mxh, 1e-30f) * (1.0f / 119.0f); const float inv = 1.0f / sh;
#pragma unroll
          for (int dd = 0; dd < 2; ++dd) { unsigned th = 0u, tl = 0u;
#pragma unroll
              for (int j = 0; j < 8; ++j) { const int q8 = (int)rintf(hv[8 * dd + j] * inv), hi = (q8 + 8) >> 4, lo = q8 - (hi << 4); th |= ((unsigned)hi & 15u) << (4 * j); tl |= ((unsigned)lo & 15u) << (4 * j); }
              hh[dd] = th; hh[2 + dd] = tl; } }
        h2_t acc[8];
#pragma unroll
        for (int i = 0; i < 8; ++i) acc[i] = (h2_t){(_Float16)0.f, (_Float16)0.f};
#if PEER_RING == 3
#pragma unroll 1
        for (int j = 0; j < 15; j += 3) {
            peer_issue_f(j + 2, tab, T, lane, bC); peer_group(bA, hh, j, lane, T, sh, acc);
            peer_issue_f(j + 3, tab, T, lane, bA); peer_group(bB, hh, j + 1, lane, T, sh, acc);
            if (j + 4 < 16) peer_issue_f(j + 4, tab, T, lane, bB);
            peer_group(bC, hh, j + 2, lane, T, sh, acc);
        }
        peer_group(bA, hh, 15, lane, T, sh, acc);
#else
#pragma unroll 1
        for (int j = 0; j < 16; j += 2) {
            peer_issue_f(j + 1, tab, T, lane, bB); peer_group(bA, hh, j, lane, T, sh, acc);
            if (j + 2 < 16) peer_issue_f(j + 2, tab, T, lane, bA);
            peer_group(bB, hh, j + 1, lane, T, sh, acc);
        }
#endif
#if PEER_RESDMA
        asm volatile("s_waitcnt vmcnt(0)" ::: "memory");
        f32x4 x[4];
        { LAS unsigned char* slot = C.lds + C.wave * 4096;
#if XB16
          const u32x4 x0 = *(const LAS u32x4*)(slot + lane * 16), x1 = *(const LAS u32x4*)(slot + 1024 + lane * 16);
          x[0] = (f32x4){bflo(x0.x), bfhi(x0.x), bflo(x0.y), bfhi(x0.y)}; x[1] = (f32x4){bflo(x0.z), bfhi(x0.z), bflo(x0.w), bfhi(x0.w)};
          x[2] = (f32x4){bflo(x1.x), bfhi(x1.x), bflo(x1.y), bfhi(x1.y)}; x[3] = (f32x4){bflo(x1.z), bfhi(x1.z), bflo(x1.w), bfhi(x1.w)};
#else
#pragma unroll
          for (int j = 0; j < 4; ++j) x[j] = *(const LAS f32x4*)(slot + j * 1024 + lane * 16);
#endif
          LDS_WAIT(); asm volatile("" ::: "memory"); }
        if (has_next) peer_tok_scales(Tn, scU, scV);
        float* xr = xs + (size_t)m * D;
#else
        if (has_next) peer_tok_scales(Tn, scU, scV);
        float* xr = xs + (size_t)m * D;
        f32x4 x[4];
#endif
#if PEER_RESDMA
#elif XB16
        { const u32x4 x0 = *((const u32x4*)(xg + (size_t)m * D) + 2 * lane), x1 = *((const u32x4*)(xg + (size_t)m * D) + 2 * lane + 1);
          x[0] = (f32x4){bflo(x0.x), bfhi(x0.x), bflo(x0.y), bfhi(x0.y)}; x[1] = (f32x4){bflo(x0.z), bfhi(x0.z), bflo(x0.w), bfhi(x0.w)};
          x[2] = (f32x4){bflo(x1.x), bfhi(x1.x), bflo(x1.y), bfhi(x1.y)}; x[3] = (f32x4){bflo(x1.z), bfhi(x1.z), bflo(x1.w), bfhi(x1.w)}; }
#else
#pragma unroll
        for (int j = 0; j < 4; ++j) x[j] = *((const f32x4*)xr + 4 * lane + j);
#endif
        float sq = 0.f;
#pragma unroll
        for (int j = 0; j < 4; ++j)
#pragma unroll
            for (int i = 0; i < 4; ++i) { x[j][i] += (float)acc[2 * j + (i >> 1)][i & 1]; sq += x[j][i] * x[j][i]; }
        sq = wave_sum(sq);
        const float rn = __builtin_amdgcn_rsqf(sq * (1.0f / D) + EPS);
        if (!(DRY && rn != 12345.678f)) {
        f32x4 gg[4];
        if (LAST || !XB16) {
#pragma unroll
        for (int j = 0; j < 4; ++j) gg[j] = *((const f32x4*)gnext + 4 * lane + j);
        }
        if (LAST) {
#pragma unroll
            for (int j = 0; j < 4; ++j) *((f32x4*)xr + 4 * lane + j) = x[j] * gg[j] * rn;
        } else {
#if XB16
            u32x4 o0, o1; const f32x4 y0 = x[0], y1 = x[1], y2 = x[2], y3 = x[3];
#else
#pragma unroll
            for (int j = 0; j < 4; ++j) *((f32x4*)xr + 4 * lane + j) = x[j];
            u32x4 o0, o1; const f32x4 y0 = x[0] * gg[0], y1 = x[1] * gg[1], y2 = x[2] * gg[2], y3 = x[3] * gg[3];
#endif
            o0.x = pk2(y0[0], y0[1]); o0.y = pk2(y0[2], y0[3]); o0.z = pk2(y1[0], y1[1]); o0.w = pk2(y1[2], y1[3]);
            o1.x = pk2(y2[0], y2[1]); o1.y = pk2(y2[2], y2[3]); o1.z = pk2(y3[0], y3[1]); o1.w = pk2(y3[2], y3[3]);
#if XB16 && OUT_PREFILL == 2
            xr[16 * lane] = 0.f;
#endif
            bf16_t* const xw = XB16 ? xo : xg;
            *((u32x4*)(xw + (size_t)m * D) + 2 * lane) = o0; *((u32x4*)(xw + (size_t)m * D) + 2 * lane + 1) = o1;
            if (GATE_F8) { u32x4 o8; o8.x = pk4_fp8(y0[0], y0[1], y0[2], y0[3]); o8.y = pk4_fp8(y1[0], y1[1], y1[2], y1[3]); o8.z = pk4_fp8(y2[0], y2[1], y2[2], y2[3]); o8.w = pk4_fp8(y3[0], y3[1], y3[2], y3[3]);
                *((u32x4*)(h8p + (size_t)m * D) + lane) = o8; }
            if (lane == 0) st_wt(rstd1 + m, rn);
        }
        }
        T = Tn;
    }
}

constexpr int PS_WAVE = 12800, PS_AC = 0, PS_EID = 8192, PS_SH = 12288;
__device__ __forceinline__ void peer_fma8_v(const u32x2 (&buf)[8], unsigned cp0, unsigned cp1, int kbase, h2_t (&acc)[8]) {
#pragma unroll
    for (int e = 0; e < 8; ++e) { const int k = kbase + e; const h2_t ck = as_h2((unsigned)__builtin_amdgcn_readlane((int)(k < 64 ? cp0 : cp1), k & 63));
        const unsigned w4[2] = {buf[e].x, buf[e].y};
#pragma unroll
        for (int dd = 0; dd < 2; ++dd) {
#pragma unroll
            for (int sl = 0; sl < 4; ++sl) { h2_t pv;
                if (sl == 0) pv = __builtin_amdgcn_cvt_scalef32_pk_f16_fp4(w4[dd], 1.0f, 0); else if (sl == 1) pv = __builtin_amdgcn_cvt_scalef32_pk_f16_fp4(w4[dd], 1.0f, 1);
                else if (sl == 2) pv = __builtin_amdgcn_cvt_scalef32_pk_f16_fp4(w4[dd], 1.0f, 2); else pv = __builtin_amdgcn_cvt_scalef32_pk_f16_fp4(w4[dd], 1.0f, 3);
                acc[4 * dd + sl] = __builtin_elementwise_fma(pv, ck, acc[4 * dd + sl]); } } }
}
__device__ __forceinline__ void peer_load8_v(const unsigned char* tabV, int e0, int e1, int kbase, int lane, u32x2 (&buf)[8]) {
#pragma unroll
    for (int e = 0; e < 8; ++e) { const int k = kbase + e; const int ex = __builtin_amdgcn_readlane(k < 64 ? e0 : e1, k & 63);
        buf[e] = *((const u32x2*)(tabV + (size_t)ex * 512) + lane); }
}
__device__ __forceinline__ void ps_issue(LAS unsigned char* wl, int i, const unsigned char* uslice, int r, int p, u32x2 (&rows)[16]) {
    const u32x4 w0 = *(const LAS u32x4*)(wl + PS_EID + i * 256 + r * 32), w1 = *(const LAS u32x4*)(wl + PS_EID + i * 256 + r * 32 + 16);
    const unsigned w[8] = {w0.x, w0.y, w0.z, w0.w, w1.x, w1.y, w1.z, w1.w};
#pragma unroll
    for (int j = 0; j < 16; ++j) { const unsigned e = (j & 1) ? (w[j >> 1] >> 16) : (w[j >> 1] & 0xffffu); rows[j] = *(const u32x2*)(uslice + (size_t)e * 64 + p * 8); }
}
__device__ __forceinline__ void ps_consume(LAS unsigned char* wl, int i, const u32x2 (&rows)[16], const u32x4& hq4, int lane) {
    const unsigned hq[4] = {hq4.x, hq4.y, hq4.z, hq4.w};
    int d[16];
#pragma unroll
    for (int j = 0; j < 16; ++j) d[j] = idot16(rows[j], hq);
    const bool b2 = lane & 4, b1 = lane & 2, b0 = lane & 1;
    int r8[8], r4[4], r2[2];
#pragma unroll
    for (int k = 0; k < 8; ++k) { const int keep = b2 ? d[8 + k] : d[k], send = b2 ? d[k] : d[8 + k]; r8[k] = keep + shx<4>(send); }
#pragma unroll
    for (int k = 0; k < 4; ++k) { const int keep = b1 ? r8[4 + k] : r8[k], send = b1 ? r8[k] : r8[4 + k]; r4[k] = keep + shx<2>(send); }
#pragma unroll
    for (int k = 0; k < 2; ++k) { const int keep = b0 ? r4[2 + k] : r4[k], send = b0 ? r4[k] : r4[2 + k]; r2[k] = keep + shx<1>(send); }
    LAS int* ap = (LAS int*)(wl + PS_AC + i * 512) + (lane >> 3) * 16 + 2 * (lane & 7);
    const int o0 = ap[0], o1 = ap[1]; ap[0] = o0 + r2[0]; ap[1] = o1 + r2[1];
}
template <bool LAST, bool DRY = false>
__device__ __forceinline__ void peer_sweep(const Ctx& C, const unsigned char* tabUs, const unsigned char* tabV, const float* scU, const float* scV, const int* idx, const float* gate, const float* ss2,
                                           float* xs, bf16_t* xg, const float* gnext, float* rstd1, unsigned char* hqbuf) {
    const int lane = C.lane, r = lane >> 3, p = lane & 7;
    LAS unsigned char* wl = C.lds + C.wave * PS_WAVE;
#pragma unroll 1
    for (int i = 0; i < 16; ++i) {
        const int m = C.gw + i * C.ngw;
        const int e0 = idx[(size_t)m * 128 + lane], e1 = idx[(size_t)m * 128 + 64 + lane];
        const int p0 = (lane & 7) * 16 + (lane >> 3), p1 = p0 + 8;
        *(LAS unsigned short*)(wl + PS_EID + i * 256 + p0 * 2) = (unsigned short)e0; *(LAS unsigned short*)(wl + PS_EID + i * 256 + p1 * 2) = (unsigned short)e1;
        ((LAS int*)(wl + PS_AC + i * 512))[lane] = 0; ((LAS int*)(wl + PS_AC + i * 512))[64 + lane] = 0;
        const float rs = pg8::row_rs(ss2, m);
        const u32x4 x0 = *((const u32x4*)(xg + (size_t)m * D) + 2 * lane), x1 = *((const u32x4*)(xg + (size_t)m * D) + 2 * lane + 1);
        const unsigned w[8] = {x0.x, x0.y, x0.z, x0.w, x1.x, x1.y, x1.z, x1.w};
        float hv[16]; float mxh = 0.f;
#pragma unroll
        for (int q = 0; q < 8; ++q) { hv[2 * q] = bflo(w[q]) * rs; hv[2 * q + 1] = bfhi(w[q]) * rs; mxh = fmaxf(mxh, fmaxf(fabsf(hv[2 * q]), fabsf(hv[2 * q + 1]))); }
        mxh = wave_max(mxh);
        const float sh = fmaxf(mxh, 1e-30f) * (1.0f / 119.0f), inv = 1.0f / sh;
        unsigned hh[4];
#pragma unroll
        for (int dd = 0; dd < 2; ++dd) { unsigned th = 0u, tl = 0u;
#pragma unroll
            for (int j = 0; j < 8; ++j) { const int q8 = (int)rintf(hv[8 * dd + j] * inv), hi = (q8 + 8) >> 4, lo = q8 - (hi << 4); th |= ((unsigned)hi & 15u) << (4 * j); tl |= ((unsigned)lo & 15u) << (4 * j); }
            hh[dd] = th; hh[2 + dd] = tl; }
        *((u32x4*)(hqbuf + (size_t)m * 1024) + lane) = (u32x4){hh[0], hh[1], hh[2], hh[3]};
        if (lane == 0) ((LAS float*)(wl + PS_SH))[i] = sh;
    }
    asm volatile("s_waitcnt vmcnt(0) lgkmcnt(0)" ::: "memory");
#pragma unroll 1
    for (int s = 0; s < 8; ++s) {
        const unsigned char* uslice = tabUs + (size_t)s * MiB;
        u32x2 rA[16], rB[16]; u32x4 hA, hB;
        ps_issue(wl, 0, uslice, r, p, rA); hA = *((const u32x4*)(hqbuf + (size_t)C.gw * 1024) + s * 8 + p);
#pragma unroll 1
        for (int i = 0; i < 16; i += 2) {
            ps_issue(wl, i + 1, uslice, r, p, rB); hB = *((const u32x4*)(hqbuf + (size_t)(C.gw + (i + 1) * C.ngw) * 1024) + s * 8 + p);
            ps_consume(wl, i, rA, hA, lane);
            if (i + 2 < 16) { ps_issue(wl, i + 2, uslice, r, p, rA); hA = *((const u32x4*)(hqbuf + (size_t)(C.gw + (i + 2) * C.ngw) * 1024) + s * 8 + p); }
            ps_consume(wl, i + 1, rB, hB, lane);
        }
    }
#pragma unroll 1
    for (int i = 0; i < 16; ++i) {
        const int m = C.gw + i * C.ngw; const float sh = ((LAS float*)(wl + PS_SH))[i];
#pragma unroll
        for (int hf = 0; hf < 2; ++hf) { const int pos = lane + 64 * hf, k = (pos & 15) * 8 + (pos >> 4);
            const int e = *(LAS unsigned short*)(wl + PS_EID + i * 256 + pos * 2); const int a = ((LAS int*)(wl + PS_AC + i * 512))[pos];
            const float g = gate[(size_t)m * 128 + k], su = scU[e], sv = scV[e];
            const float c = ABL_PEER ? 0.f : g * gelu_tanh((float)a * (su * sh)) * sv;
            ((LAS float*)(wl + PS_AC + i * 512))[pos] = c; }
    }
#pragma unroll 1
    for (int i = 0; i < 16; ++i) {
        const int m = C.gw + i * C.ngw;
        const int e0 = idx[(size_t)m * 128 + lane], e1 = idx[(size_t)m * 128 + 64 + lane];
        const int p0 = (lane & 7) * 16 + (lane >> 3);
        const float c0 = ((LAS float*)(wl + PS_AC + i * 512))[p0], c1 = ((LAS float*)(wl + PS_AC + i * 512))[p0 + 8];
        h2_t acc[8];
#pragma unroll
        for (int q = 0; q < 8; ++q) acc[q] = (h2_t){(_Float16)0.f, (_Float16)0.f};
        const unsigned cp0 = pkh2(c0, c0), cp1 = pkh2(c1, c1);
        u32x2 bA[8], bB[8];
        peer_load8_v(tabV, e0, e1, 0, lane, bA);
#pragma unroll 1
        for (int j = 0; j < 16; j += 2) {
            peer_load8_v(tabV, e0, e1, 8 * (j + 1), lane, bB); peer_fma8_v(bA, cp0, cp1, 8 * j, acc);
            if (j + 2 < 16) peer_load8_v(tabV, e0, e1, 8 * (j + 2), lane, bA);
            peer_fma8_v(bB, cp0, cp1, 8 * (j + 1), acc);
        }
        float* xr = xs + (size_t)m * D;
        f32x4 x[4];
#pragma unroll
        for (int j = 0; j < 4; ++j) x[j] = *((const f32x4*)xr + 4 * lane + j);
        float sq = 0.f;
#pragma unroll
        for (int j = 0; j < 4; ++j)
#pragma unroll
            for (int q = 0; q < 4; ++q) { x[j][q] += (float)acc[2 * j + (q >> 1)][q & 1]; sq += x[j][q] * x[j][q]; }
        sq = wave_sum(sq);
        const float rn = __builtin_amdgcn_rsqf(sq * (1.0f / D) + EPS);
        if (!(DRY && rn != 12345.678f)) {
        f32x4 gg[4];
#pragma unroll
        for (int j = 0; j < 4; ++j) gg[j] = *((const f32x4*)gnext + 4 * lane + j);
        if (LAST) {
#pragma unroll
            for (int j = 0; j < 4; ++j) *((f32x4*)xr + 4 * lane + j) = x[j] * gg[j] * rn;
        } else {
#pragma unroll
            for (int j = 0; j < 4; ++j) *((f32x4*)xr + 4 * lane + j) = x[j];
            u32x4 o0, o1; const f32x4 y0 = x[0] * gg[0], y1 = x[1] * gg[1], y2 = x[2] * gg[2], y3 = x[3] * gg[3];
            o0.x = pk2(y0[0], y0[1]); o0.y = pk2(y0[2], y0[3]); o0.z = pk2(y1[0], y1[1]); o0.w = pk2(y1[2], y1[3]);
            o1.x = pk2(y2[0], y2[1]); o1.y = pk2(y2[2], y2[3]); o1.z = pk2(y3[0], y3[1]); o1.w = pk2(y3[2], y3[3]);
            *((u32x4*)(xg + (size_t)m * D) + 2 * lane) = o0; *((u32x4*)(xg + (size_t)m * D) + 2 * lane + 1) = o1;
            if (GATE_F8) { u32x4 o8; o8.x = pk4_fp8(y0[0], y0[1], y0[2], y0[3]); o8.y = pk4_fp8(y1[0], y1[1], y1[2], y1[3]); o8.z = pk4_fp8(y2[0], y2[1], y2[2], y2[3]); o8.w = pk4_fp8(y3[0], y3[1], y3[2], y3[3]);
                *((u32x4*)((unsigned char*)xg + (WS_H8 - WS_E) + (size_t)m * D) + lane) = o8; }
            if (lane == 0) st_wt(rstd1 + m, rn);
        }
        }
    }
}

typedef int v8i_t __attribute__((ext_vector_type(8)));
constexpr int PM_WAVE = 2048, PM_H = 0, PM_A = 1024;
#define PM_MFMA8(ACC, UA, BF, SC) asm volatile("s_nop 4\n\t" \
    "v_mfma_scale_f32_16x16x128_f8f6f4 %0, %1, %9, %0, %17, %17 op_sel_hi:[0,0,0] cbsz:4\n\t" \
    "v_mfma_scale_f32_16x16x128_f8f6f4 %0, %2, %10, %0, %17, %17 op_sel_hi:[0,0,0] cbsz:4\n\t" \
    "v_mfma_scale_f32_16x16x128_f8f6f4 %0, %3, %11, %0, %17, %17 op_sel_hi:[0,0,0] cbsz:4\n\t" \
    "v_mfma_scale_f32_16x16x128_f8f6f4 %0, %4, %12, %0, %17, %17 op_sel_hi:[0,0,0] cbsz:4\n\t" \
    "v_mfma_scale_f32_16x16x128_f8f6f4 %0, %5, %13, %0, %17, %17 op_sel_hi:[0,0,0] cbsz:4\n\t" \
    "v_mfma_scale_f32_16x16x128_f8f6f4 %0, %6, %14, %0, %17, %17 op_sel_hi:[0,0,0] cbsz:4\n\t" \
    "v_mfma_scale_f32_16x16x128_f8f6f4 %0, %7, %15, %0, %17, %17 op_sel_hi:[0,0,0] cbsz:4\n\t" \
    "v_mfma_scale_f32_16x16x128_f8f6f4 %0, %8, %16, %0, %17, %17 op_sel_hi:[0,0,0] cbsz:4\n\t" \
    "s_nop 15\n\ts_nop 7" \
    : "+v"(ACC) : "v"(UA[0]), "v"(UA[1]), "v"(UA[2]), "v"(UA[3]), "v"(UA[4]), "v"(UA[5]), "v"(UA[6]), "v"(UA[7]), \
      "v"(BF[0]), "v"(BF[1]), "v"(BF[2]), "v"(BF[3]), "v"(BF[4]), "v"(BF[5]), "v"(BF[6]), "v"(BF[7]), "v"(SC))
struct TokM { int e0, e1; float g0, g1, su0, su1, sv0, sv1; int er[8]; };
__device__ __forceinline__ void tokm_idx(TokM& T, int m, const int* idx, const float* gate, int lane) {
    T.e0 = idx[(size_t)m * 128 + lane]; T.e1 = idx[(size_t)m * 128 + 64 + lane]; T.g0 = gate[(size_t)m * 128 + lane]; T.g1 = gate[(size_t)m * 128 + 64 + lane];
#pragma unroll
    for (int mb = 0; mb < 8; ++mb) T.er[mb] = idx[(size_t)m * 128 + 16 * mb + (lane & 15)];
}
__device__ __forceinline__ void tokm_scales(TokM& T, const float* scU, const float* scV) { T.su0 = scU[T.e0]; T.su1 = scU[T.e1]; T.sv0 = scV[T.e0]; T.sv1 = scV[T.e1]; }
__device__ __forceinline__ void pm_issue_u(const unsigned char* tab, int er, int quad, u32x4 (&ua)[8]) {
    const u32x4* bp = (const u32x4*)(tab + (size_t)er * 1024 + 16 * quad);
#pragma unroll
    for (int kb = 0; kb < 8; ++kb) ua[kb] = bp[4 * kb];
}
__device__ __forceinline__ void pm_issue_v(int grp, const unsigned char* tab, const TokM& T, int lane, u32x2 (&buf)[8]) {
#pragma unroll
    for (int e = 0; e < 8; ++e) { const int k = 8 * grp + e; const int ex = __builtin_amdgcn_readlane(k < 64 ? T.e0 : T.e1, k & 63);
        buf[e] = *((const u32x2*)(tab + (size_t)ex * 1024 + 512) + lane); }
}
__device__ __forceinline__ void pm_fma_v(const u32x2 (&buf)[8], unsigned cp0, unsigned cp1, int grp, h2_t (&acc)[8]) {
#pragma unroll
    for (int e = 0; e < 8; ++e) { const int k = 8 * grp + e; const h2_t ck = as_h2((unsigned)__builtin_amdgcn_readlane((int)(k < 64 ? cp0 : cp1), k & 63));
        const unsigned w4[2] = {buf[e].x, buf[e].y};
#pragma unroll
        for (int dd = 0; dd < 2; ++dd) {
#pragma unroll
            for (int sl = 0; sl < 4; ++sl) { h2_t pv;
                if (sl == 0) pv = __builtin_amdgcn_cvt_scalef32_pk_f16_fp4(w4[dd], 1.0f, 0); else if (sl == 1) pv = __builtin_amdgcn_cvt_scalef32_pk_f16_fp4(w4[dd], 1.0f, 1);
                else if (sl == 2) pv = __builtin_amdgcn_cvt_scalef32_pk_f16_fp4(w4[dd], 1.0f, 2); else pv = __builtin_amdgcn_cvt_scalef32_pk_f16_fp4(w4[dd], 1.0f, 3);
                acc[4 * dd + sl] = __builtin_elementwise_fma(pv, ck, acc[4 * dd + sl]); } } }
}
template <bool LAST, bool DRY = false>
__device__ __forceinline__ void peer_tokens_mf(const Ctx& C, int m0, int step, const unsigned char* tab, const float* scU, const float* scV, const int* idx, const float* gate, const float* ss2,
                                               float* xs, bf16_t* xg, const float* gnext, float* rstd1) {
    const int lane = C.lane, n16 = lane & 15, quad = lane >> 4;
    if (m0 >= M) return;
    LAS unsigned char* wl = C.lds + C.wave * PM_WAVE;
    TokM T, Tn;
    tokm_idx(T, m0, idx, gate, lane); tokm_scales(T, scU, scV);
    unsigned e8m0_one = 0x7F7F7F7Fu; asm volatile("" : "+v"(e8m0_one));
    for (int m = m0; m < M; m += step) {
        const int mn = m + step; const bool has_next = mn < M;
        u32x4 uA[8], uB[8];
        pm_issue_u(tab, T.er[0], quad, uA);
        if (has_next) tokm_idx(Tn, mn, idx, gate, lane);
        const float rs = pg8::row_rs(ss2, m);
        float sh;
        { const u32x4 x0 = *((const u32x4*)(xg + (size_t)m * D) + 2 * lane), x1 = *((const u32x4*)(xg + (size_t)m * D) + 2 * lane + 1);
          const unsigned w[8] = {x0.x, x0.y, x0.z, x0.w, x1.x, x1.y, x1.z, x1.w};
          float hv[16]; float mxh = 0.f;
#pragma unroll
          for (int q = 0; q < 8; ++q) { hv[2 * q] = bflo(w[q]) * rs; hv[2 * q + 1] = bfhi(w[q]) * rs; mxh = fmaxf(mxh, fmaxf(fabsf(hv[2 * q]), fabsf(hv[2 * q + 1]))); }
          mxh = wave_max(mxh);
          sh = fmaxf(mxh, 1e-30f) * (1.0f / 240.0f); const float inv = 1.0f / sh;
          unsigned hb[4];
#pragma unroll
          for (int q = 0; q < 4; ++q) { unsigned t = __builtin_amdgcn_cvt_pk_fp8_f32(hv[4 * q] * inv, hv[4 * q + 1] * inv, 0u, false); hb[q] = __builtin_amdgcn_cvt_pk_fp8_f32(hv[4 * q + 2] * inv, hv[4 * q + 3] * inv, t, true); }
          *(LAS u32x4*)(wl + PM_H + 16 * lane) = (u32x4){hb[0], hb[1], hb[2], hb[3]}; }
        v8i_t bfr[8];
#pragma unroll
        for (int kb = 0; kb < 8; ++kb) { const u32x4 b0 = *(const LAS u32x4*)(wl + PM_H + 128 * kb + 16 * quad), b1 = *(const LAS u32x4*)(wl + PM_H + 128 * kb + 64 + 16 * quad);
            bfr[kb] = (v8i_t){(int)b0.x, (int)b0.y, (int)b0.z, (int)b0.w, (int)b1.x, (int)b1.y, (int)b1.z, (int)b1.w}; }
#pragma unroll
        for (int mb = 0; mb < 8; ++mb) {
            if (mb + 1 < 8) { if (mb & 1) pm_issue_u(tab, T.er[mb + 1], quad, uA); else pm_issue_u(tab, T.er[mb + 1], quad, uB); }
            f32x4 acc = {0.f, 0.f, 0.f, 0.f};
            if (mb & 1) PM_MFMA8(acc, uB, bfr, e8m0_one); else PM_MFMA8(acc, uA, bfr, e8m0_one);
            *(LAS f32x4*)(wl + PM_A + (16 * mb + 4 * quad) * 4) = acc;
        }
        const float a0 = ((const LAS float*)(wl + PM_A))[lane], a1 = ((const LAS float*)(wl + PM_A))[64 + lane];
        const float c0 = ABL_PEER ? 0.f : T.g0 * gelu_tanh(a0 * (T.su0 * sh)) * T.sv0, c1 = ABL_PEER ? 0.f : T.g1 * gelu_tanh(a1 * (T.su1 * sh)) * T.sv1;
        const unsigned cp0 = pkh2(c0, c0), cp1 = pkh2(c1, c1);
        if (has_next) tokm_scales(Tn, scU, scV);
        h2_t acc[8];
#pragma unroll
        for (int i = 0; i < 8; ++i) acc[i] = (h2_t){(_Float16)0.f, (_Float16)0.f};
        u32x2 vA[8], vB[8];
        pm_issue_v(0, tab, T, lane, vA);
#pragma unroll 1
        for (int j = 0; j < 16; j += 2) {
            pm_issue_v(j + 1, tab, T, lane, vB); pm_fma_v(vA, cp0, cp1, j, acc);
            if (j + 2 < 16) pm_issue_v(j + 2, tab, T, lane, vA);
            pm_fma_v(vB, cp0, cp1, j + 1, acc);
        }
        float* xr = xs + (size_t)m * D;
        f32x4 x[4];
#pragma unroll
        for (int j = 0; j < 4; ++j) x[j] = *((const f32x4*)xr + 4 * lane + j);
        float sq = 0.f;
#pragma unroll
        for (int j = 0; j < 4; ++j)
#pragma unroll
            for (int i = 0; i < 4; ++i) { x[j][i] += (float)acc[2 * j + (i >> 1)][i & 1]; sq += x[j][i] * x[j][i]; }
        sq = wave_sum(sq);
        const float rn = __builtin_amdgcn_rsqf(sq * (1.0f / D) + EPS);
        if (!(DRY && rn != 12345.678f)) {
        f32x4 gg[4];
#pragma unroll
        for (int j = 0; j < 4; ++j) gg[j] = *((const f32x4*)gnext + 4 * lane + j);
        if (LAST) {
#pragma unroll
            for (int j = 0; j < 4; ++j) *((f32x4*)xr + 4 * lane + j) = x[j] * gg[j] * rn;
        } else {
#pragma unroll
            for (int j = 0; j < 4; ++j) *((f32x4*)xr + 4 * lane + j) = x[j];
            u32x4 o0, o1; const f32x4 y0 = x[0] * gg[0], y1 = x[1] * gg[1], y2 = x[2] * gg[2], y3 = x[3] * gg[3];
            o0.x = pk2(y0[0], y0[1]); o0.y = pk2(y0[2], y0[3]); o0.z = pk2(y1[0], y1[1]); o0.w = pk2(y1[2], y1[3]);
            o1.x = pk2(y2[0], y2[1]); o1.y = pk2(y2[2], y2[3]); o1.z = pk2(y3[0], y3[1]); o1.w = pk2(y3[2], y3[3]);
            *((u32x4*)(xg + (size_t)m * D) + 2 * lane) = o0; *((u32x4*)(xg + (size_t)m * D) + 2 * lane + 1) = o1;
            if (GATE_F8) { u32x4 o8; o8.x = pk4_fp8(y0[0], y0[1], y0[2], y0[3]); o8.y = pk4_fp8(y1[0], y1[1], y1[2], y1[3]); o8.z = pk4_fp8(y2[0], y2[1], y2[2], y2[3]); o8.w = pk4_fp8(y3[0], y3[1], y3[2], y3[3]);
                *((u32x4*)((unsigned char*)xg + (WS_H8 - WS_E) + (size_t)m * D) + lane) = o8; }
            if (lane == 0) st_wt(rstd1 + m, rn);
        }
        }
        T = Tn;
    }
}
typedef __attribute__((address_space(1))) unsigned gu32;
#define XB_TMO      128
#define XB_XCNT(j)  (256  + 64 * (j))
#define XB_XSUB(j)  (1280 + 64 * (j))
#define XB_XGEN(j)  (2304 + 64 * (j))
#define XB_TOP      3328
#define XB_TOPGEN   3392
#define XCD_BAR_WORDS 3456
#define XB_SPIN_CAP (1u << 18)

__device__ __forceinline__ unsigned xb_ld(unsigned* p)              { return __hip_atomic_load(p, __ATOMIC_RELAXED, __HIP_MEMORY_SCOPE_AGENT); }
__device__ __forceinline__ unsigned xb_add(unsigned* p, unsigned v) { return __hip_atomic_fetch_add(p, v, __ATOMIC_RELAXED, __HIP_MEMORY_SCOPE_AGENT); }
__device__ __forceinline__ unsigned xb_xcc_id() { return (unsigned)__builtin_amdgcn_s_getreg((3 << 11) | 20) & 0xFu; }
#define XB_SPIN(cond, bar) do { unsigned _sp = 0; while (cond) { __builtin_amdgcn_s_sleep(1); \
    if ((++_sp & 255u) == 0u) { if (xb_ld(&(bar)[XB_TMO])) break; if (_sp > XB_SPIN_CAP) { atomicAdd(&(bar)[XB_TMO], 1u); break; } } } } while (0)

struct XcdBarrier {
    unsigned* bar; unsigned x;
    volatile LAS unsigned* st;
};

__device__ __forceinline__ XcdBarrier xcd_barrier_post(unsigned* bar, volatile LAS unsigned* st) {
    XcdBarrier b; b.bar = bar; b.x = xb_xcc_id(); b.st = st;
    if (threadIdx.x == 0) (void)xb_add(&bar[XB_XCNT(b.x)], 1u);
    return b;
}
__device__ __forceinline__ void xcd_barrier_complete(unsigned* bar, unsigned x, unsigned& nloc, unsigned& nx) {
    const unsigned G = gridDim.x * gridDim.y * gridDim.z;
    unsigned sum, cnt, mine, sp = 0u;
    for (;;) {
        sum = 0u; cnt = 0u; mine = 0u;
#pragma unroll
        for (unsigned j = 0; j < 16; ++j) { const unsigned c = xb_ld(&bar[XB_XCNT(j)]); sum += c; cnt += (c > 0u) ? 1u : 0u; mine = (j == x) ? c : mine; }
        if (sum == G) break;
        __builtin_amdgcn_s_sleep(1);
        if ((++sp & 255u) == 0u) { if (xb_ld(&bar[XB_TMO])) break; if (sp > XB_SPIN_CAP) { atomicAdd(&bar[XB_TMO], 1u); break; } }
    }
    nloc = mine > 0u ? mine : 1u; nx = cnt > 0u ? cnt : 1u;
}

template <bool FIRST>
__device__ __forceinline__ void xcd_barrier(unsigned* bar_, volatile LAS unsigned* st_, int tid0) {
    XcdBarrier b; b.bar = bar_; b.x = xb_xcc_id(); b.st = st_;
    asm volatile("s_waitcnt vmcnt(0)" ::: "memory");
#if XB_SAFE == 8
    __builtin_amdgcn_fence(__ATOMIC_RELEASE, "agent");
    asm volatile("s_waitcnt vmcnt(0)" ::: "memory");
#endif
    __syncthreads();
    if (tid0 == 0) {
        unsigned* bar = b.bar;
        __builtin_amdgcn_s_waitcnt(0);
#if XB_SAFE == 4
        __builtin_amdgcn_fence(__ATOMIC_RELEASE, "");
        asm volatile("s_waitcnt vmcnt(0)" ::: "memory");
#endif
#if XB_SAFE == 1 || XB_SAFE == 2 || XB_SAFE == 5 || XB_SAFE == 8
        __builtin_amdgcn_fence(__ATOMIC_RELEASE, "agent");
        asm volatile("s_waitcnt vmcnt(0)" ::: "memory");
#endif
        unsigned nloc = b.st[0], nx = b.st[1];
        if constexpr (FIRST) { xcd_barrier_complete(bar, b.x, nloc, nx); b.st[0] = nloc; b.st[1] = nx; }
        const unsigned old = xb_add(&bar[XB_XSUB(b.x)], 1u);
        const unsigned gen = old / nloc;
        if (old + 1u == (gen + 1u) * nloc) {
            __builtin_amdgcn_fence(__ATOMIC_RELEASE, "agent");
            asm volatile("s_waitcnt vmcnt(0)" ::: "memory");
            const unsigned og = xb_add(&bar[XB_TOP], 1u);
            const unsigned tg = og / nx;
            if (og + 1u == (tg + 1u) * nx) xb_add(&bar[XB_TOPGEN], 1u);
            else XB_SPIN(xb_ld(&bar[XB_TOPGEN]) == tg, bar);
#if XB_SAFE == 4 || XB_SAFE == 5 || XB_SAFE == 6 || XB_SAFE == 8
            __builtin_amdgcn_fence(__ATOMIC_ACQUIRE, "");
#if XB_INVWAIT
            asm volatile("s_waitcnt vmcnt(0)" ::: "memory");
#endif
#endif
            __builtin_amdgcn_fence(__ATOMIC_ACQUIRE, "agent");
            xb_add(&bar[XB_XGEN(b.x)], 1u);
            asm volatile("s_waitcnt vmcnt(0)" ::: "memory");
        } else {
            XB_SPIN(xb_ld(&bar[XB_XGEN(b.x)]) == gen, bar);
#if XB_SAFE == 4
            __builtin_amdgcn_fence(__ATOMIC_ACQUIRE, "");
#endif
            __builtin_amdgcn_fence(__ATOMIC_ACQUIRE, "agent");
            asm volatile("s_waitcnt vmcnt(0)" ::: "memory");
        }
    }
    __syncthreads();
#if XB_SAFE == 1 || XB_SAFE == 3
    __builtin_amdgcn_fence(__ATOMIC_ACQUIRE, "agent");
    asm volatile("s_waitcnt vmcnt(0)" ::: "memory");
    __syncthreads();
#endif
}

constexpr int LDS_BYTES = 147456;
#ifndef MK_SYNC_CG
#define MK_SYNC_CG 1
#endif

__device__ __forceinline__ int lane_now() { int l; asm volatile("v_mbcnt_lo_u32_b32 %0, -1, 0\n\tv_mbcnt_hi_u32_b32 %0, -1, %0" : "=v"(l)); return l; }
__device__ __forceinline__ Ctx make_ctx(LAS unsigned char* lds, int tidx) {
    Ctx C; int tid = tidx; asm volatile("" : "+v"(tid));
    C.tid = tid; C.lane = tid & 63; C.wave = __builtin_amdgcn_readfirstlane(tid >> 6); C.G = gridDim.x; C.bid = blockIdx.x;
    C.gw = C.bid * NWAVES + C.wave; C.ngw = C.G * NWAVES; C.gt = C.bid * NTHREADS + tid; C.ngt = C.G * NTHREADS; C.lds = lds;
    return C;
}
template <class Epi, bool F8 = false>
__device__ __forceinline__ void run_gemm(const Ctx& C, const bf16_t* A, int lda, const bf16_t* Bt, int ldb, int N, int K, const Epi& E) {
    pg8::Gemm g{A, Bt, M, N, K, lda, ldb}; pg8::StaticOrder S; S.init(M, N, C.G, C.bid);
    pg8::gemm_phase<Epi, pg8::StaticOrder, true, true, F8>(C.lds, g, S, E, C.tid);
}

__device__ __forceinline__ const void* karg(int i) {
    const __attribute__((address_space(4))) unsigned long long* ka = (const __attribute__((address_space(4))) unsigned long long*)__builtin_amdgcn_kernarg_segment_ptr();
    int z = 0; asm volatile("" : "+s"(z));
    return (const void*)(const __attribute__((address_space(1))) void*)ka[i + z];
}
#define KWS() ((unsigned char*)karg(27))
#define KIN(i) ((const float*)karg(i))


#if PEER_SLICED
#define PEER_CALL(LAST_, DRY_) PEER_CALL_S_<LAST_, DRY_>
template <bool LAST, bool DRY>
__device__ __forceinline__ void PEER_CALL_S_(const Ctx& C, unsigned char* ws, const unsigned char* tab, const float* scU, const float* scV, const int* idx, const float* gate, const float* ssp, float* xs, bf16_t* xg, const float* gn, float* rstd1) {
    peer_sweep<LAST, DRY>(C, tab, tab + 16 * MiB, scU, scV, idx, gate, ssp, xs, xg, gn, rstd1, ws + WS_HQ);
}
#else
#define PEER_CALL(LAST_, DRY_) PEER_CALL_T_<LAST_, DRY_>
template <bool LAST, bool DRY>
__device__ __forceinline__ void PEER_CALL_T_(const Ctx& C, unsigned char* ws, const unsigned char* tab, const float* scU, const float* scV, const int* idx, const float* gate, const float* ssp, float* xs, bf16_t* xg, const float* gn, float* rstd1, const float* g2 = nullptr, bf16_t* xo = nullptr) {
#if PEER_MFMA
    peer_tokens_mf<LAST, DRY>(C, C.gw, C.ngw, tab, scU, scV, idx, gate, ssp, xs, xg, gn, rstd1);
#else
    peer_tokens<LAST, DRY>(C, C.gw, C.ngw, tab, scU, scV, idx, gate, ssp, xs, xg, gn, rstd1, g2, xo, ws + WS_H8);
#endif
}
#endif
#ifndef XB16_INPLACE
#define XB16_INPLACE 1
#endif

#ifndef DBG_WHAT
#define DBG_WHAT 0
#endif
#define DBG_DUMP_RET() do { const Ctx C = MKCTX(); unsigned char* ws = KWS(); float* o = (float*)karg(26); \
    for (size_t i = C.gt; i < (size_t)M * D; i += C.ngt) { const size_t m = i >> 10; const int c = (int)(i & 1023); float v; \
      if (DBG_WHAT == 0) v = bflo((unsigned)((const bf16_t*)(ws + WS_E))[i]); else if (DBG_WHAT == 2) v = bflo((unsigned)((const bf16_t*)(ws + WS_F))[i]); else if (DBG_WHAT == 3) v = bflo((unsigned)((const bf16_t*)(ws + WS_C))[i]); \
      else if (DBG_WHAT == 5) v = bflo((unsigned)((const bf16_t*)(ws + WS_D))[m * QKVW + c]) + 2.0f * bflo((unsigned)((const bf16_t*)(ws + WS_D))[m * QKVW + 1024 + c]); \
      else v = bflo((unsigned)((const bf16_t*)(ws + WS_D))[m * PQ + c]) + 3.0f * bflo((unsigned)((const bf16_t*)(ws + WS_D))[m * PQ + 1024 + c]); \
      o[i] = v; } return; } while (0)
#ifndef DBG_STOP
#define DBG_STOP 0
#endif
#ifndef DBG_LAYER
#define DBG_LAYER 1
#endif
#ifndef DUP_PHASE
#define DUP_PHASE 0
#endif
#ifndef STAG_P1
#define STAG_P1 0
#endif
#ifndef STAG_P5
#define STAG_P5 0
#endif
#ifndef STAG_P6
#define STAG_P6 0
#endif
#ifndef STAG_P7
#define STAG_P7 0
#endif
__device__ __forceinline__ void stagger(unsigned ticks) {
    if (ticks != 0u && blockIdx.x >= 128u) { const unsigned long long t0 = (unsigned long long)wall_clock64(); while ((unsigned long long)wall_clock64() - t0 < ticks) __builtin_amdgcn_s_sleep(16); }
}
#ifndef DUP_LAYER
#define DUP_LAYER -1
#endif
__global__ void __launch_bounds__(NTHREADS, 2) mk_fwd(Args args) {
    extern __shared__ __attribute__((aligned(16))) unsigned char lds_raw[];
    cg::grid_group grid = cg::this_grid();
    const int wid0 = __builtin_amdgcn_readfirstlane((int)threadIdx.x >> 6);
#define TIDX() ((wid0 << 6) | lane_now())
#define MKCTX() make_ctx((LAS unsigned char*)lds_raw, TIDX())
    volatile LAS unsigned* bst = (volatile LAS unsigned*)((LAS unsigned char*)lds_raw + 131072 + 64);
    if (threadIdx.x < 2) bst[threadIdx.x] = 0u;
    __syncthreads();
    (void)xcd_barrier_post((unsigned*)(args.ws + WS_CTL) + 4096, bst);
#define GRID_SYNC() xcd_barrier<false>((unsigned*)(KWS() + WS_CTL) + 4096, (volatile LAS unsigned*)((LAS unsigned char*)lds_raw + 131072 + 64), TIDX())
#define GRID_SYNC_FIRST() xcd_barrier<true>((unsigned*)(KWS() + WS_CTL) + 4096, (volatile LAS unsigned*)((LAS unsigned char*)lds_raw + 131072 + 64), TIDX())
#define GRID_SYNC_CG() do { asm volatile("s_waitcnt vmcnt(0)" ::: "memory"); grid.sync(); if (threadIdx.x == 0) { __builtin_amdgcn_fence(__ATOMIC_ACQUIRE, ""); asm volatile("s_waitcnt vmcnt(0)" ::: "memory"); } __syncthreads(); } while (0)

    for (int rep_ = 0; rep_ < (DUP_PHASE == 10 ? 2 : 1); ++rep_) { const Ctx C = MKCTX(); phase_prologue(C, args); }
#if XB16 && OUT_PREFILL == 1
    { const Ctx C = MKCTX(); f32x4* o = (f32x4*)karg(26); for (size_t i = C.gt; i < (size_t)M * D / 4; i += C.ngt) o[i] = (f32x4){3.0f, 3.0f, 3.0f, 3.0f}; }
#endif
    if (gridDim.y == 0x7fffffffu) GRID_SYNC_CG();
    GRID_SYNC_FIRST();

    if (DUP_PHASE == 11) { for (int rep_ = 0; rep_ < 10; ++rep_) GRID_SYNC(); }
    for (int l = 0; l < DEPTH; ++l) {
#define WL(ws) ((ws) + WS_W + (size_t)l * W_LAYER)
#if XB16 && !XB16_INPLACE
        static_assert(DEPTH == 2, "residual buffer rotation is written for two layers");
#define XA_(ws) (l == 0 ? (bf16_t*)((ws) + WS_E) : (bf16_t*)((unsigned char*)karg(26) + 64 * MiB))
#define X1_(ws) (l == 0 ? (bf16_t*)karg(26) : (bf16_t*)((ws) + WS_E))
#define X2_(ws) ((bf16_t*)((unsigned char*)karg(26) + 64 * MiB))
#else
#define XA_(ws) ((bf16_t*)((ws) + WS_E))
#define X1_(ws) ((bf16_t*)((ws) + WS_E))
#define X2_(ws) ((bf16_t*)((ws) + WS_E))
#endif
        const size_t o_rstd = l == 0 ? WS_RSTD1 : WS_L1, o_lse = l == 0 ? WS_LSE : WS_L1 + 1 * MiB, o_send = l == 0 ? WS_SEND : WS_L1 + 3 * MiB, o_ssp = l == 0 ? WS_SSP : WS_L1 + 5 * MiB;
        const size_t o_rstd_next = WS_L1;
        for (int rep_ = 0; rep_ < ((DUP_PHASE == 1 && (DUP_LAYER < 0 || DUP_LAYER == l)) ? 2 : 1); ++rep_) {
        stagger(STAG_P1);
        { const Ctx C = MKCTX(); unsigned char* ws = KWS(); pg8::EpiZ E{(bf16_t*)(ws + WS_C), (bf16_t*)(ws + WS_D), (const float*)(ws + o_rstd)};
          run_gemm(C, (const bf16_t*)XA_(ws), D, (const bf16_t*)(WL(ws) + WO_WIN), D, NZ, D, E);
#if TABQ_DEFER
          static_assert(DEPTH == 2, "deferred table conversion is written for two layers");
          if (C.G == 256 && C.bid >= 128) { const int iw = (C.bid - 128) * NWAVES + C.wave;
              quant_rows(KIN(I_PU) + (size_t)NEXP * D, KIN(I_PV) + (size_t)NEXP * D, ws + WS_TAB + TAB_LAYER, (float*)(ws + WS_TSC + 131072), (float*)(ws + WS_TSC + 131072 + 65536), (NEXP / 2) * l + iw, (NEXP / 2) * (l + 1), 1024, C.lane);
 }
#endif
        }
        GRID_SYNC();
        }
#if DBG_STOP >= 11 && DBG_STOP <= 18
        if (DBG_STOP == 10 + 1 && l == DBG_LAYER) DBG_DUMP_RET();
#endif
        for (int rep_ = 0; rep_ < ((DUP_PHASE == 2 && (DUP_LAYER < 0 || DUP_LAYER == l)) ? 2 : 1); ++rep_) {
        for (int r2_ = 0; r2_ < (DUP_PHASE == 21 ? 2 : 1); ++r2_)
        { const Ctx C = MKCTX(); unsigned char* ws = KWS();
          attn_items(C, (const bf16_t*)(ws + WS_D), ROPE_FLY ? (const f32x2*)KIN(I_POS) : (const f32x2*)(ws + WS_ROPE), (bf16_t*)(ws + WS_F), (float*)(ws + o_lse)); }
        for (int r2_ = 0; r2_ < (DUP_PHASE == 22 ? 2 : 1); ++r2_)
        { const Ctx C = MKCTX(); unsigned char* ws = KWS();
          for (int it = C.gw; it < BATCH * NCH * SSM_G; it += C.ngw) ssm_item<false>(C, it, (const bf16_t*)(ws + WS_C), ws + WS_SSMC + (size_t)l * SSMC_LAYER, (f32x2*)(ws + o_send), nullptr, nullptr, nullptr, nullptr); }
        GRID_SYNC();
        }
#if DBG_STOP >= 11 && DBG_STOP <= 18
        if (DBG_STOP == 10 + 2 && l == DBG_LAYER) DBG_DUMP_RET();
#endif
        for (int rep_ = 0; rep_ < ((DUP_PHASE == 3 && (DUP_LAYER < 0 || DUP_LAYER == l)) ? 2 : 1); ++rep_) {
        for (int r2_ = 0; r2_ < (DUP_PHASE == 31 ? 2 : 1); ++r2_)
        { const Ctx C = MKCTX(); unsigned char* ws = KWS();
          const float* cre = KIN(I_CRE) + (size_t)l * SSM_G * SSM_P * SSM_N; const float* cim = KIN(I_CIM) + (size_t)l * SSM_G * SSM_P * SSM_N; const float* dsk = KIN(I_SD) + (size_t)l * SSMW;
          for (int it = C.gw; it < BATCH * NCH * SSM_G; it += C.ngw)
              ssm_item<true>(C, it, (const bf16_t*)(ws + WS_C), ws + WS_SSMC + (size_t)l * SSMC_LAYER, (f32x2*)(ws + o_send), cre, cim, dsk, (bf16_t*)(ws + WS_D + 32 * MiB)); }
        for (int r2_ = 0; r2_ < (DUP_PHASE == 32 ? 2 : 1); ++r2_)
        { const Ctx C = MKCTX(); unsigned char* ws = KWS();
          pool_items(C, (const bf16_t*)(ws + WS_C), (bf16_t*)(ws + WS_D));
          attn_merge_items(C, (const bf16_t*)(ws + WS_F), (const float*)(ws + o_lse), (bf16_t*)(ws + WS_D + 64 * MiB));
          }
        GRID_SYNC();
        }
#if DBG_STOP >= 11 && DBG_STOP <= 18
        if (DBG_STOP == 10 + 3 && l == DBG_LAYER) DBG_DUMP_RET();
#endif
        for (int rep_ = 0; rep_ < ((DUP_PHASE == 4 && (DUP_LAYER < 0 || DUP_LAYER == l)) ? 2 : 1); ++rep_) {
        { const Ctx C = MKCTX(); unsigned char* ws = KWS(); pg8::EpiPlain E{(bf16_t*)(ws + WS_C), POOLW, nullptr};
          run_gemm(C, (const bf16_t*)(ws + WS_D), POOLW, (const bf16_t*)(WL(ws) + WO_POOL), POOLW, POOLW, POOLW, E); }
        { const Ctx C = MKCTX(); unsigned char* ws = KWS(); pg8::EpiGlu E{(bf16_t*)(ws + WS_C + 32 * MiB)};
          run_gemm(C, (const bf16_t*)(ws + WS_D + 32 * MiB), SSMW, (const bf16_t*)(WL(ws) + WO_GLU), SSMW, 2 * SSMW, SSMW, E); }
        GRID_SYNC();
        }
#if DBG_STOP >= 11 && DBG_STOP <= 18
        if (DBG_STOP == 10 + 4 && l == DBG_LAYER) DBG_DUMP_RET();
#endif
        for (int rep_ = 0; rep_ < ((DUP_PHASE == 5 && (DUP_LAYER < 0 || DUP_LAYER == l)) ? 2 : 1); ++rep_) {
#if GATE_F8
#define GATE_GEMM(b) { const Ctx C = MKCTX(); unsigned char* ws = KWS(); pg8::EpiGate E{(bf16_t*)(ws + WS_D + 80 * MiB), (const float*)(ws + o_rstd), 1.0f / GATE_WSC}; \
          run_gemm<pg8::EpiGate, true>(C, (const bf16_t*)(ws + WS_H8), D / 2, (const bf16_t*)(WL(ws) + WO_WIN + (size_t)NZ * D * 2 + (size_t)(b) * D * D), D / 2, D, D / 2, E); }
#else
#define GATE_GEMM(b) { const Ctx C = MKCTX(); unsigned char* ws = KWS(); pg8::EpiGate E{(bf16_t*)(ws + WS_D + 80 * MiB), (const float*)(ws + o_rstd), 1.0f}; \
          run_gemm(C, (const bf16_t*)XA_(ws), D, (const bf16_t*)(WL(ws) + WO_WIN) + (size_t)(NZ + (b) * D) * D, D, D, D, E); }
#endif
        stagger(STAG_P5);
        GATE_GEMM(0)
        { const Ctx C = MKCTX(); unsigned char* ws = KWS(); pg8::EpiMerge<true> E{(const bf16_t*)(ws + WS_D + 80 * MiB), (bf16_t*)(ws + WS_F), ABL_POOL ? 0.f : (S_U8 ? 1.0f / 255.0f : 1.f)};
          run_gemm(C, (const bf16_t*)(ws + WS_C), POOLW, (const bf16_t*)(WL(ws) + WO_PPROJ), POOLW, D, POOLW, E); }
        GATE_GEMM(1)
        { const Ctx C = MKCTX(); unsigned char* ws = KWS(); pg8::EpiMerge<false> E{(const bf16_t*)(ws + WS_D + 80 * MiB), (bf16_t*)(ws + WS_F), ABL_SSM ? 0.f : (S_U8 ? 1.0f / 255.0f : 1.f)};
          run_gemm(C, (const bf16_t*)(ws + WS_C + 32 * MiB), SSMW, (const bf16_t*)(WL(ws) + WO_SPROJ), SSMW, D, SSMW, E); }
        GATE_GEMM(2)
        { const Ctx C = MKCTX(); unsigned char* ws = KWS(); pg8::EpiMerge<false> E{(const bf16_t*)(ws + WS_D + 80 * MiB), (bf16_t*)(ws + WS_F), ABL_ATTN ? 0.f : (S_U8 ? 1.0f / 255.0f : 1.f)};
          run_gemm(C, (const bf16_t*)(ws + WS_D + 64 * MiB), AOUT, (const bf16_t*)(WL(ws) + WO_APROJ), AOUT, D, AOUT, E); }
        GRID_SYNC();
        }
#if DBG_STOP >= 11 && DBG_STOP <= 18
        if (DBG_STOP == 10 + 5 && l == DBG_LAYER) DBG_DUMP_RET();
#endif
        for (int rep_ = 0; rep_ < ((DUP_PHASE == 6 && (DUP_LAYER < 0 || DUP_LAYER == l)) ? 2 : 1); ++rep_) {
        stagger(STAG_P6);
        { const Ctx C = MKCTX(); unsigned char* ws = KWS(); float* xs = (float*)karg(26);
#if XB16
          pg8::EpiOut E{(const bf16_t*)XA_(ws), X1_(ws), (float*)(ws + o_ssp), ws + WS_H8};
#else
          pg8::EpiOut E{l == 0 ? KIN(I_X) : (const float*)xs, xs, (bf16_t*)(ws + WS_E), KIN(I_N2G) + (size_t)l * D, (float*)(ws + o_ssp), ws + WS_H8};
#endif
          run_gemm(C, (const bf16_t*)(ws + WS_F), D, (const bf16_t*)(WL(ws) + WO_WOUT), D, D, D, E); }
        GRID_SYNC();
        }
#if DBG_STOP >= 11 && DBG_STOP <= 18
        if (DBG_STOP == 10 + 6 && l == DBG_LAYER) DBG_DUMP_RET();
#endif
        for (int rep_ = 0; rep_ < ((DUP_PHASE == 7 && (DUP_LAYER < 0 || DUP_LAYER == l)) ? 2 : 1); ++rep_) {
        stagger(STAG_P7);
#if Q_F8
        { const Ctx C = MKCTX(); unsigned char* ws = KWS(); pg8::EpiPlain E{(bf16_t*)(ws + WS_D), PQ, (const float*)(ws + o_ssp), 1.0f / GATE_WSC};
          run_gemm<pg8::EpiPlain, true>(C, (const bf16_t*)(ws + WS_H8), D / 2, (const bf16_t*)(WL(ws) + WO_WQ), D / 2, PQ, D / 2, E); }
#else
        { const Ctx C = MKCTX(); unsigned char* ws = KWS(); pg8::EpiPlain E{(bf16_t*)(ws + WS_D), PQ, (const float*)(ws + o_ssp)};
          run_gemm(C, (const bf16_t*)X1_(ws), D, (const bf16_t*)(WL(ws) + WO_WQ), D, PQ, D, E); }
#endif
#if FUSE78
        { const Ctx C = MKCTX(); unsigned char* ws = KWS();
          asm volatile("s_waitcnt vmcnt(0)" ::: "memory"); __syncthreads();
          topk_stage_keys(C, (const bf16_t*)(WL(ws) + WO_K1), (const bf16_t*)(WL(ws) + WO_K2));
          __syncthreads();
          pg8::StaticOrder S; S.init(M, PQ, C.G, C.bid);
          topk_own_items(C, S, (const bf16_t*)(ws + WS_D), (int*)(ws + WS_C), (float*)(ws + WS_C + 16 * MiB)); }
#endif
        GRID_SYNC();
        }
#if DBG_STOP >= 11 && DBG_STOP <= 18
        if (DBG_STOP == 10 + 7 && l == DBG_LAYER) DBG_DUMP_RET();
#endif
#if !FUSE78
        for (int rep_ = 0; rep_ < ((DUP_PHASE == 8 && (DUP_LAYER < 0 || DUP_LAYER == l)) ? 2 : 1); ++rep_) {
        { const Ctx C = MKCTX(); unsigned char* ws = KWS();
          topk_stage_keys(C, (const bf16_t*)(WL(ws) + WO_K1), (const bf16_t*)(WL(ws) + WO_K2));
          __syncthreads();
          topk_items(C, (const bf16_t*)(ws + WS_D), (int*)(ws + WS_C), (float*)(ws + WS_C + 16 * MiB)); }
        GRID_SYNC();
        }
#endif
#if DBG_STOP >= 11 && DBG_STOP <= 18
        if (DBG_STOP == 10 + 8 && l == DBG_LAYER) DBG_DUMP_RET();
#endif
#if DBG_STOP == 28 || DBG_STOP == 27
        if (l == DBG_LAYER) { const Ctx C = MKCTX(); unsigned char* ws = KWS(); float* o = (float*)karg(26);
          if (DBG_STOP == 28) { const int* pi = (const int*)(ws + WS_C); for (size_t i = C.gt; i < (size_t)M * D; i += C.ngt) { const size_t m = i >> 10; const int c = (int)(i & 1023); o[i] = c < 128 ? (float)pi[m * 128 + c] : 0.f; } }
          else { const bf16_t* q = (const bf16_t*)(ws + WS_D); for (size_t i = C.gt; i < (size_t)M * D; i += C.ngt) { const size_t m = i >> 10; const int c = (int)(i & 1023); o[i] = bflo((unsigned)q[m * PQ + c]) + bflo((unsigned)q[m * PQ + 1024 + c]) * 3.0f; } }
          return; }
#endif
        if (l + 1 < DEPTH) {
            { const Ctx C = MKCTX(); unsigned char* ws = KWS(); float* xs = (float*)karg(26); const float* gn = KIN(I_N1G) + (size_t)(l + 1) * D;
              if (DUP_PHASE == 9) { PEER_CALL(false, true)(C, ws, ws + WS_TAB + (size_t)l * TAB_LAYER, (const float*)(ws + WS_TSC + (size_t)l * 131072), (const float*)(ws + WS_TSC + (size_t)l * 131072 + 65536), (const int*)(ws + WS_C), (const float*)(ws + WS_C + 16 * MiB),
                                                                     (const float*)(ws + o_ssp), xs, X1_(ws), gn, (float*)(ws + o_rstd_next), KIN(I_N2G) + (size_t)l * D, X2_(ws)); }
              PEER_CALL(false, false)(C, ws, ws + WS_TAB + (size_t)l * TAB_LAYER, (const float*)(ws + WS_TSC + (size_t)l * 131072), (const float*)(ws + WS_TSC + (size_t)l * 131072 + 65536), (const int*)(ws + WS_C), (const float*)(ws + WS_C + 16 * MiB),
                                                                     (const float*)(ws + o_ssp), xs, X1_(ws), gn, (float*)(ws + o_rstd_next), KIN(I_N2G) + (size_t)l * D, X2_(ws)); }
            GRID_SYNC();
#if DBG_STOP == 6
            DBG_DUMP_RET();
#endif
        } else {
            const Ctx C = MKCTX(); unsigned char* ws = KWS(); float* xs = (float*)karg(26); const float* gn = KIN(I_FG);
            PEER_CALL(true, false)(C, ws, ws + WS_TAB + (size_t)l * TAB_LAYER, (const float*)(ws + WS_TSC + (size_t)l * 131072), (const float*)(ws + WS_TSC + (size_t)l * 131072 + 65536), (const int*)(ws + WS_C), (const float*)(ws + WS_C + 16 * MiB),
                                                                  (const float*)(ws + o_ssp), xs, X1_(ws), gn, (float*)(ws + o_rstd_next), KIN(I_N2G) + (size_t)l * D, X2_(ws));
#ifdef PROBE_END_RELEASE
            asm volatile("s_waitcnt vmcnt(0)" ::: "memory"); __syncthreads();
            if (TIDX() == 0) { __builtin_amdgcn_fence(__ATOMIC_RELEASE, ""); asm volatile("s_waitcnt vmcnt(0)" ::: "memory"); }
#endif
        }
    }
}

extern "C" void kernel_launch(void* const* d_in, const int* in_sizes, int n_in, void* d_out, int out_size, void* d_ws, size_t ws_size, hipStream_t stream) {
    static int grid = 0;
    if (grid == 0) {
        if (n_in != 26 || in_sizes[0] != M * D || out_size != M * D || ws_size < WS_END) { fprintf(stderr, "kernel_launch: unexpected shapes (n_in %d, in0 %d, out %d, ws %zu); nothing launched\n", n_in, n_in > 0 ? in_sizes[0] : -1, out_size, ws_size); grid = -1; return; }
        int dev = 0, cus = 0, per_cu = 0;
        if (hipGetDevice(&dev) != hipSuccess || hipDeviceGetAttribute(&cus, hipDeviceAttributeMultiprocessorCount, dev) != hipSuccess) { grid = -1; return; }
        if (hipFuncSetAttribute((const void*)mk_fwd, hipFuncAttributeMaxDynamicSharedMemorySize, LDS_BYTES) != hipSuccess) { fprintf(stderr, "kernel_launch: hipFuncSetAttribute failed\n"); grid = -1; return; }
        if (hipOccupancyMaxActiveBlocksPerMultiprocessor(&per_cu, (const void*)mk_fwd, NTHREADS, LDS_BYTES) != hipSuccess || per_cu < 1) { fprintf(stderr, "kernel_launch: occupancy query says %d\n", per_cu); grid = -1; (void)hipGetLastError(); return; }
        grid = cus;
    }
    if (grid < 0) return;
    (void)hipMemsetAsync((char*)d_ws + WS_CTL, 0, CTL_BYTES, stream);
    Args a{};
    for (int i = 0; i < 26; ++i) a.in[i] = d_in[i];
    a.out = (float*)d_out; a.ws = (unsigned char*)d_ws;
    void* kargs[] = {&a};
    const hipError_t e = hipLaunchCooperativeKernel((const void*)mk_fwd, dim3(grid), dim3(NTHREADS), kargs, LDS_BYTES, stream);
    if (e != hipSuccess) fprintf(stderr, "kernel_launch: cooperative launch failed: %s (grid %d)\n", hipGetErrorString(e), grid);
}
```
